# Optimizing an MI355X kernel written in HIP

```python
import jax, jax.numpy as jnp
from jax import lax
import numpy as np

D_MODEL = 1024
BATCH = 32
SEQ = 2048
DEPTH = 1
DEC_BATCH = 4
DEC_SEQ = 8192
PAST_LEN = 128

F32 = jnp.float32
RMS_EPS = 1e-6
N_MEM = 256
MLA_HEADS = 8
MLA_NOPE = 64
MLA_ROPE = 32
MLA_QK = MLA_NOPE + MLA_ROPE
MLA_V = 64
Q_LORA = 384
KV_LORA = 256
ROPE_THETA = 10000.0
Q_BLOCK = 128
RW_HEADS = 8
RW_HEAD = 64
RW_DIM = RW_HEADS * RW_HEAD
DECAY_LORA = 64
AAA_LORA = 64
GATE_LORA = 128
RW_COLS = 3 * RW_DIM + 2 * DECAY_LORA + 2 * AAA_LORA + GATE_LORA
LNX_EPS = 64e-5
X_HEADS = 4
X_HEAD = 128
X_DIM = X_HEADS * X_HEAD
N_BRANCH = 3
MLA_COLS = Q_LORA + KV_LORA + MLA_ROPE
IN_COLS = MLA_COLS + RW_COLS + X_DIM + N_BRANCH * D_MODEL
D_FF = 2816

kernel_name = 'hybrid_mla_rwkv7_memxattn_convffn_encoder'


def rms_norm(x, g, eps=RMS_EPS):
    xf = x.astype(F32)
    y = xf * lax.rsqrt(jnp.mean(xf * xf, axis=-1, keepdims=True) + eps)
    return (y * g.astype(F32)).astype(x.dtype)


def shift_prev(x):
    return jnp.pad(x, ((0, 0), (1, 0), (0, 0)))[:, :-1]


def shift_next(x):
    return jnp.pad(x, ((0, 0), (0, 1), (0, 0)))[:, 1:]


def rope(x, T):
    half = MLA_ROPE // 2
    inv = jnp.power(ROPE_THETA, -jnp.arange(half, dtype=F32) / half)
    ang = jnp.arange(T, dtype=F32)[:, None] * inv[None, :]
    cos = jnp.cos(ang)[None, :, None, :]
    sin = jnp.sin(ang)[None, :, None, :]
    x1 = x[..., :half].astype(F32)
    x2 = x[..., half:].astype(F32)
    return jnp.concatenate([x1 * cos - x2 * sin, x2 * cos + x1 * sin], axis=-1).astype(x.dtype)


def blocked_attention(q, k, v, scale):
    B, T, H, Dq = q.shape
    nb = T // Q_BLOCK
    qb = jnp.moveaxis(q.reshape(B, nb, Q_BLOCK, H, Dq), 1, 0)

    def one(qblk):
        s = jnp.einsum('bqhd,bkhd->bhqk', qblk, k).astype(F32) * scale
        p = jax.nn.softmax(s, axis=-1)
        return jnp.einsum('bhqk,bkhd->bqhd', p.astype(v.dtype), v)

    o = lax.map(one, qb)
    return jnp.moveaxis(o, 0, 1).reshape(B, T, H, v.shape[-1])


def wkv7_scan(r, decay, k, v, kk, b, reverse):
    B, T, H, N = r.shape
    xs = tuple(jnp.moveaxis(a, 1, 0) for a in (r, decay, k, v, kk, b))

    def step(S, inp):
        r_t, w_t, k_t, v_t, kk_t, b_t = inp
        sa = jnp.einsum('bhvk,bhk->bhv', S, kk_t)
        S = S * w_t[:, :, None, :] - sa[..., None] * b_t[:, :, None, :] + v_t[..., None] * k_t[:, :, None, :]
        y = jnp.einsum('bhvk,bhk->bhv', S, r_t)
        return S, y

    S0 = jnp.zeros((B, H, N, N), F32)
    _, ys = lax.scan(step, S0, xs, reverse=reverse)
    return jnp.moveaxis(ys, 0, 1)


def rwkv7_direction(r, k, v, kk, wl, al, w0, w2, a0, a2, k_a, r_k, reverse):
    B, T, _ = r.shape
    hs = lambda t: t.reshape(B, T, RW_HEADS, RW_HEAD)
    w = -jax.nn.softplus(-(w0.astype(F32) + jnp.tanh(wl) @ w2.astype(F32))) - 0.5
    decay = jnp.exp(-jnp.exp(w))
    a = jax.nn.sigmoid(a0.astype(F32) + al @ a2.astype(F32))
    kd = k * (1.0 + (a - 1.0) * k_a.astype(F32))
    rh, kdh, vh = hs(r), hs(kd), hs(v)
    y = wkv7_scan(rh, hs(decay), kdh, vh, kk, kk * hs(a), reverse)
    bonus = jnp.sum(rh * kdh * r_k.astype(F32), axis=-1, keepdims=True) * vh
    return y + bonus


def encoder_layer(x, mem, p, l):
    B, T, _ = x.shape
    h = rms_norm(x, p['norm_mix_g'][l])
    proj = h @ p['w_in'][l]
    idx = [int(i) for i in np.cumsum([Q_LORA, KV_LORA, MLA_ROPE, RW_COLS, X_DIM])]
    c_q, c_kv, k_r, rw, xq, gate_logits = jnp.split(proj, idx, axis=-1)

    H = MLA_HEADS
    q = (rms_norm(c_q, p['q_norm_g'][l]) @ p['w_uq'][l]).reshape(B, T, H, MLA_QK)
    kv = (rms_norm(c_kv, p['kv_norm_g'][l]) @ p['w_ukv'][l]).reshape(B, T, H, MLA_NOPE + MLA_V)
    k_nope, v_a = kv[..., :MLA_NOPE], kv[..., MLA_NOPE:]
    k = jnp.concatenate([k_nope, jnp.broadcast_to(k_r[:, :, None, :], (B, T, H, MLA_ROPE))], axis=-1)
    q = rms_norm(q, p['mla_qn_g'][l])
    k = rms_norm(k, p['mla_kn_g'][l])
    q = jnp.concatenate([q[..., :MLA_NOPE], rope(q[..., MLA_NOPE:], T)], axis=-1)
    k = jnp.concatenate([k[..., :MLA_NOPE], rope(k[..., MLA_NOPE:], T)], axis=-1)
    o_a = blocked_attention(q, k, v_a, MLA_QK ** -0.5).reshape(B, T, H * MLA_V) @ p['w_o_a'][l]

    rwf = rw.astype(F32)
    rwf = rwf + p['mu_prev'][l].astype(F32) * (shift_prev(rwf) - rwf) + p['mu_next'][l].astype(F32) * (shift_next(rwf) - rwf)
    idx2 = [int(i) for i in np.cumsum([RW_DIM, RW_DIM, RW_DIM, DECAY_LORA, DECAY_LORA, AAA_LORA, AAA_LORA])]
    r7, k7, v7, wl_f, wl_b, al_f, al_b, gl = jnp.split(rwf, idx2, axis=-1)
    kk = (k7 * p['k_k'][l].astype(F32)).reshape(B, T, RW_HEADS, RW_HEAD)
    kk = kk / jnp.maximum(jnp.sqrt(jnp.sum(kk * kk, axis=-1, keepdims=True)), 1e-12)
    y_f = rwkv7_direction(r7, k7, v7, kk, wl_f, al_f, p['w0_f'][l], p['w2_f'][l], p['a0_f'][l], p['a2_f'][l], p['k_a'][l], p['r_k'][l], False)
    y_b = rwkv7_direction(r7, k7, v7, kk, wl_b, al_b, p['w0_b'][l], p['w2_b'][l], p['a0_b'][l], p['a2_b'][l], p['k_a'][l], p['r_k'][l], True)
    y7 = y_f + y_b
    mu = jnp.mean(y7, axis=-1, keepdims=True)
    var = jnp.mean(jnp.square(y7 - mu), axis=-1, keepdims=True)
    y7 = ((y7 - mu) * lax.rsqrt(var + LNX_EPS)).reshape(B, T, RW_DIM)
    y7 = y7 * p['lnx_g'][l].astype(F32) + p['lnx_b'][l].astype(F32)
    g7 = jax.nn.sigmoid(gl) @ p['g2'][l].astype(F32)
    o_b = (y7 * g7).astype(x.dtype) @ p['w_o_b'][l]

    m = rms_norm(mem, p['mem_norm_g'][l])
    mkv = (m @ p['w_mkv'][l]).reshape(B, N_MEM, X_HEADS, 2 * X_HEAD)
    mk, mv = mkv[..., :X_HEAD], mkv[..., X_HEAD:]
    xqh = rms_norm(xq.reshape(B, T, X_HEADS, X_HEAD), p['x_qn_g'][l])
    mk = rms_norm(mk, p['x_kn_g'][l])
    s = jnp.einsum('bqhd,bkhd->bhqk', xqh, mk).astype(F32) * (X_HEAD ** -0.5)
    pr = jax.nn.softmax(s, axis=-1)
    o_c = jnp.einsum('bhqk,bkhd->bqhd', pr.astype(mv.dtype), mv).reshape(B, T, X_DIM) @ p['w_o_c'][l]

    gates = jax.nn.sigmoid(gate_logits.astype(F32)).reshape(B, T, N_BRANCH, D_MODEL).astype(x.dtype)
    merged = gates[:, :, 0] * o_a + gates[:, :, 1] * o_b + gates[:, :, 2] * o_c
    x = x + merged @ p['w_out'][l]

    h2 = rms_norm(x, p['norm_ffn_g'][l])
    up = h2 @ p['w_up'][l]
    u_gate, u_val = up[..., :D_FF], up[..., D_FF:]
    cw = p['conv_w'][l]
    c = cw[0] * shift_prev(u_gate) + cw[1] * u_gate + cw[2] * shift_next(u_gate) + p['conv_b'][l]
    act = jax.nn.gelu(c, approximate=False) * u_val
    return x + act @ p['w_down'][l]


def setup_inputs(seed: int = 0) -> dict:
    key = jax.random.key(seed)
    ks = iter(jax.random.split(key, 64))

    def nrm(shape, scale):
        return jax.random.normal(next(ks), shape, F32) * scale

    def gain(shape):
        return 1.0 + nrm(shape, 0.1)

    L = DEPTH
    return {
        'x_prompt': nrm((BATCH, SEQ, D_MODEL), 1.0),
        'x_sample': nrm((DEC_BATCH, DEC_SEQ, D_MODEL), 1.0),
        'mem_prompt': nrm((BATCH, N_MEM, D_MODEL), 1.0),
        'mem_sample': nrm((DEC_BATCH, N_MEM, D_MODEL), 1.0),
        'norm_mix_g': gain((L, D_MODEL)),
        'w_in': nrm((L, D_MODEL, IN_COLS), D_MODEL ** -0.5),
        'q_norm_g': gain((L, Q_LORA)),
        'w_uq': nrm((L, Q_LORA, MLA_HEADS * MLA_QK), Q_LORA ** -0.5),
        'kv_norm_g': gain((L, KV_LORA)),
        'w_ukv': nrm((L, KV_LORA, MLA_HEADS * (MLA_NOPE + MLA_V)), KV_LORA ** -0.5),
        'mla_qn_g': gain((L, MLA_QK)),
        'mla_kn_g': gain((L, MLA_QK)),
        'w_o_a': nrm((L, MLA_HEADS * MLA_V, D_MODEL), (MLA_HEADS * MLA_V) ** -0.5),
        'mu_prev': 0.3 + nrm((L, RW_COLS), 0.1),
        'mu_next': 0.3 + nrm((L, RW_COLS), 0.1),
        'w0_f': -2.0 + nrm((L, RW_DIM), 1.0),
        'w2_f': nrm((L, DECAY_LORA, RW_DIM), 0.5 * DECAY_LORA ** -0.5),
        'a0_f': nrm((L, RW_DIM), 0.1),
        'a2_f': nrm((L, AAA_LORA, RW_DIM), 0.5 * AAA_LORA ** -0.5),
        'w0_b': -2.0 + nrm((L, RW_DIM), 1.0),
        'w2_b': nrm((L, DECAY_LORA, RW_DIM), 0.5 * DECAY_LORA ** -0.5),
        'a0_b': nrm((L, RW_DIM), 0.1),
        'a2_b': nrm((L, AAA_LORA, RW_DIM), 0.5 * AAA_LORA ** -0.5),
        'g2': nrm((L, GATE_LORA, RW_DIM), GATE_LORA ** -0.5),
        'k_k': 0.85 + nrm((L, RW_DIM), 0.05),
        'k_a': 1.0 + nrm((L, RW_DIM), 0.1),
        'r_k': nrm((L, RW_HEADS, RW_HEAD), 0.1),
        'lnx_g': gain((L, RW_DIM)),
        'lnx_b': nrm((L, RW_DIM), 0.02),
        'w_o_b': nrm((L, RW_DIM, D_MODEL), RW_DIM ** -0.5),
        'mem_norm_g': gain((L, D_MODEL)),
        'w_mkv': nrm((L, D_MODEL, 2 * X_DIM), D_MODEL ** -0.5),
        'x_qn_g': gain((L, X_HEAD)),
        'x_kn_g': gain((L, X_HEAD)),
        'w_o_c': nrm((L, X_DIM, D_MODEL), X_DIM ** -0.5),
        'w_out': nrm((L, D_MODEL, D_MODEL), D_MODEL ** -0.5),
        'norm_ffn_g': gain((L, D_MODEL)),
        'w_up': nrm((L, D_MODEL, 2 * D_FF), D_MODEL ** -0.5),
        'conv_w': nrm((L, 3, D_FF), 3 ** -0.5),
        'conv_b': nrm((L, D_FF), 0.02),
        'w_down': nrm((L, D_FF, D_MODEL), D_FF ** -0.5),
    }


def reference(x_prompt, x_sample, mem_prompt, mem_sample, norm_mix_g, w_in, q_norm_g, w_uq, kv_norm_g, w_ukv,
              mla_qn_g, mla_kn_g, w_o_a, mu_prev, mu_next, w0_f, w2_f, a0_f, a2_f, w0_b, w2_b, a0_b, a2_b,
              g2, k_k, k_a, r_k, lnx_g, lnx_b, w_o_b, mem_norm_g, w_mkv, x_qn_g, x_kn_g, w_o_c, w_out,
              norm_ffn_g, w_up, conv_w, conv_b, w_down):
    p = dict(norm_mix_g=norm_mix_g, w_in=w_in, q_norm_g=q_norm_g, w_uq=w_uq, kv_norm_g=kv_norm_g, w_ukv=w_ukv,
             mla_qn_g=mla_qn_g, mla_kn_g=mla_kn_g, w_o_a=w_o_a, mu_prev=mu_prev, mu_next=mu_next,
             w0_f=w0_f, w2_f=w2_f, a0_f=a0_f, a2_f=a2_f, w0_b=w0_b, w2_b=w2_b, a0_b=a0_b, a2_b=a2_b,
             g2=g2, k_k=k_k, k_a=k_a, r_k=r_k, lnx_g=lnx_g, lnx_b=lnx_b, w_o_b=w_o_b,
             mem_norm_g=mem_norm_g, w_mkv=w_mkv, x_qn_g=x_qn_g, x_kn_g=x_kn_g, w_o_c=w_o_c, w_out=w_out,
             norm_ffn_g=norm_ffn_g, w_up=w_up, conv_w=conv_w, conv_b=conv_b, w_down=w_down)
    y_prompt = x_prompt
    y_sample = x_sample
    for l in range(DEPTH):
        y_prompt = encoder_layer(y_prompt, mem_prompt, p, l)
        y_sample = encoder_layer(y_sample, mem_sample, p, l)
    return (y_prompt, y_sample)
```

```cpp
#include <hip/hip_runtime.h>
#include <hip/hip_cooperative_groups.h>
#include <cstdio>
#include <cstdint>
namespace cg = cooperative_groups;

typedef unsigned short u16;
typedef __attribute__((ext_vector_type(8))) short bf16x8;
typedef __attribute__((ext_vector_type(16))) float f32x16;

#ifndef MEGA
#define MEGA 1
#endif

constexpr int NT = 98304;
constexpr int NTP = 65536;
constexpr int NMEMROWS = 9216;
constexpr int NTHREADS = 256;
constexpr int LDS_BYTES = 73728;

constexpr size_t OFF_CTL = 0;
constexpr size_t OFF_WIN = 4096;
constexpr size_t OFF_WUQ = OFF_WIN + (size_t)6272 * 1024 * 2;
constexpr size_t OFF_WUKV = OFF_WUQ + (size_t)768 * 384 * 2;
constexpr size_t OFF_WOA = OFF_WUKV + (size_t)1024 * 256 * 2;
constexpr size_t OFF_WOB = OFF_WOA + (size_t)1024 * 768 * 2;
constexpr size_t OFF_WOC = OFF_WOB + (size_t)1024 * 512 * 2;
constexpr size_t OFF_WMKV = OFF_WOC + (size_t)1024 * 512 * 2;
constexpr size_t OFF_WOUT = OFF_WMKV + (size_t)2048 * 1024 * 2;
constexpr size_t OFF_WUP = OFF_WOUT + (size_t)1024 * 1024 * 2;
constexpr size_t OFF_WDOWN = OFF_WUP + (size_t)5632 * 1024 * 2;
constexpr size_t OFF_G2 = OFF_WDOWN + (size_t)1024 * 2816 * 2;
constexpr size_t OFF_W2F = OFF_G2 + (size_t)512 * 128 * 2;
constexpr size_t OFF_W2B = OFF_W2F + 65536;
constexpr size_t OFF_A2F = OFF_W2B + 65536;
constexpr size_t OFF_A2B = OFF_A2F + 65536;
constexpr size_t OFF_H = 50331648;
static_assert(OFF_A2B + 65536 <= OFF_H, "weights overflow");
constexpr size_t OFF_CQKV = OFF_H + (size_t)NT * 1024 * 2;
constexpr size_t OFF_RW = OFF_CQKV + (size_t)NT * 672 * 2;
constexpr size_t OFF_XQ = OFF_RW + (size_t)NT * 1920 * 2;
constexpr size_t OFF_MH = OFF_XQ + (size_t)NT * 512 * 2;
constexpr size_t OFF_MKV = OFF_MH + (size_t)NMEMROWS * 1024 * 2;
constexpr size_t OFF_MK = OFF_MKV + (size_t)NMEMROWS * 2048 * 2;
constexpr size_t OFF_MVT = OFF_MK + (size_t)NMEMROWS * 512 * 2;
constexpr size_t OFF_YB = OFF_MVT + (size_t)NMEMROWS * 512 * 2;
constexpr size_t WS_END = OFF_YB + (size_t)NT * 512 * 2;
static_assert(WS_END <= (size_t)1073741824, "workspace overflow");
constexpr size_t OFF_YF = OFF_CQKV;
constexpr size_t OFF_MERGED = OFF_RW;
constexpr size_t OFF_ACT = OFF_CQKV;
static_assert((size_t)NT * 2816 * 2 <= OFF_MH - OFF_CQKV, "act overflow");
constexpr size_t DO_Q = 0;
constexpr size_t DO_K = (size_t)NT * 768 * 2;
constexpr size_t DO_VT = DO_K + (size_t)NT * 768 * 2;

struct Params {
  const float* in[41];
  float* out;
  unsigned char* ws;
  int lo, hi;
};

typedef __bf16 bf16x2_t __attribute__((ext_vector_type(2)));
typedef float f32x2_t __attribute__((ext_vector_type(2)));
__device__ __forceinline__ unsigned pack2(float a, float b) {
  f32x2_t f = {a, b};
  bf16x2_t h = __builtin_convertvector(f, bf16x2_t);
  return __builtin_bit_cast(unsigned, h);
}
__device__ __forceinline__ u16 f2bf(float f) { return (u16)(pack2(f, f) & 0xffffu); }
__device__ __forceinline__ float bf2f(u16 b) { return __uint_as_float(((unsigned)b) << 16); }
__device__ __forceinline__ float bflo(unsigned u) { return __uint_as_float(u << 16); }
__device__ __forceinline__ float bfhi(unsigned u) { return __uint_as_float(u & 0xffff0000u); }

template <int CTRL>
__device__ __forceinline__ float dppf(float v) {
  return __int_as_float(__builtin_amdgcn_mov_dpp(__float_as_int(v), CTRL, 0xF, 0xF, true));
}
__device__ __forceinline__ float sum16(float v) {
  v += dppf<0xB1>(v);
  v += dppf<0x4E>(v);
  v += dppf<0x141>(v);
  v += dppf<0x140>(v);
  return v;
}
__device__ __forceinline__ float sum8(float v) {
  v += dppf<0xB1>(v);
  v += dppf<0x4E>(v);
  v += dppf<0x141>(v);
  return v;
}
__device__ __forceinline__ float wave_sum(float v) {
  v = sum16(v);
  v += __shfl_xor(v, 16);
  v += __shfl_xor(v, 32);
  return v;
}
__device__ __forceinline__ float sigmoidf_(float x) { return 1.f / (1.f + __expf(-x)); }

__device__ __forceinline__ void tok_seq(int g, int& seq, int& start, int& T) {
  if (g < NTP) { seq = g >> 11; start = seq << 11; T = 2048; }
  else { int s = (g - NTP) >> 13; seq = 32 + s; start = NTP + (s << 13); T = 8192; }
}
__device__ __forceinline__ size_t vt_base(int seq) {
  return seq < 32 ? (size_t)seq * (512 * 2048) : (size_t)32 * 512 * 2048 + (size_t)(seq - 32) * (512 * 8192);
}

struct Acc { f32x16 a[2][2]; };
constexpr int LROW = 72;
constexpr int LTILE = 128 * LROW;

__device__ __forceinline__ void acc_zero(Acc& acc) {
#pragma unroll
  for (int i = 0; i < 2; i++)
#pragma unroll
    for (int j = 0; j < 2; j++)
#pragma unroll
      for (int r = 0; r < 16; r++) acc.a[i][j][r] = 0.f;
}

__device__ __forceinline__ void gemm_compute(Acc& acc, const u16* lds, int b) {
  const int lane = threadIdx.x & 63, wave = threadIdx.x >> 6, wm = wave >> 1, wn = wave & 1;
  const u16* A = lds + b * (2 * LTILE) + (64 * wm + (lane & 31)) * LROW + 8 * (lane >> 5);
  const u16* B = lds + b * (2 * LTILE) + LTILE + (64 * wn + (lane & 31)) * LROW + 8 * (lane >> 5);
#pragma unroll
  for (int s = 0; s < 4; s++) {
    bf16x8 a0 = *(const bf16x8*)(A + 16 * s);
    bf16x8 a1 = *(const bf16x8*)(A + 32 * LROW + 16 * s);
    bf16x8 b0 = *(const bf16x8*)(B + 16 * s);
    bf16x8 b1 = *(const bf16x8*)(B + 32 * LROW + 16 * s);
    acc.a[0][0] = __builtin_amdgcn_mfma_f32_32x32x16_bf16(a0, b0, acc.a[0][0], 0, 0, 0);
    acc.a[0][1] = __builtin_amdgcn_mfma_f32_32x32x16_bf16(a0, b1, acc.a[0][1], 0, 0, 0);
    acc.a[1][0] = __builtin_amdgcn_mfma_f32_32x32x16_bf16(a1, b0, acc.a[1][0], 0, 0, 0);
    acc.a[1][1] = __builtin_amdgcn_mfma_f32_32x32x16_bf16(a1, b1, acc.a[1][1], 0, 0, 0);
  }
}

template <bool SINGLE = false, bool DEEP = true>
__device__ __forceinline__ void gemm_main(Acc& acc, u16* lds, const u16* pa0, const u16* pa1, const u16* pa2,
                                          const u16* pa3, const u16* pb0, const u16* pb1, const u16* pb2,
                                          const u16* pb3, int K) {
  const int tid = threadIdx.x;
  const int lr = tid >> 3, lk = (tid & 7) * 8;
  uint4 xa0, xa1, xa2, xa3, xb0, xb1, xb2, xb3;
  uint4 ya0, ya1, ya2, ya3, yb0, yb1, yb2, yb3;
  const int nk = K >> 6;
#define GLOAD(S, k0)                                                                         \
  S##a0 = *(const uint4*)(pa0 + (k0) + lk); S##a1 = *(const uint4*)(pa1 + (k0) + lk);         \
  S##a2 = *(const uint4*)(pa2 + (k0) + lk); S##a3 = *(const uint4*)(pa3 + (k0) + lk);         \
  S##b0 = *(const uint4*)(pb0 + (k0) + lk); S##b1 = *(const uint4*)(pb1 + (k0) + lk);         \
  S##b2 = *(const uint4*)(pb2 + (k0) + lk); S##b3 = *(const uint4*)(pb3 + (k0) + lk);
#define SSTORE(S, b)                                                                         \
  {                                                                                          \
    u16* A_ = lds + (b) * (2 * LTILE) + lr * LROW + lk;                                      \
    u16* B_ = A_ + LTILE;                                                                    \
    *(uint4*)(A_) = S##a0; *(uint4*)(A_ + 32 * LROW) = S##a1;                                \
    *(uint4*)(A_ + 64 * LROW) = S##a2; *(uint4*)(A_ + 96 * LROW) = S##a3;                    \
    *(uint4*)(B_) = S##b0; *(uint4*)(B_ + 32 * LROW) = S##b1;                                \
    *(uint4*)(B_ + 64 * LROW) = S##b2; *(uint4*)(B_ + 96 * LROW) = S##b3;                    \
  }
  if (!DEEP) {
    GLOAD(x, 0)
    SSTORE(x, 0)
    __syncthreads();
    for (int kt = 0; kt < nk; kt++) {
      if (kt + 1 < nk) { GLOAD(x, (kt + 1) * 64) }
      gemm_compute(acc, lds, SINGLE ? 0 : (kt & 1));
      if (SINGLE) __syncthreads();
      if (kt + 1 < nk) { SSTORE(x, SINGLE ? 0 : ((kt + 1) & 1)) }
      __syncthreads();
    }
    return;
  }
  GLOAD(x, 0)
  GLOAD(y, 64)
  SSTORE(x, 0)
  __syncthreads();
  for (int kt = 0; kt < nk; kt += 2) {
    if (kt + 2 < nk) { GLOAD(x, (kt + 2) * 64) }
    __builtin_amdgcn_sched_barrier(0);
    gemm_compute(acc, lds, 0);
    if (SINGLE) __syncthreads();
    SSTORE(y, SINGLE ? 0 : 1)
    __syncthreads();
    if (kt + 3 < nk) { GLOAD(y, (kt + 3) * 64) }
    __builtin_amdgcn_sched_barrier(0);
    gemm_compute(acc, lds, SINGLE ? 0 : 1);
    if (SINGLE) __syncthreads();
    if (kt + 2 < nk) { SSTORE(x, 0) }
    __syncthreads();
  }
#undef GLOAD
#undef SSTORE
}

template <bool SINGLE = false, bool DEEP = true>
__device__ __forceinline__ void gemm_lin(Acc& acc, u16* lds, const u16* A, long lda, const u16* B, long ldb, int K) {
  const int lr = threadIdx.x >> 3;
  gemm_main<SINGLE, DEEP>(acc, lds, A + (long)lr * lda, A + (long)(lr + 32) * lda, A + (long)(lr + 64) * lda,
            A + (long)(lr + 96) * lda, B + (long)lr * ldb, B + (long)(lr + 32) * ldb, B + (long)(lr + 64) * ldb,
            B + (long)(lr + 96) * ldb, K);
}

template <class F>
__device__ __forceinline__ void epi_each(const Acc& acc, F f) {
  const int lane = threadIdx.x & 63, wave = threadIdx.x >> 6, wm = wave >> 1, wn = wave & 1;
#pragma unroll
  for (int i = 0; i < 2; i++)
#pragma unroll
    for (int j = 0; j < 2; j++)
#pragma unroll
      for (int g = 0; g < 4; g++) {
        int r0 = 64 * wm + 32 * i + 8 * g + 4 * (lane >> 5);
        int c = 64 * wn + 32 * j + (lane & 31);
        f(r0, c, acc.a[i][j][4 * g + 0], acc.a[i][j][4 * g + 1], acc.a[i][j][4 * g + 2], acc.a[i][j][4 * g + 3]);
      }
}

__device__ __forceinline__ bool tile_map(int k, int MT, int NTL, int& mt, int& nt) {
  const int G = gridDim.x;
  if (G & 7) {
    int it = blockIdx.x + k * G;
    if (it >= MT * NTL) return false;
    mt = it / NTL; nt = it % NTL;
    return true;
  }
  const int xcd = blockIdx.x & 7, lb = blockIdx.x >> 3, nbx = G >> 3;
  const int mtx0 = (MT * xcd) >> 3, mtx1 = (MT * (xcd + 1)) >> 3, MTX = mtx1 - mtx0;
  const int idx = lb + k * nbx;
  if (idx >= MTX * NTL) return false;
  const int mg0 = idx / (8 * NTL);
  const int base = mg0 * 8;
  const int gsz = (MTX - base) < 8 ? (MTX - base) : 8;
  const int rem = idx - mg0 * 8 * NTL;
  nt = rem / gsz;
  mt = mtx0 + base + rem % gsz;
  return true;
}

template <class NMap, class KMap>
__device__ __forceinline__ void cvtw(const float* __restrict__ W, int srcN, u16* __restrict__ Wt, int dN, int dK,
                     const float* __restrict__ gain, NMap nmap, KMap kmap, long gtid, long gsz) {
  const int kch = dK >> 3;
  const long total = (long)dN * kch;
  for (long i = gtid; i < total; i += gsz) {
    int n = (int)(i % dN), kc = (int)(i / dN);
    int sn = nmap(n);
    float v[8];
#pragma unroll
    for (int j = 0; j < 8; j++) {
      int sk = kmap(kc * 8 + j);
      float x = 0.f;
      if (sn >= 0 && sk >= 0) {
        x = W[(long)sk * srcN + sn];
        if (gain) x *= gain[sk];
      }
      v[j] = x;
    }
    uint4 o;
    o.x = pack2(v[0], v[1]); o.y = pack2(v[2], v[3]); o.z = pack2(v[4], v[5]); o.w = pack2(v[6], v[7]);
    *(uint4*)(Wt + (long)n * dK + kc * 8) = o;
  }
}

__device__ __forceinline__ void phase0(const Params& P) {
  const long gtid = (long)blockIdx.x * NTHREADS + threadIdx.x, gsz = (long)gridDim.x * NTHREADS;
  unsigned char* ws = P.ws;
  if (gtid == 0) { ((unsigned*)(ws + OFF_CTL))[0] = 0u; }
  auto idn = [](int n) { return n; };
  cvtw(P.in[5], 6176, (u16*)(ws + OFF_WIN), 6272, 1024, P.in[4],
       [](int n) {
         if (n < 640) return n;
         if (n < 2560) return 672 + (n - 640);
         if (n < 3072) return 2592 + (n - 2560);
         if (n < 3104) return 640 + (n - 3072);
         if (n < 3200) return -1;
         return 3104 + (n - 3200);
       },
       idn, gtid, gsz);
  cvtw(P.in[7], 768, (u16*)(ws + OFF_WUQ), 768, 384, P.in[6], idn, idn, gtid, gsz);
  cvtw(P.in[9], 1024, (u16*)(ws + OFF_WUKV), 1024, 256, P.in[8], idn, idn, gtid, gsz);
  cvtw(P.in[12], 1024, (u16*)(ws + OFF_WOA), 1024, 768, nullptr, idn,
       [](int k) { int h = k / 96, d = k % 96; return d < 64 ? h * 64 + d : -1; }, gtid, gsz);
  cvtw(P.in[29], 1024, (u16*)(ws + OFF_WOB), 1024, 512, nullptr, idn, idn, gtid, gsz);
  cvtw(P.in[34], 1024, (u16*)(ws + OFF_WOC), 1024, 512, nullptr, idn, idn, gtid, gsz);
  cvtw(P.in[31], 1024, (u16*)(ws + OFF_WMKV), 1024, 1024, P.in[30], idn, idn, gtid, gsz);
  cvtw(P.in[35], 1024, (u16*)(ws + OFF_WOUT), 1024, 1024, nullptr, idn, idn, gtid, gsz);
  cvtw(P.in[37], 5632, (u16*)(ws + OFF_WUP), 5632, 1024, P.in[36],
       [](int n) { int t = n >> 7, w = n & 127; return w < 64 ? t * 64 + w : 2816 + t * 64 + (w - 64); }, idn, gtid, gsz);
  cvtw(P.in[40], 1024, (u16*)(ws + OFF_WDOWN), 1024, 2816, nullptr, idn, idn, gtid, gsz);
  cvtw(P.in[23], 512, (u16*)(ws + OFF_G2), 512, 128, nullptr, idn, idn, gtid, gsz);
  cvtw(P.in[16], 512, (u16*)(ws + OFF_W2F), 512, 64, nullptr, idn, idn, gtid, gsz);
  cvtw(P.in[20], 512, (u16*)(ws + OFF_W2B), 512, 64, nullptr, idn, idn, gtid, gsz);
  cvtw(P.in[18], 512, (u16*)(ws + OFF_A2F), 512, 64, nullptr, idn, idn, gtid, gsz);
  cvtw(P.in[22], 512, (u16*)(ws + OFF_A2B), 512, 64, nullptr, idn, idn, gtid, gsz);
}

__device__ __forceinline__ void norm_row(const float* __restrict__ src, u16* __restrict__ dst) {
  const int lane = threadIdx.x & 63;
  float4 v0 = *(const float4*)(src + lane * 4);
  float4 v1 = *(const float4*)(src + 256 + lane * 4);
  float4 v2 = *(const float4*)(src + 512 + lane * 4);
  float4 v3 = *(const float4*)(src + 768 + lane * 4);
  float ss = v0.x * v0.x + v0.y * v0.y + v0.z * v0.z + v0.w * v0.w + v1.x * v1.x + v1.y * v1.y + v1.z * v1.z +
             v1.w * v1.w + v2.x * v2.x + v2.y * v2.y + v2.z * v2.z + v2.w * v2.w + v3.x * v3.x + v3.y * v3.y +
             v3.z * v3.z + v3.w * v3.w;
  ss = wave_sum(ss);
  float r = rsqrtf(ss * (1.f / 1024.f) + 1e-6f);
  uint2 o;
  o.x = pack2(v0.x * r, v0.y * r); o.y = pack2(v0.z * r, v0.w * r); *(uint2*)(dst + lane * 4) = o;
  o.x = pack2(v1.x * r, v1.y * r); o.y = pack2(v1.z * r, v1.w * r); *(uint2*)(dst + 256 + lane * 4) = o;
  o.x = pack2(v2.x * r, v2.y * r); o.y = pack2(v2.z * r, v2.w * r); *(uint2*)(dst + 512 + lane * 4) = o;
  o.x = pack2(v3.x * r, v3.y * r); o.y = pack2(v3.z * r, v3.w * r); *(uint2*)(dst + 768 + lane * 4) = o;
}

__device__ __forceinline__ void phase0b(const Params& P) {
  const int wave = threadIdx.x >> 6;
  u16* H = (u16*)(P.ws + OFF_H);
  u16* MH = (u16*)(P.ws + OFF_MH);
  for (int row = blockIdx.x * 4 + wave; row < NT + NMEMROWS; row += gridDim.x * 4) {
    if (row < NT) {
      const float* src = row < NTP ? P.in[0] + (size_t)row * 1024 : P.in[1] + (size_t)(row - NTP) * 1024;
      norm_row(src, H + (size_t)row * 1024);
    } else {
      int mr = row - NT;
      const float* src = mr < 8192 ? P.in[2] + (size_t)mr * 1024 : P.in[3] + (size_t)(mr - 8192) * 1024;
      norm_row(src, MH + (size_t)mr * 1024);
    }
  }
}

__device__ __forceinline__ void phase1(const Params& P, u16* lds) {
  unsigned char* ws = P.ws;
  const u16* H = (const u16*)(ws + OFF_H);
  const u16* Win = (const u16*)(ws + OFF_WIN);
  u16* CQKV = (u16*)(ws + OFF_CQKV);
  u16* RW = (u16*)(ws + OFF_RW);
  u16* XQ = (u16*)(ws + OFF_XQ);
  for (int kk_ = 0;; kk_++) {
    int mt, nt;
    if (!tile_map(kk_, 768, 25, mt, nt)) break;
    Acc acc; acc_zero(acc);
    {
      int m0 = mt * 128, n0 = nt * 128;
      gemm_lin(acc, lds, H + (size_t)m0 * 1024, 1024, Win + (size_t)n0 * 1024, 1024, 1024);
      epi_each(acc, [&](int r0, int c, float v0, float v1, float v2, float v3) {
        int n = n0 + c;
        u16* dst; int ld;
        if (n < 640) { dst = CQKV + n; ld = 672; }
        else if (n < 2560) { dst = RW + (n - 640); ld = 1920; }
        else if (n < 3072) { dst = XQ + (n - 2560); ld = 512; }
        else if (n < 3104) { dst = CQKV + 640 + (n - 3072); ld = 672; }
        else return;
        size_t row = (size_t)(m0 + r0);
        dst[row * ld] = f2bf(v0); dst[(row + 1) * ld] = f2bf(v1); dst[(row + 2) * ld] = f2bf(v2); dst[(row + 3) * ld] = f2bf(v3);
      });
    }
  }
  for (int i2 = blockIdx.x; i2 < 72 * 8; i2 += gridDim.x) {
    Acc acc; acc_zero(acc);
    {
      int mt = i2 / 8, nt = i2 % 8;
      int m0 = mt * 128, n0 = nt * 128;
      gemm_lin(acc, lds, (const u16*)(ws + OFF_MH) + (size_t)m0 * 1024, 1024, (const u16*)(ws + OFF_WMKV) + (size_t)n0 * 1024, 1024, 1024);
      u16* MKV = (u16*)(ws + OFF_MKV);
      epi_each(acc, [&](int r0, int c, float v0, float v1, float v2, float v3) {
        u16* dst = MKV + (size_t)(m0 + r0) * 1024 + n0 + c;
        dst[0] = f2bf(v0); dst[1024] = f2bf(v1); dst[2048] = f2bf(v2); dst[3072] = f2bf(v3);
      });
    }
  }
}

__device__ __forceinline__ void phase2(const Params& P, u16* lds) {
  unsigned char* ws = P.ws;
  const u16* CQKV = (const u16*)(ws + OFF_CQKV);
  u16* Q = (u16*)((unsigned char*)P.out + DO_Q);
  u16* Kb = (u16*)((unsigned char*)P.out + DO_K);
  u16* Vt = (u16*)((unsigned char*)P.out + DO_VT);
  __shared__ float rstd_s[128];
  const int tid = threadIdx.x;
  for (int it = blockIdx.x; it < 768 * 14; it += gridDim.x) {
    int mt = it / 14, nt = it % 14;
    int m0 = mt * 128;
    const bool isq = nt < 6;
    {
      int r = tid >> 1, hf = tid & 1;
      const u16* src = CQKV + (size_t)(m0 + r) * 672 + (isq ? hf * 192 : 384 + hf * 128);
      int nch = isq ? 24 : 16;
      float ss = 0.f;
      for (int c = 0; c < nch; c++) {
        uint4 u = *(const uint4*)(src + c * 8);
        float a;
        a = bflo(u.x); ss += a * a; a = bfhi(u.x); ss += a * a;
        a = bflo(u.y); ss += a * a; a = bfhi(u.y); ss += a * a;
        a = bflo(u.z); ss += a * a; a = bfhi(u.z); ss += a * a;
        a = bflo(u.w); ss += a * a; a = bfhi(u.w); ss += a * a;
      }
      ss += dppf<0xB1>(ss);
      if (hf == 0) rstd_s[r] = rsqrtf(ss / (isq ? 384.f : 256.f) + 1e-6f);
    }
    __syncthreads();
    Acc acc; acc_zero(acc);
    if (isq) {
      int n0 = nt * 128;
      gemm_lin(acc, lds, CQKV + (size_t)m0 * 672, 672, (const u16*)(ws + OFF_WUQ) + (size_t)n0 * 384, 384, 384);
      epi_each(acc, [&](int r0, int c, float v0, float v1, float v2, float v3) {
        u16* dst = Q + (size_t)(m0 + r0) * 768 + n0 + c;
        dst[0] = f2bf(v0 * rstd_s[r0]); dst[768] = f2bf(v1 * rstd_s[r0 + 1]);
        dst[1536] = f2bf(v2 * rstd_s[r0 + 2]); dst[2304] = f2bf(v3 * rstd_s[r0 + 3]);
      });
    } else {
      int head = nt - 6;
      int n0 = head * 128;
      gemm_lin(acc, lds, CQKV + (size_t)m0 * 672 + 384, 672, (const u16*)(ws + OFF_WUKV) + (size_t)n0 * 256, 256, 256);
      int seq, start, T;
      tok_seq(m0, seq, start, T);
      u16* vtb = Vt + vt_base(seq) + (size_t)head * 64 * T + (m0 - start);
      epi_each(acc, [&](int r0, int c, float v0, float v1, float v2, float v3) {
        v0 *= rstd_s[r0]; v1 *= rstd_s[r0 + 1]; v2 *= rstd_s[r0 + 2]; v3 *= rstd_s[r0 + 3];
        if (c < 64) {
          u16* dst = Kb + (size_t)(m0 + r0) * 768 + head * 96 + c;
          dst[0] = f2bf(v0); dst[768] = f2bf(v1); dst[1536] = f2bf(v2); dst[2304] = f2bf(v3);
        } else {
          uint2 o; o.x = pack2(v0, v1); o.y = pack2(v2, v3);
          *(uint2*)(vtb + (size_t)(c - 64) * T + r0) = o;
        }
      });
    }
    __syncthreads();
  }
}

__device__ __forceinline__ void phase3(const Params& P) {
  unsigned char* ws = P.ws;
  const u16* CQKV = (const u16*)(ws + OFF_CQKV);
  u16* Kb = (u16*)((unsigned char*)P.out + DO_K);
  const float* gk = P.in[11];
  const int tid = threadIdx.x;
  const int sub = tid >> 4, i = tid & 15;
  const float inv = powf(10000.f, -(float)i / 16.f);
  const float g0 = gk[4 * i], g1 = gk[4 * i + 1], g2 = gk[4 * i + 2], g3 = gk[4 * i + 3], gr1 = gk[64 + i], gr2 = gk[80 + i];
  for (long pr = (long)blockIdx.x * 16 + sub; pr < (long)NT * 8; pr += (long)gridDim.x * 16) {
    int tok = (int)(pr >> 3), head = (int)(pr & 7);
    u16* kp = Kb + (size_t)tok * 768 + head * 96;
    uint2 u = *(const uint2*)(kp + 4 * i);
    float a0 = bflo(u.x), a1 = bfhi(u.x), a2 = bflo(u.y), a3 = bfhi(u.y);
    float x1 = bf2f(CQKV[(size_t)tok * 672 + 640 + i]);
    float x2 = bf2f(CQKV[(size_t)tok * 672 + 656 + i]);
    float ss = a0 * a0 + a1 * a1 + a2 * a2 + a3 * a3 + x1 * x1 + x2 * x2;
    ss = sum16(ss);
    float r = rsqrtf(ss * (1.f / 96.f) + 1e-6f);
    int seq, start, T;
    tok_seq(tok, seq, start, T);
    float ang = (float)(tok - start) * inv;
    float sn, cs;
    sincosf(ang, &sn, &cs);
    x1 *= r * gr1; x2 *= r * gr2;
    uint2 o; o.x = pack2(a0 * r * g0, a1 * r * g1); o.y = pack2(a2 * r * g2, a3 * r * g3);
    *(uint2*)(kp + 4 * i) = o;
    kp[64 + i] = f2bf(x1 * cs - x2 * sn);
    kp[80 + i] = f2bf(x2 * cs + x1 * sn);
  }
  const u16* MKV = (const u16*)(ws + OFF_MKV);
  u16* MK = (u16*)(ws + OFF_MK);
  u16* MVT = (u16*)(ws + OFF_MVT);
  const float* gxk = P.in[33];
  for (int pr = blockIdx.x * 16 + sub; pr < NMEMROWS * 4; pr += gridDim.x * 16) {
    int row = pr >> 2, head = pr & 3;
    int b = row >> 8, key = row & 255;
    uint4 u = *(const uint4*)(MKV + (size_t)row * 1024 + head * 256 + 8 * i);
    float a0 = bflo(u.x), a1 = bfhi(u.x), a2 = bflo(u.y), a3 = bfhi(u.y), a4 = bflo(u.z), a5 = bfhi(u.z), a6 = bflo(u.w), a7 = bfhi(u.w);
    float ss = a0 * a0 + a1 * a1 + a2 * a2 + a3 * a3 + a4 * a4 + a5 * a5 + a6 * a6 + a7 * a7;
    ss = sum16(ss);
    float r = rsqrtf(ss * (1.f / 128.f) + 1e-6f);
    const float* g = gxk + 8 * i;
    uint4 o;
    o.x = pack2(a0 * r * g[0], a1 * r * g[1]); o.y = pack2(a2 * r * g[2], a3 * r * g[3]);
    o.z = pack2(a4 * r * g[4], a5 * r * g[5]); o.w = pack2(a6 * r * g[6], a7 * r * g[7]);
    *(uint4*)(MK + ((size_t)(b * 4 + head) * 256 + key) * 128 + 8 * i) = o;
  }
  for (long e = (long)blockIdx.x * NTHREADS + tid; e < (long)NMEMROWS * 512; e += (long)gridDim.x * NTHREADS) {
    int row = (int)(e >> 9), c = (int)(e & 511);
    int head = c >> 7, dv = c & 127;
    int b = row >> 8, key = row & 255;
    MVT[((size_t)(b * 4 + head) * 128 + dv) * 256 + key] = MKV[(size_t)row * 1024 + head * 256 + 128 + dv];
  }
}

template <int DQK, int DV, bool ROPE, bool PREF>
__device__ __forceinline__ void attn_item(u16* lds, const u16* Qp, long qld, const u16* Kp, long kld, const u16* Vtp, long vld,
                          int nkeys, const float* __restrict__ gq, float qscale, int tpos0, u16* Op, long old) {
  constexpr int KP = DQK + 8;
  constexpr int KT = 64 * KP;
  constexpr int VT = DV * 72;
  constexpr int BUF = KT + VT;
  constexpr int NS = DQK / 16;
  constexpr int ND = DV / 32;
  constexpr int KCH = DQK / 8;
  constexpr int NKC = 64 * KCH / 256;
  constexpr int NVC = DV * 8 / 256;
  const int tid = threadIdx.x, lane = tid & 63, wave = tid >> 6, h = lane >> 5, lr = lane & 31;

  bf16x8 qf[NS];
  {
    const u16* qp = Qp + (long)(32 * wave + lr) * qld + 8 * h;
    float qv[NS][8];
    float ss = 0.f;
#pragma unroll
    for (int s = 0; s < NS; s++) {
      uint4 u = *(const uint4*)(qp + 16 * s);
      qv[s][0] = bflo(u.x); qv[s][1] = bfhi(u.x); qv[s][2] = bflo(u.y); qv[s][3] = bfhi(u.y);
      qv[s][4] = bflo(u.z); qv[s][5] = bfhi(u.z); qv[s][6] = bflo(u.w); qv[s][7] = bfhi(u.w);
#pragma unroll
      for (int j = 0; j < 8; j++) ss += qv[s][j] * qv[s][j];
    }
    ss += __shfl_xor(ss, 32);
    float r = rsqrtf(ss * (1.f / DQK) + 1e-6f);
#pragma unroll
    for (int s = 0; s < NS; s++)
#pragma unroll
      for (int j = 0; j < 8; j++) qv[s][j] *= r * gq[16 * s + 8 * h + j];
    if (ROPE) {
      float t = (float)(tpos0 + 32 * wave + lr);
#pragma unroll
      for (int j = 0; j < 8; j++) {
        float inv = powf(10000.f, -(float)(8 * h + j) / 16.f);
        float sn, cs;
        sincosf(t * inv, &sn, &cs);
        float x1 = qv[NS - 2][j], x2 = qv[NS - 1][j];
        qv[NS - 2][j] = x1 * cs - x2 * sn;
        qv[NS - 1][j] = x2 * cs + x1 * sn;
      }
    }
#pragma unroll
    for (int s = 0; s < NS; s++) {
      uint4 u;
      u.x = pack2(qv[s][0] * qscale, qv[s][1] * qscale); u.y = pack2(qv[s][2] * qscale, qv[s][3] * qscale);
      u.z = pack2(qv[s][4] * qscale, qv[s][5] * qscale); u.w = pack2(qv[s][6] * qscale, qv[s][7] * qscale);
      qf[s] = *(bf16x8*)&u;
    }
  }

  f32x16 o[ND];
#pragma unroll
  for (int d = 0; d < ND; d++)
#pragma unroll
    for (int r = 0; r < 16; r++) o[d][r] = 0.f;
  float lsum = 0.f;

  uint4 rk[NKC], rv[NVC];
  const int nkt = nkeys >> 6;
#define AGLOAD(kt)                                                                           \
  {                                                                                          \
    _Pragma("unroll") for (int i = 0; i < NKC; i++) {                                        \
      int c = tid + 256 * i; int row = c / KCH, kc = c % KCH;                                \
      rk[i] = *(const uint4*)(Kp + (long)((kt) * 64 + row) * kld + kc * 8);                  \
    }                                                                                        \
    _Pragma("unroll") for (int i = 0; i < NVC; i++) {                                        \
      int c = tid + 256 * i; int row = c >> 3, kc = c & 7;                                   \
      rv[i] = *(const uint4*)(Vtp + (long)row * vld + (kt) * 64 + kc * 8);                   \
    }                                                                                        \
  }
#define ASTORE(b)                                                                            \
  {                                                                                          \
    u16* Kl = lds + (b) * BUF; u16* Vl = Kl + KT;                                            \
    _Pragma("unroll") for (int i = 0; i < NKC; i++) {                                        \
      int c = tid + 256 * i; int row = c / KCH, kc = c % KCH;                                \
      *(uint4*)(Kl + row * KP + kc * 8) = rk[i];                                             \
    }                                                                                        \
    _Pragma("unroll") for (int i = 0; i < NVC; i++) {                                        \
      int c = tid + 256 * i; int row = c >> 3, kc = c & 7;                                   \
      *(uint4*)(Vl + row * 72 + kc * 8) = rv[i];                                             \
    }                                                                                        \
  }
  AGLOAD(0)
  ASTORE(0)
  __syncthreads();
  for (int kt = 0; kt < nkt; kt++) {
    if (PREF) { if (kt + 1 < nkt) AGLOAD(kt + 1) }
    else { if (kt + 1 < nkt) { AGLOAD(kt + 1) ASTORE((kt + 1) & 1) } }
    const u16* Kl = lds + (kt & 1) * BUF;
    const u16* Vl = Kl + KT;
#pragma unroll
    for (int ks = 0; ks < 2; ks++) {
      f32x16 st;
#pragma unroll
      for (int r = 0; r < 16; r++) st[r] = 0.f;
      const u16* kr = Kl + (32 * ks + lr) * KP + 8 * h;
#pragma unroll
      for (int s = 0; s < NS; s++) {
        bf16x8 kf = *(const bf16x8*)(kr + 16 * s);
        st = __builtin_amdgcn_mfma_f32_32x32x16_bf16(kf, qf[s], st, 0, 0, 0);
      }
      float p[16];
#pragma unroll
      for (int r = 0; r < 16; r++) { p[r] = __builtin_amdgcn_exp2f(st[r]); lsum += p[r]; }
#pragma unroll
      for (int s2 = 0; s2 < 2; s2++) {
        uint4 u;
        u.x = pack2(p[8 * s2 + 0], p[8 * s2 + 1]); u.y = pack2(p[8 * s2 + 2], p[8 * s2 + 3]);
        u.z = pack2(p[8 * s2 + 4], p[8 * s2 + 5]); u.w = pack2(p[8 * s2 + 6], p[8 * s2 + 7]);
        bf16x8 pb = *(bf16x8*)&u;
#pragma unroll
        for (int d = 0; d < ND; d++) {
          const u16* vr = Vl + (32 * d + lr) * 72 + 32 * ks + 16 * s2 + 4 * h;
          uint2 v0 = *(const uint2*)(vr);
          uint2 v1 = *(const uint2*)(vr + 8);
          uint4 vv; vv.x = v0.x; vv.y = v0.y; vv.z = v1.x; vv.w = v1.y;
          bf16x8 vf = *(bf16x8*)&vv;
          o[d] = __builtin_amdgcn_mfma_f32_32x32x16_bf16(vf, pb, o[d], 0, 0, 0);
        }
      }
    }
    if (PREF) { if (kt + 1 < nkt) ASTORE((kt + 1) & 1) }
    __syncthreads();
  }
#undef AGLOAD
#undef ASTORE
  lsum += __shfl_xor(lsum, 32);
  float il = 1.f / lsum;
  u16* op = Op + (long)(32 * wave + lr) * old;
#pragma unroll
  for (int d = 0; d < ND; d++)
#pragma unroll
    for (int g = 0; g < 4; g++) {
      uint2 u;
      u.x = pack2(o[d][4 * g] * il, o[d][4 * g + 1] * il);
      u.y = pack2(o[d][4 * g + 2] * il, o[d][4 * g + 3] * il);
      *(uint2*)(op + 32 * d + 8 * g + 4 * h) = u;
    }
}

typedef __attribute__((ext_vector_type(2))) float f32x2;
constexpr int SC_OP = 2048;
constexpr int SC_WR = 0, SC_KK = SC_OP, SC_WD = 2 * SC_OP, SC_KD = 3 * SC_OP, SC_BB = 4 * SC_OP;
constexpr int SC_R = SC_WR, SC_K = SC_KK, SC_LW = SC_WD, SC_LA = SC_KD;
constexpr int SC_V = 5 * SC_OP, SC_BR = SC_V + 2048, SC_CKR = SC_BR + 32, SC_Y = SC_CKR + 32;
constexpr int SC_END = SC_Y + 2048;
constexpr int SC_TW_B = SC_END * 4;
constexpr int SC_AL_B = SC_TW_B + 32 * 72 * 2;
static_assert(SC_AL_B + 32 * 72 * 2 + 960 * 4 <= LDS_BYTES, "scan lds");

__device__ __forceinline__ float fexp(float x) { return __builtin_amdgcn_exp2f(x * 1.4426950408889634f); }
__device__ __forceinline__ float frcp(float x) { return __builtin_amdgcn_rcpf(x); }
__device__ __forceinline__ float ftanh(float x) { return 1.f - 2.f * frcp(1.f + fexp(2.f * x)); }
__device__ __forceinline__ float fsigm(float x) { return frcp(1.f + fexp(-x)); }

struct Raw3 { uint4 c, a, b; };
__device__ __forceinline__ Raw3 ld3(const u16* __restrict__ p, bool hp, bool hn) {
  Raw3 r;
  r.c = *(const uint4*)p;
  r.a = hp ? *(const uint4*)(p - 1920) : make_uint4(0, 0, 0, 0);
  r.b = hn ? *(const uint4*)(p + 1920) : make_uint4(0, 0, 0, 0);
  return r;
}
__device__ __forceinline__ void mixr(const Raw3& r, const float* __restrict__ mp, const float* __restrict__ mn, float* out) {
  float cc[8] = {bflo(r.c.x), bfhi(r.c.x), bflo(r.c.y), bfhi(r.c.y), bflo(r.c.z), bfhi(r.c.z), bflo(r.c.w), bfhi(r.c.w)};
  float aa[8] = {bflo(r.a.x), bfhi(r.a.x), bflo(r.a.y), bfhi(r.a.y), bflo(r.a.z), bfhi(r.a.z), bflo(r.a.w), bfhi(r.a.w)};
  float bb[8] = {bflo(r.b.x), bfhi(r.b.x), bflo(r.b.y), bfhi(r.b.y), bflo(r.b.z), bfhi(r.b.z), bflo(r.b.w), bfhi(r.b.w)};
#pragma unroll
  for (int j = 0; j < 8; j++) out[j] = cc[j] + mp[j] * (aa[j] - cc[j]) + mn[j] * (bb[j] - cc[j]);
}
__device__ __forceinline__ void mix8(const u16* __restrict__ p, bool hp, bool hn, const float* __restrict__ mp,
                                     const float* __restrict__ mn, float* out) {
  Raw3 r = ld3(p, hp, hn);
  mixr(r, mp, mn, out);
}

template <int NRG>
__device__ __forceinline__ void scan_item(const Params& P, unsigned char* ldsb, int seq, int head, int dir, int rg) {
  float* L = (float*)ldsb;
  u16* TWb = (u16*)(ldsb + SC_TW_B);
  u16* ALb = (u16*)(ldsb + SC_AL_B);
  unsigned char* ws = P.ws;
  const u16* RW = (const u16*)(ws + OFF_RW);
  u16* Y = (u16*)(ws + (dir ? OFF_YB : OFF_YF));
  const float* w0 = dir ? P.in[19] : P.in[15];
  const float* a0 = dir ? P.in[21] : P.in[17];
  const u16* w2t = (const u16*)(ws + (dir ? OFF_W2B : OFF_W2F));
  const u16* a2t = (const u16*)(ws + (dir ? OFF_A2B : OFF_A2F));
  const int T = seq < 32 ? 2048 : 8192;
  const int start = seq < 32 ? seq * 2048 : NTP + (seq - 32) * 8192;
  const int tid = threadIdx.x, lane = tid & 63, wave = tid >> 6;
  const int hc = head * 64;
  const int pt = tid >> 3, pc = (tid & 7) * 8;
  const int wlo = dir ? 1600 : 1536, alo = dir ? 1728 : 1664;
  float* CS = (float*)(ldsb + SC_AL_B + 32 * 72 * 2);
  for (int i = tid; i < 960; i += NTHREADS) {
    const int arr = i >> 6, c = i & 63;
    const float* src;
    switch (arr) {
      case 0: src = P.in[13] + hc; break;
      case 1: src = P.in[14] + hc; break;
      case 2: src = P.in[13] + 512 + hc; break;
      case 3: src = P.in[14] + 512 + hc; break;
      case 4: src = P.in[13] + 1024 + hc; break;
      case 5: src = P.in[14] + 1024 + hc; break;
      case 6: src = P.in[13] + wlo; break;
      case 7: src = P.in[14] + wlo; break;
      case 8: src = P.in[13] + alo; break;
      case 9: src = P.in[14] + alo; break;
      case 10: src = w0 + hc; break;
      case 11: src = a0 + hc; break;
      case 12: src = P.in[24] + hc; break;
      case 13: src = P.in[25] + hc; break;
      default: src = P.in[26] + hc; break;
    }
    CS[i] = src[c];
  }
  __syncthreads();
  const float *mpr = CS + pc, *mnr = CS + 64 + pc, *mpk = CS + 128 + pc, *mnk = CS + 192 + pc, *mpv = CS + 256 + pc,
              *mnv = CS + 320 + pc, *mpw = CS + 384 + pc, *mnw = CS + 448 + pc, *mpa = CS + 512 + pc, *mna = CS + 576 + pc,
              *cw0 = CS + 640 + pc, *ca0 = CS + 704 + pc, *ckk = CS + 768 + pc, *cka = CS + 832 + pc, *crk = CS + 896 + pc;
  const int rp = tid >> 3, seg = tid & 7;
  f32x2 st[8];
#pragma unroll
  for (int k = 0; k < 8; k++) st[k] = (f32x2){0.f, 0.f};
  const int nch = T >> 5;
  Raw3 g_r, g_k, g_v, g_w, g_a;
#define SLOAD(chn)                                                                     \
  {                                                                                    \
    const int t0_ = dir ? T - 32 * ((chn) + 1) : 32 * (chn);                           \
    const int t_ = t0_ + pt;                                                           \
    const bool hp_ = t_ > 0, hn_ = t_ < T - 1;                                         \
    const u16* base_ = RW + (size_t)(start + t_) * 1920;                               \
    g_r = ld3(base_ + hc + pc, hp_, hn_); g_k = ld3(base_ + 512 + hc + pc, hp_, hn_);  \
    g_v = ld3(base_ + 1024 + hc + pc, hp_, hn_); g_w = ld3(base_ + wlo + pc, hp_, hn_); \
    g_a = ld3(base_ + alo + pc, hp_, hn_);                                             \
  }
  SLOAD(0)
  for (int ch = 0; ch < nch; ch++) {
    const int t0 = dir ? T - 32 * (ch + 1) : 32 * ch;
    bf16x8 lb0, lb1, lb2, lb3;
    {
      const int mat = wave >> 1, ntile = wave & 1;
      const u16* Bsrc = (mat ? a2t : w2t) + (size_t)(hc + 32 * ntile + (lane & 31)) * 64 + 8 * (lane >> 5);
      lb0 = *(const bf16x8*)(Bsrc); lb1 = *(const bf16x8*)(Bsrc + 16); lb2 = *(const bf16x8*)(Bsrc + 32); lb3 = *(const bf16x8*)(Bsrc + 48);
    }
    {
      float v[8];
      mixr(g_r, mpr, mnr, v);
#pragma unroll
      for (int j = 0; j < 8; j++) L[SC_R + pt * 64 + pc + j] = v[j];
      mixr(g_k, mpk, mnk, v);
#pragma unroll
      for (int j = 0; j < 8; j++) L[SC_K + pt * 64 + pc + j] = v[j];
      mixr(g_v, mpv, mnv, v);
#pragma unroll
      for (int j = 0; j < 8; j++) L[SC_V + pt * 64 + pc + j] = v[j];
      mixr(g_w, mpw, mnw, v);
      uint4 u;
      u.x = pack2(ftanh(v[0]), ftanh(v[1])); u.y = pack2(ftanh(v[2]), ftanh(v[3]));
      u.z = pack2(ftanh(v[4]), ftanh(v[5])); u.w = pack2(ftanh(v[6]), ftanh(v[7]));
      *(uint4*)(TWb + pt * 72 + pc) = u;
      mixr(g_a, mpa, mna, v);
      u.x = pack2(v[0], v[1]); u.y = pack2(v[2], v[3]); u.z = pack2(v[4], v[5]); u.w = pack2(v[6], v[7]);
      *(uint4*)(ALb + pt * 72 + pc) = u;
    }
    __syncthreads();
    {
      const int mat = wave >> 1, ntile = wave & 1;
      const u16* Asrc = (mat ? ALb : TWb) + (lane & 31) * 72 + 8 * (lane >> 5);
      f32x16 c;
#pragma unroll
      for (int r = 0; r < 16; r++) c[r] = 0.f;
      c = __builtin_amdgcn_mfma_f32_32x32x16_bf16(*(const bf16x8*)(Asrc), lb0, c, 0, 0, 0);
      c = __builtin_amdgcn_mfma_f32_32x32x16_bf16(*(const bf16x8*)(Asrc + 16), lb1, c, 0, 0, 0);
      c = __builtin_amdgcn_mfma_f32_32x32x16_bf16(*(const bf16x8*)(Asrc + 32), lb2, c, 0, 0, 0);
      c = __builtin_amdgcn_mfma_f32_32x32x16_bf16(*(const bf16x8*)(Asrc + 48), lb3, c, 0, 0, 0);
      float* dst = L + (mat ? SC_LA : SC_LW);
#pragma unroll
      for (int r = 0; r < 16; r++) {
        int tr = (r & 3) + 8 * (r >> 2) + 4 * (lane >> 5);
        dst[tr * 64 + 32 * ntile + (lane & 31)] = c[r];
      }
    }
    __syncthreads();
    {
      float ssk = 0.f, br = 0.f, kr = 0.f, bon = 0.f;
      float kkr[8], av[8], kdv[8], rr[8], dec[8];
#pragma unroll
      for (int j = 0; j < 8; j++) {
        int o = pt * 64 + pc + j;
        float r = L[SC_R + o], k = L[SC_K + o];
        float wp = cw0[j] + L[SC_LW + o];
        float z = -wp;
        float sp = z > 15.f ? z : 0.6931471805599453f * __builtin_amdgcn_logf(1.f + fexp(z));
        float w = -sp - 0.5f;
        dec[j] = fexp(-fexp(w));
        float a = fsigm(ca0[j] + L[SC_LA + o]);
        av[j] = a;
        kkr[j] = k * ckk[j];
        ssk += kkr[j] * kkr[j];
        kdv[j] = k * (1.f + (a - 1.f) * cka[j]);
        rr[j] = r;
        kr += kdv[j] * r;
        bon += r * kdv[j] * crk[j];
      }
      ssk = sum8(ssk);
      float inrm = __builtin_amdgcn_rsqf(fmaxf(ssk, 1e-24f));
#pragma unroll
      for (int j = 0; j < 8; j++) {
        float kk = kkr[j] * inrm;
        float b = kk * av[j];
        br += b * rr[j];
        int o = pt * 64 + pc + j;
        L[SC_KK + o] = kk;
        L[SC_BB + o] = b;
        L[SC_WR + o] = dec[j] * rr[j];
        L[SC_WD + o] = dec[j];
        L[SC_KD + o] = kdv[j];
      }
      br = sum8(br); kr = sum8(kr); bon = sum8(bon);
      if ((tid & 7) == 0) { L[SC_BR + pt] = br; L[SC_CKR + pt] = kr + bon; }
    }
    __syncthreads();
    if (ch + 1 < nch) SLOAD(ch + 1)
    {
#pragma unroll 1
      for (int qo = 0; qo < 4; qo++) {
        f32x2 yk = (f32x2){0.f, 0.f};
#pragma unroll
        for (int qi = 0; qi < 8; qi++) {
          const int q = qo * 8 + qi;
          const int tt = dir ? 31 - q : q;
          const float* ob = L + tt * 64 + 8 * seg;
          float4 kka = *(const float4*)(ob + SC_KK), kkb = *(const float4*)(ob + SC_KK + 4);
          float4 wra = *(const float4*)(ob + SC_WR), wrb = *(const float4*)(ob + SC_WR + 4);
          float4 wda = *(const float4*)(ob + SC_WD), wdb = *(const float4*)(ob + SC_WD + 4);
          float4 bba = *(const float4*)(ob + SC_BB), bbb = *(const float4*)(ob + SC_BB + 4);
          float4 kda = *(const float4*)(ob + SC_KD), kdb = *(const float4*)(ob + SC_KD + 4);
          float br = L[SC_BR + tt], ckr = L[SC_CKR + tt];
          float kk[8] = {kka.x, kka.y, kka.z, kka.w, kkb.x, kkb.y, kkb.z, kkb.w};
          float wr[8] = {wra.x, wra.y, wra.z, wra.w, wrb.x, wrb.y, wrb.z, wrb.w};
          float wd[8] = {wda.x, wda.y, wda.z, wda.w, wdb.x, wdb.y, wdb.z, wdb.w};
          float bb[8] = {bba.x, bba.y, bba.z, bba.w, bbb.x, bbb.y, bbb.z, bbb.w};
          float kd[8] = {kda.x, kda.y, kda.z, kda.w, kdb.x, kdb.y, kdb.z, kdb.w};
          if (NRG == 1) {
            float2 vv = *(const float2*)(L + SC_V + tt * 64 + 2 * rp);
            f32x2 v2 = (f32x2){vv.x, vv.y};
            f32x2 p1 = st[0] * kk[0], p2 = st[0] * wr[0];
#pragma unroll
            for (int k = 1; k < 8; k++) { p1 += st[k] * kk[k]; p2 += st[k] * wr[k]; }
            p1.x = sum8(p1.x); p1.y = sum8(p1.y); p2.x = sum8(p2.x); p2.y = sum8(p2.y);
            f32x2 y2 = p2 - p1 * br + v2 * ckr;
            if (qi == seg) yk = y2;
#pragma unroll
            for (int k = 0; k < 8; k++) st[k] = st[k] * wd[k] - p1 * bb[k] + v2 * kd[k];
          } else {
            const float v = L[SC_V + tt * 64 + 32 * rg + rp];
            f32x2 q1 = st[0] * (f32x2){kk[0], kk[1]}, q2 = st[0] * (f32x2){wr[0], wr[1]};
#pragma unroll
            for (int i = 1; i < 4; i++) {
              q1 += st[i] * (f32x2){kk[2 * i], kk[2 * i + 1]};
              q2 += st[i] * (f32x2){wr[2 * i], wr[2 * i + 1]};
            }
            const float p1 = sum8(q1.x + q1.y), p2 = sum8(q2.x + q2.y);
            const float y = p2 - p1 * br + v * ckr;
            if (qi == seg) yk.x = y;
#pragma unroll
            for (int i = 0; i < 4; i++)
              st[i] = st[i] * (f32x2){wd[2 * i], wd[2 * i + 1]} - p1 * (f32x2){bb[2 * i], bb[2 * i + 1]} + v * (f32x2){kd[2 * i], kd[2 * i + 1]};
          }
        }
        {
          const int q = qo * 8 + seg;
          const int tt = dir ? 31 - q : q;
          if (NRG == 1) *(float2*)(L + SC_Y + tt * 64 + 2 * rp) = make_float2(yk.x, yk.y);
          else L[SC_Y + tt * 64 + 32 * rg + rp] = yk.x;
        }
      }
    }
    __syncthreads();
    if (NRG == 1 || (pc >> 5) == rg) {
      const float* yp = L + SC_Y + pt * 64 + pc;
      uint4 u;
      u.x = pack2(yp[0], yp[1]); u.y = pack2(yp[2], yp[3]); u.z = pack2(yp[4], yp[5]); u.w = pack2(yp[6], yp[7]);
      *(uint4*)(Y + (size_t)(start + t0 + pt) * 512 + hc + pc) = u;
    }
  }
#undef SLOAD
}

__device__ __forceinline__ void phase4(const Params& P, unsigned char* ldsb) {
  __shared__ int s_item;
  unsigned* ctr = (unsigned*)(P.ws + OFF_CTL);
  u16* lds = (u16*)ldsb;
  u16* Q = (u16*)((unsigned char*)P.out + DO_Q);
  const u16* Kb = (const u16*)((unsigned char*)P.out + DO_K);
  const u16* Vt = (const u16*)((unsigned char*)P.out + DO_VT);
  u16* XQ = (u16*)(P.ws + OFF_XQ);
  const u16* MK = (const u16*)(P.ws + OFF_MK);
  const u16* MVT = (const u16*)(P.ws + OFF_MVT);
  const int total = 128 + 512 * 13;
  const float LOG2E = 1.4426950408889634f;
  while (true) {
    __syncthreads();
    if (threadIdx.x == 0) s_item = (int)atomicAdd(ctr, 1u);
    __syncthreads();
    const int q = s_item;
    if (q >= total) break;
    int kind, idx;
    if (q < 128) { kind = 0; idx = q; }
    else if (q < 640) { kind = 1; idx = q - 128; }
    else if (q < 640 + 2048) { kind = 2; idx = q - 640; }
    else { kind = 3; idx = q - 2688; }
    if (kind == 0) {
      int rg = idx & 1, dir = (idx >> 1) & 1, head = (idx >> 2) & 7, sl = idx >> 5;
      scan_item<2>(P, ldsb, 32 + sl, head, dir, rg);
    } else if (kind == 1) {
      int dir = idx & 1, head = (idx >> 1) & 7, sl = idx >> 4;
      scan_item<1>(P, ldsb, sl, head, dir, 0);
    } else if (kind <= 3) {
      int seq, head, qb, T, start;
      if (kind == 2) { seq = 32 + (idx >> 9); head = (idx >> 6) & 7; qb = idx & 63; T = 8192; start = NTP + (seq - 32) * 8192; }
      else { seq = idx >> 7; head = (idx >> 4) & 7; qb = idx & 15; T = 2048; start = seq * 2048; }
      const size_t tok0 = (size_t)start + qb * 128;
      attn_item<96, 64, true, true>(lds, Q + tok0 * 768 + head * 96, 768, Kb + (size_t)start * 768 + head * 96, 768,
                              Vt + vt_base(seq) + (size_t)head * 64 * T, T, T, P.in[10],
                              0.10206207261596577f * LOG2E, qb * 128, Q + tok0 * 768 + head * 96, 768);
    }
  }
#ifdef SCANREP
  __syncthreads();
  for (int idx = blockIdx.x; idx < 576; idx += gridDim.x) {
    int dir = idx & 1, head = (idx >> 1) & 7, sl = idx >> 4;
    __syncthreads();
    scan_item<1>(P, ldsb, sl, head, dir, 0);
  }
#endif
  __syncthreads();
  for (int idx = blockIdx.x; idx < 3072; idx += gridDim.x) {
    int mt = idx >> 2, head = idx & 3;
    int seq, start, T;
    tok_seq(mt * 128, seq, start, T);
    const size_t tok0 = (size_t)mt * 128;
    attn_item<128, 128, false, false>(lds, XQ + tok0 * 512 + head * 128, 512, MK + (size_t)(seq * 4 + head) * 256 * 128, 128,
                                      MVT + (size_t)(seq * 4 + head) * 128 * 256, 256, 256, P.in[32],
                                      0.08838834764831845f * LOG2E, 0, XQ + tok0 * 512 + head * 128, 512);
  }
}

__device__ __forceinline__ void phase5(const Params& P, u16* lds) {
  __shared__ float st_mean[256], st_rstd[256];
  unsigned char* ws = P.ws;
  const u16* RW = (const u16*)(ws + OFF_RW);
  const u16* YF = (const u16*)(ws + OFF_YF);
  u16* YB = (u16*)(ws + OFF_YB);
  const u16* G2 = (const u16*)(ws + OFF_G2);
  const float* mup = P.in[13] + 1792;
  const float* mun = P.in[14] + 1792;
  const float* lng = P.in[27];
  const float* lnb = P.in[28];
  const int tid = threadIdx.x;
  for (int it = blockIdx.x; it < 768 * 4; it += gridDim.x) {
    int mt = it >> 2, nt = it & 3;
    int m0 = mt * 128, n0 = nt * 128;
    int seq, start, T;
    tok_seq(m0, seq, start, T);
    {
      int r = tid >> 1, hh = tid & 1;
      const u16* pf = YF + (size_t)(m0 + r) * 512 + n0 + hh * 64;
      const u16* pb = YB + (size_t)(m0 + r) * 512 + n0 + hh * 64;
      float sm = 0.f, sq = 0.f;
      for (int c = 0; c < 8; c++) {
        uint4 a = *(const uint4*)(pf + 8 * c), b = *(const uint4*)(pb + 8 * c);
        float y;
        y = bflo(a.x) + bflo(b.x); sm += y; sq += y * y; y = bfhi(a.x) + bfhi(b.x); sm += y; sq += y * y;
        y = bflo(a.y) + bflo(b.y); sm += y; sq += y * y; y = bfhi(a.y) + bfhi(b.y); sm += y; sq += y * y;
        y = bflo(a.z) + bflo(b.z); sm += y; sq += y * y; y = bfhi(a.z) + bfhi(b.z); sm += y; sq += y * y;
        y = bflo(a.w) + bflo(b.w); sm += y; sq += y * y; y = bfhi(a.w) + bfhi(b.w); sm += y; sq += y * y;
      }
      float mean = sm * (1.f / 64.f);
      float var = fmaxf(sq * (1.f / 64.f) - mean * mean, 0.f);
      st_mean[tid] = mean;
      st_rstd[tid] = rsqrtf(var + 64e-5f);
    }
    {
      const int lr = tid >> 3, lk = (tid & 7) * 8;
#pragma unroll
      for (int kb = 0; kb < 2; kb++) {
#pragma unroll
        for (int i = 0; i < 4; i++) {
          int r = lr + 32 * i;
          int t = m0 + r - start;
          float v[8];
          mix8(RW + (size_t)(m0 + r) * 1920 + 1792 + kb * 64 + lk, t > 0, t < T - 1, mup + kb * 64 + lk, mun + kb * 64 + lk, v);
          uint4 u;
          u.x = pack2(sigmoidf_(v[0]), sigmoidf_(v[1])); u.y = pack2(sigmoidf_(v[2]), sigmoidf_(v[3]));
          u.z = pack2(sigmoidf_(v[4]), sigmoidf_(v[5])); u.w = pack2(sigmoidf_(v[6]), sigmoidf_(v[7]));
          *(uint4*)(lds + kb * (2 * LTILE) + r * LROW + lk) = u;
          *(uint4*)(lds + kb * (2 * LTILE) + LTILE + r * LROW + lk) = *(const uint4*)(G2 + (size_t)(n0 + r) * 128 + kb * 64 + lk);
        }
      }
    }
    __syncthreads();
    Acc acc; acc_zero(acc);
    gemm_compute(acc, lds, 0);
    gemm_compute(acc, lds, 1);
    epi_each(acc, [&](int r0, int c, float v0, float v1, float v2, float v3) {
      int hh = c >> 6;
      float g = lng[n0 + c], b = lnb[n0 + c];
      float vv[4] = {v0, v1, v2, v3};
#pragma unroll
      for (int k = 0; k < 4; k++) {
        size_t o = (size_t)(m0 + r0 + k) * 512 + n0 + c;
        float y = bf2f(YF[o]) + bf2f(YB[o]);
        int si = (r0 + k) * 2 + hh;
        float yn = (y - st_mean[si]) * st_rstd[si] * g + b;
        YB[o] = f2bf(yn * vv[k]);
      }
    });
    __syncthreads();
  }
}

__device__ __forceinline__ void merge_branch(Acc& mg, u16* lds, const u16* Hrow, const u16* Wg_rows, const u16* Abr,
                                             const u16* Wbr, int Kb) {
  unsigned* G = (unsigned*)(lds + 2 * LTILE);
  {
    Acc acc; acc_zero(acc);
    gemm_lin<false, false>(acc, lds, Hrow, 1024, Wg_rows, 1024, 1024);
#pragma unroll
    for (int i = 0; i < 2; i++)
#pragma unroll
      for (int j = 0; j < 2; j++)
#pragma unroll
        for (int r = 0; r < 8; r++)
          G[((i * 2 + j) * 8 + r) * 256 + threadIdx.x] = pack2(sigmoidf_(acc.a[i][j][2 * r]), sigmoidf_(acc.a[i][j][2 * r + 1]));
  }
  Acc acc; acc_zero(acc);
  gemm_lin<true, false>(acc, lds, Abr, Kb, Wbr, Kb, Kb);
#pragma unroll
  for (int i = 0; i < 2; i++)
#pragma unroll
    for (int j = 0; j < 2; j++)
#pragma unroll
      for (int r = 0; r < 8; r++) {
        unsigned g = G[((i * 2 + j) * 8 + r) * 256 + threadIdx.x];
        mg.a[i][j][2 * r] += bflo(g) * acc.a[i][j][2 * r];
        mg.a[i][j][2 * r + 1] += bfhi(g) * acc.a[i][j][2 * r + 1];
      }
  __syncthreads();
}
__device__ __forceinline__ void phase6(const Params& P, u16* lds) {
  unsigned char* ws = P.ws;
  const u16* H = (const u16*)(ws + OFF_H);
  const u16* Wg = (const u16*)(ws + OFF_WIN) + (size_t)3200 * 1024;
  u16* MG = (u16*)(ws + OFF_MERGED);
  const u16* A0 = (const u16*)((unsigned char*)P.out + DO_Q);
  const u16* A1 = (const u16*)(ws + OFF_YB);
  const u16* A2 = (const u16*)(ws + OFF_XQ);
  const u16* W0 = (const u16*)(ws + OFF_WOA);
  const u16* W1 = (const u16*)(ws + OFF_WOB);
  const u16* W2 = (const u16*)(ws + OFF_WOC);
  for (int kk_ = 0;; kk_++) {
    int mt, nt;
    if (!tile_map(kk_, 768, 8, mt, nt)) break;
    int m0 = mt * 128, n0 = nt * 128;
    Acc mg; acc_zero(mg);
    const u16* Hrow = H + (size_t)m0 * 1024;
#pragma nounroll
    for (int br = 0; br < 3; br++) {
      const u16* Ab = br == 0 ? A0 + (size_t)m0 * 768 : (br == 1 ? A1 + (size_t)m0 * 512 : A2 + (size_t)m0 * 512);
      const u16* Wb = br == 0 ? W0 + (size_t)n0 * 768 : (br == 1 ? W1 + (size_t)n0 * 512 : W2 + (size_t)n0 * 512);
      merge_branch(mg, lds, Hrow, Wg + (size_t)(br * 1024 + n0) * 1024, Ab, Wb, br == 0 ? 768 : 512);
    }
    epi_each(mg, [&](int r0, int c, float v0, float v1, float v2, float v3) {
      u16* dst = MG + (size_t)(m0 + r0) * 1024 + n0 + c;
      dst[0] = f2bf(v0); dst[1024] = f2bf(v1); dst[2048] = f2bf(v2); dst[3072] = f2bf(v3);
    });
  }
}

__device__ __forceinline__ void phase7(const Params& P, u16* lds) {
  unsigned char* ws = P.ws;
  const u16* MG = (const u16*)(ws + OFF_MERGED);
  const u16* W = (const u16*)(ws + OFF_WOUT);
  for (int kk_ = 0;; kk_++) {
    int mt, nt;
    if (!tile_map(kk_, 768, 8, mt, nt)) break;
    int m0 = mt * 128, n0 = nt * 128;
    Acc acc; acc_zero(acc);
    gemm_lin(acc, lds, MG + (size_t)m0 * 1024, 1024, W + (size_t)n0 * 1024, 1024, 1024);
    const float* xin = m0 < NTP ? P.in[0] + (size_t)m0 * 1024 : P.in[1] + (size_t)(m0 - NTP) * 1024;
    float* xo = P.out + (size_t)m0 * 1024;
    epi_each(acc, [&](int r0, int c, float v0, float v1, float v2, float v3) {
      size_t o = (size_t)r0 * 1024 + n0 + c;
      xo[o] = xin[o] + v0; xo[o + 1024] = xin[o + 1024] + v1; xo[o + 2048] = xin[o + 2048] + v2; xo[o + 3072] = xin[o + 3072] + v3;
    });
  }
}

__device__ __forceinline__ void phase8(const Params& P) {
  const int wave = threadIdx.x >> 6;
  u16* H = (u16*)(P.ws + OFF_H);
  for (int row = blockIdx.x * 4 + wave; row < NT; row += gridDim.x * 4)
    norm_row(P.out + (size_t)row * 1024, H + (size_t)row * 1024);
}

__device__ __forceinline__ void phase9(const Params& P, u16* lds) {
  unsigned char* ws = P.ws;
  const u16* H = (const u16*)(ws + OFF_H);
  const u16* W = (const u16*)(ws + OFF_WUP);
  u16* ACT = (u16*)(ws + OFF_ACT);
  const float* cw = P.in[38];
  const float* cb = P.in[39];
  float* Lf = (float*)lds;
  const int tid = threadIdx.x, lane = tid & 63, wave = tid >> 6, wm = wave >> 1, wn = wave & 1;
  for (int kk_ = 0;; kk_++) {
    int mt, nt;
    if (!tile_map(kk_, 808, 44, mt, nt)) break;
    int start, T, ti;
    if (mt < 544) { int s = mt / 17; ti = mt % 17; start = s * 2048; T = 2048; }
    else { int m2 = mt - 544; int s = m2 / 66; ti = m2 % 66; start = NTP + s * 8192; T = 8192; }
    const int p0 = 126 * ti - 1;
    const int lr = tid >> 3;
    const u16* pa[4];
#pragma unroll
    for (int i = 0; i < 4; i++) {
      int p = p0 + lr + 32 * i;
      p = p < 0 ? 0 : (p > T - 1 ? T - 1 : p);
      pa[i] = H + (size_t)(start + p) * 1024;
    }
    const u16* Bt = W + (size_t)nt * 128 * 1024;
    Acc acc; acc_zero(acc);
    gemm_main(acc, lds, pa[0], pa[1], pa[2], pa[3], Bt + (size_t)lr * 1024, Bt + (size_t)(lr + 32) * 1024,
              Bt + (size_t)(lr + 64) * 1024, Bt + (size_t)(lr + 96) * 1024, 1024);
    {
      float* dst = Lf + wn * 8192;
#pragma unroll
      for (int i = 0; i < 2; i++)
#pragma unroll
        for (int j = 0; j < 2; j++)
#pragma unroll
          for (int r = 0; r < 16; r++) {
            int rr = 64 * wm + 32 * i + (r & 3) + 8 * (r >> 2) + 4 * (lane >> 5);
            dst[rr * 64 + 32 * j + (lane & 31)] = acc.a[i][j][r];
          }
    }
    __syncthreads();
    {
      const int c = tid & 63, rgp = tid >> 6;
      const int col = nt * 64 + c;
      const float w0 = cw[col], w1 = cw[2816 + col], w2 = cw[2 * 2816 + col], bb = cb[col];
      int rbeg = rgp * 32; if (rbeg < 1) rbeg = 1;
      int rend = rgp * 32 + 32; if (rend > 127) rend = 127;
      auto gval = [&](int r) { int p = p0 + r; return (p >= 0 && p < T) ? Lf[r * 64 + c] : 0.f; };
      float gp = gval(rbeg - 1), gc = gval(rbeg);
      for (int r = rbeg; r < rend; r++) {
        float gn = gval(r + 1);
        int p = p0 + r;
        if (p < T) {
          float cc = w0 * gp + w1 * gc + w2 * gn + bb;
          float a = 0.5f * cc * (1.f + erff(cc * 0.70710678118654752f)) * Lf[8192 + r * 64 + c];
          ACT[(size_t)(start + p) * 2816 + col] = f2bf(a);
        }
        gp = gc; gc = gn;
      }
    }
    __syncthreads();
  }
}

__device__ __forceinline__ void phase10(const Params& P, u16* lds) {
  unsigned char* ws = P.ws;
  const u16* ACT = (const u16*)(ws + OFF_ACT);
  const u16* W = (const u16*)(ws + OFF_WDOWN);
  for (int kk_ = 0;; kk_++) {
    int mt, nt;
    if (!tile_map(kk_, 768, 8, mt, nt)) break;
    int m0 = mt * 128, n0 = nt * 128;
    Acc acc; acc_zero(acc);
    gemm_lin(acc, lds, ACT + (size_t)m0 * 2816, 2816, W + (size_t)n0 * 2816, 2816, 2816);
    float* xo = P.out + (size_t)m0 * 1024;
    epi_each(acc, [&](int r0, int c, float v0, float v1, float v2, float v3) {
      size_t o = (size_t)r0 * 1024 + n0 + c;
      xo[o] += v0; xo[o + 1024] += v1; xo[o + 2048] += v2; xo[o + 3072] += v3;
    });
  }
}

constexpr int NPHASE = 11;
__global__ void __launch_bounds__(NTHREADS, 2) fwd_kernel(Params P) {
  extern __shared__ __attribute__((aligned(16))) unsigned char dlds[];
  cg::grid_group grid = cg::this_grid();
  u16* lds = (u16*)dlds;
#ifndef REPMASK
#define REPMASK 0
#endif
#define PH(k, call)                                   \
  if (P.lo <= (k) && (k) < P.hi) {                    \
    call;                                             \
    if ((REPMASK >> (k)) & 1) { grid.sync(); call; }  \
    if ((k) + 1 < P.hi) grid.sync();                  \
  }
  PH(0, (phase0(P), phase0b(P)))
  PH(1, phase1(P, lds))
  PH(2, phase2(P, lds))
  PH(3, phase3(P))
  PH(4, phase4(P, dlds))
  PH(5, phase5(P, lds))
  PH(6, phase6(P, lds))
  PH(7, phase7(P, lds))
  PH(8, phase8(P))
  PH(9, phase9(P, lds))
  PH(10, phase10(P, lds))
#undef PH
}

extern "C" void kernel_launch(void* const* d_in, const int* in_sizes, int n_in, void* d_out, int out_size, void* d_ws,
                              size_t ws_size, hipStream_t stream) {
  static int grid_blocks = 0;
  if (!grid_blocks) {
    int dev = 0, cus = 0, per_cu = 0;
    hipGetDevice(&dev);
    hipDeviceGetAttribute(&cus, hipDeviceAttributeMultiprocessorCount, dev);
    hipFuncSetAttribute((const void*)fwd_kernel, hipFuncAttributeMaxDynamicSharedMemorySize, LDS_BYTES);
    hipOccupancyMaxActiveBlocksPerMultiprocessor(&per_cu, (const void*)fwd_kernel, NTHREADS, LDS_BYTES);
    if (per_cu < 1) per_cu = 1;
    if (per_cu > 2) per_cu = 2;
    grid_blocks = cus * per_cu;
    if (ws_size < WS_END) fprintf(stderr, "workspace too small: %zu < %zu\n", ws_size, (size_t)WS_END);
  }
  if (ws_size < WS_END) return;
  Params p{};
  for (int i = 0; i < 41; i++) p.in[i] = (const float*)d_in[i];
  p.out = (float*)d_out;
  p.ws = (unsigned char*)d_ws;
#if MEGA
  p.lo = 0; p.hi = NPHASE;
  void* args[] = {&p};
  hipError_t e = hipLaunchCooperativeKernel((const void*)fwd_kernel, dim3(grid_blocks), dim3(NTHREADS), args, LDS_BYTES, stream);
  if (e != hipSuccess) fprintf(stderr, "cooperative launch failed: %s (grid %d)\n", hipGetErrorString(e), grid_blocks);
#else
#ifndef PHMAX
#define PHMAX 11
#endif
  for (int k = 0; k < PHMAX; k++) {
    p.lo = k; p.hi = k + 1;
    hipLaunchKernelGGL(fwd_kernel, dim3(grid_blocks), dim3(NTHREADS), LDS_BYTES, stream, p);
  }
#endif
}
```

```cpp
#include <hip/hip_runtime.h>
#include <hip/hip_cooperative_groups.h>
#include <cstdio>
#include <cstdint>
namespace cg = cooperative_groups;

typedef unsigned short u16;
typedef __attribute__((ext_vector_type(8))) short bf16x8;
typedef __attribute__((ext_vector_type(16))) float f32x16;

#ifndef MEGA
#define MEGA 1
#endif

constexpr int NT = 98304;
constexpr int NTP = 65536;
constexpr int NMEMROWS = 9216;
constexpr int NTHREADS = 256;
constexpr int LDS_BYTES = 73728;

constexpr size_t OFF_CTL = 0;
constexpr size_t OFF_WIN = 4096;
constexpr size_t OFF_WUQ = OFF_WIN + (size_t)6272 * 1024 * 2;
constexpr size_t OFF_WUKV = OFF_WUQ + (size_t)768 * 384 * 2;
constexpr size_t OFF_WOA = OFF_WUKV + (size_t)1024 * 256 * 2;
constexpr size_t OFF_WOB = OFF_WOA + (size_t)1024 * 768 * 2;
constexpr size_t OFF_WOC = OFF_WOB + (size_t)1024 * 512 * 2;
constexpr size_t OFF_WMKV = OFF_WOC + (size_t)1024 * 512 * 2;
constexpr size_t OFF_WOUT = OFF_WMKV + (size_t)2048 * 1024 * 2;
constexpr size_t OFF_WUP = OFF_WOUT + (size_t)1024 * 1024 * 2;
constexpr size_t OFF_WDOWN = OFF_WUP + (size_t)5632 * 1024 * 2;
constexpr size_t OFF_G2 = OFF_WDOWN + (size_t)1024 * 2816 * 2;
constexpr size_t OFF_W2F = OFF_G2 + (size_t)512 * 128 * 2;
constexpr size_t OFF_W2B = OFF_W2F + 65536;
constexpr size_t OFF_A2F = OFF_W2B + 65536;
constexpr size_t OFF_A2B = OFF_A2F + 65536;
constexpr size_t OFF_H = 50331648;
static_assert(OFF_A2B + 65536 <= OFF_H, "weights overflow");
constexpr size_t OFF_CQKV = OFF_H + (size_t)NT * 1024 * 2;
constexpr size_t OFF_RW = OFF_CQKV + (size_t)NT * 672 * 2;
constexpr size_t OFF_XQ = OFF_RW + (size_t)NT * 1920 * 2;
constexpr size_t OFF_MH = OFF_XQ + (size_t)NT * 512 * 2;
constexpr size_t OFF_MKV = OFF_MH + (size_t)NMEMROWS * 1024 * 2;
constexpr size_t OFF_MK = OFF_MKV + (size_t)NMEMROWS * 2048 * 2;
constexpr size_t OFF_MVT = OFF_MK + (size_t)NMEMROWS * 512 * 2;
constexpr size_t OFF_YB = OFF_MVT + (size_t)NMEMROWS * 512 * 2;
constexpr size_t WS_END = OFF_YB + (size_t)NT * 512 * 2;
static_assert(WS_END <= (size_t)1073741824, "workspace overflow");
constexpr size_t OFF_YF = OFF_CQKV;
constexpr size_t OFF_MERGED = OFF_RW;
constexpr size_t OFF_ACT = OFF_CQKV;
static_assert((size_t)NT * 2816 * 2 <= OFF_MH - OFF_CQKV, "act overflow");
constexpr size_t DO_Q = 0;
constexpr size_t DO_K = (size_t)NT * 768 * 2;
constexpr size_t DO_VT = DO_K + (size_t)NT * 768 * 2;

struct Params {
  const float* in[41];
  float* out;
  unsigned char* ws;
  int lo, hi;
};

typedef __bf16 bf16x2_t __attribute__((ext_vector_type(2)));
typedef float f32x2_t __attribute__((ext_vector_type(2)));
__device__ __forceinline__ unsigned pack2(float a, float b) {
  f32x2_t f = {a, b};
  bf16x2_t h = __builtin_convertvector(f, bf16x2_t);
  return __builtin_bit_cast(unsigned, h);
}
__device__ __forceinline__ u16 f2bf(float f) { return (u16)(pack2(f, f) & 0xffffu); }
__device__ __forceinline__ float bf2f(u16 b) { return __uint_as_float(((unsigned)b) << 16); }
__device__ __forceinline__ float bflo(unsigned u) { return __uint_as_float(u << 16); }
__device__ __forceinline__ float bfhi(unsigned u) { return __uint_as_float(u & 0xffff0000u); }

template <int CTRL>
__device__ __forceinline__ float dppf(float v) {
  return __int_as_float(__builtin_amdgcn_mov_dpp(__float_as_int(v), CTRL, 0xF, 0xF, true));
}
__device__ __forceinline__ float sum16(float v) {
  v += dppf<0xB1>(v);
  v += dppf<0x4E>(v);
  v += dppf<0x141>(v);
  v += dppf<0x140>(v);
  return v;
}
__device__ __forceinline__ float sum8(float v) {
  v += dppf<0xB1>(v);
  v += dppf<0x4E>(v);
  v += dppf<0x141>(v);
  return v;
}
__device__ __forceinline__ float wave_sum(float v) {
  v = sum16(v);
  v += __shfl_xor(v, 16);
  v += __shfl_xor(v, 32);
  return v;
}
__device__ __forceinline__ float sigmoidf_(float x) { return 1.f / (1.f + __expf(-x)); }

__device__ __forceinline__ void tok_seq(int g, int& seq, int& start, int& T) {
  if (g < NTP) { seq = g >> 11; start = seq << 11; T = 2048; }
  else { int s = (g - NTP) >> 13; seq = 32 + s; start = NTP + (s << 13); T = 8192; }
}
__device__ __forceinline__ size_t vt_base(int seq) {
  return seq < 32 ? (size_t)seq * (512 * 2048) : (size_t)32 * 512 * 2048 + (size_t)(seq - 32) * (512 * 8192);
}

struct Acc { f32x16 a[2][2]; };
constexpr int LROW = 72;
constexpr int LTILE = 128 * LROW;

__device__ __forceinline__ void acc_zero(Acc& acc) {
#pragma unroll
  for (int i = 0; i < 2; i++)
#pragma unroll
    for (int j = 0; j < 2; j++)
#pragma unroll
      for (int r = 0; r < 16; r++) acc.a[i][j][r] = 0.f;
}

__device__ __forceinline__ void gemm_compute(Acc& acc, const u16* lds, int b) {
  const int lane = threadIdx.x & 63, wave = threadIdx.x >> 6, wm = wave >> 1, wn = wave & 1;
  const u16* A = lds + b * (2 * LTILE) + (64 * wm + (lane & 31)) * LROW + 8 * (lane >> 5);
  const u16* B = lds + b * (2 * LTILE) + LTILE + (64 * wn + (lane & 31)) * LROW + 8 * (lane >> 5);
#pragma unroll
  for (int s = 0; s < 4; s++) {
    bf16x8 a0 = *(const bf16x8*)(A + 16 * s);
    bf16x8 a1 = *(const bf16x8*)(A + 32 * LROW + 16 * s);
    bf16x8 b0 = *(const bf16x8*)(B + 16 * s);
    bf16x8 b1 = *(const bf16x8*)(B + 32 * LROW + 16 * s);
    acc.a[0][0] = __builtin_amdgcn_mfma_f32_32x32x16_bf16(a0, b0, acc.a[0][0], 0, 0, 0);
    acc.a[0][1] = __builtin_amdgcn_mfma_f32_32x32x16_bf16(a0, b1, acc.a[0][1], 0, 0, 0);
    acc.a[1][0] = __builtin_amdgcn_mfma_f32_32x32x16_bf16(a1, b0, acc.a[1][0], 0, 0, 0);
    acc.a[1][1] = __builtin_amdgcn_mfma_f32_32x32x16_bf16(a1, b1, acc.a[1][1], 0, 0, 0);
  }
}

template <bool SINGLE = false, bool DEEP = true>
__device__ __forceinline__ void gemm_main(Acc& acc, u16* lds, const u16* pa0, const u16* pa1, const u16* pa2,
                                          const u16* pa3, const u16* pb0, const u16* pb1, const u16* pb2,
                                          const u16* pb3, int K) {
  const int tid = threadIdx.x;
  const int lr = tid >> 3, lk = (tid & 7) * 8;
  uint4 xa0, xa1, xa2, xa3, xb0, xb1, xb2, xb3;
  uint4 ya0, ya1, ya2, ya3, yb0, yb1, yb2, yb3;
  const int nk = K >> 6;
#define GLOAD(S, k0)                                                                         \
  S##a0 = *(const uint4*)(pa0 + (k0) + lk); S##a1 = *(const uint4*)(pa1 + (k0) + lk);         \
  S##a2 = *(const uint4*)(pa2 + (k0) + lk); S##a3 = *(const uint4*)(pa3 + (k0) + lk);         \
  S##b0 = *(const uint4*)(pb0 + (k0) + lk); S##b1 = *(const uint4*)(pb1 + (k0) + lk);         \
  S##b2 = *(const uint4*)(pb2 + (k0) + lk); S##b3 = *(const uint4*)(pb3 + (k0) + lk);
#define SSTORE(S, b)                                                                         \
  {                                                                                          \
    u16* A_ = lds + (b) * (2 * LTILE) + lr * LROW + lk;                                      \
    u16* B_ = A_ + LTILE;                                                                    \
    *(uint4*)(A_) = S##a0; *(uint4*)(A_ + 32 * LROW) = S##a1;                                \
    *(uint4*)(A_ + 64 * LROW) = S##a2; *(uint4*)(A_ + 96 * LROW) = S##a3;                    \
    *(uint4*)(B_) = S##b0; *(uint4*)(B_ + 32 * LROW) = S##b1;                                \
    *(uint4*)(B_ + 64 * LROW) = S##b2; *(uint4*)(B_ + 96 * LROW) = S##b3;                    \
  }
  if (!DEEP) {
    GLOAD(x, 0)
    SSTORE(x, 0)
    __syncthreads();
    for (int kt = 0; kt < nk; kt++) {
      if (kt + 1 < nk) { GLOAD(x, (kt + 1) * 64) }
      gemm_compute(acc, lds, SINGLE ? 0 : (kt & 1));
      if (SINGLE) __syncthreads();
      if (kt + 1 < nk) { SSTORE(x, SINGLE ? 0 : ((kt + 1) & 1)) }
      __syncthreads();
    }
    return;
  }
  GLOAD(x, 0)
  GLOAD(y, 64)
  SSTORE(x, 0)
  __syncthreads();
  for (int kt = 0; kt < nk; kt += 2) {
    if (kt + 2 < nk) { GLOAD(x, (kt + 2) * 64) }
    __builtin_amdgcn_sched_barrier(0);
    gemm_compute(acc, lds, 0);
    if (SINGLE) __syncthreads();
    SSTORE(y, SINGLE ? 0 : 1)
    __syncthreads();
    if (kt + 3 < nk) { GLOAD(y, (kt + 3) * 64) }
    __builtin_amdgcn_sched_barrier(0);
    gemm_compute(acc, lds, SINGLE ? 0 : 1);
    if (SINGLE) __syncthreads();
    if (kt + 2 < nk) { SSTORE(x, 0) }
    __syncthreads();
  }
#undef GLOAD
#undef SSTORE
}

template <bool SINGLE = false, bool DEEP = true>
__device__ __forceinline__ void gemm_lin(Acc& acc, u16* lds, const u16* A, long lda, const u16* B, long ldb, int K) {
  const int lr = threadIdx.x >> 3;
  gemm_main<SINGLE, DEEP>(acc, lds, A + (long)lr * lda, A + (long)(lr + 32) * lda, A + (long)(lr + 64) * lda,
            A + (long)(lr + 96) * lda, B + (long)lr * ldb, B + (long)(lr + 32) * ldb, B + (long)(lr + 64) * ldb,
            B + (long)(lr + 96) * ldb, K);
}

template <class F>
__device__ __forceinline__ void epi_each(const Acc& acc, F f) {
  const int lane = threadIdx.x & 63, wave = threadIdx.x >> 6, wm = wave >> 1, wn = wave & 1;
#pragma unroll
  for (int i = 0; i < 2; i++)
#pragma unroll
    for (int j = 0; j < 2; j++)
#pragma unroll
      for (int g = 0; g < 4; g++) {
        int r0 = 64 * wm + 32 * i + 8 * g + 4 * (lane >> 5);
        int c = 64 * wn + 32 * j + (lane & 31);
        f(r0, c, acc.a[i][j][4 * g + 0], acc.a[i][j][4 * g + 1], acc.a[i][j][4 * g + 2], acc.a[i][j][4 * g + 3]);
      }
}

__device__ __forceinline__ bool tile_map(int k, int MT, int NTL, int& mt, int& nt) {
  const int G = gridDim.x;
  if (G & 7) {
    int it = blockIdx.x + k * G;
    if (it >= MT * NTL) return false;
    mt = it / NTL; nt = it % NTL;
    return true;
  }
  const int xcd = blockIdx.x & 7, lb = blockIdx.x >> 3, nbx = G >> 3;
  const int mtx0 = (MT * xcd) >> 3, mtx1 = (MT * (xcd + 1)) >> 3, MTX = mtx1 - mtx0;
  const int idx = lb + k * nbx;
  if (idx >= MTX * NTL) return false;
  const int mg0 = idx / (8 * NTL);
  const int base = mg0 * 8;
  const int gsz = (MTX - base) < 8 ? (MTX - base) : 8;
  const int rem = idx - mg0 * 8 * NTL;
  nt = rem / gsz;
  mt = mtx0 + base + rem % gsz;
  return true;
}

template <class NMap, class KMap>
__device__ __forceinline__ void cvtw(const float* __restrict__ W, int srcN, u16* __restrict__ Wt, int dN, int dK,
                     const float* __restrict__ gain, NMap nmap, KMap kmap, long gtid, long gsz) {
  const int kch = dK >> 3;
  const long total = (long)dN * kch;
  for (long i = gtid; i < total; i += gsz) {
    int n = (int)(i % dN), kc = (int)(i / dN);
    int sn = nmap(n);
    float v[8];
#pragma unroll
    for (int j = 0; j < 8; j++) {
      int sk = kmap(kc * 8 + j);
      float x = 0.f;
      if (sn >= 0 && sk >= 0) {
        x = W[(long)sk * srcN + sn];
        if (gain) x *= gain[sk];
      }
      v[j] = x;
    }
    uint4 o;
    o.x = pack2(v[0], v[1]); o.y = pack2(v[2], v[3]); o.z = pack2(v[4], v[5]); o.w = pack2(v[6], v[7]);
    *(uint4*)(Wt + (long)n * dK + kc * 8) = o;
  }
}

__device__ __forceinline__ void phase0(const Params& P) {
  const long gtid = (long)blockIdx.x * NTHREADS + threadIdx.x, gsz = (long)gridDim.x * NTHREADS;
  unsigned char* ws = P.ws;
  if (gtid == 0) { ((unsigned*)(ws + OFF_CTL))[0] = 0u; }
  auto idn = [](int n) { return n; };
  cvtw(P.in[5], 6176, (u16*)(ws + OFF_WIN), 6272, 1024, P.in[4],
       [](int n) {
         if (n < 640) return n;
         if (n < 2560) return 672 + (n - 640);
         if (n < 3072) return 2592 + (n - 2560);
         if (n < 3104) return 640 + (n - 3072);
         if (n < 3200) return -1;
         return 3104 + (n - 3200);
       },
       idn, gtid, gsz);
  cvtw(P.in[7], 768, (u16*)(ws + OFF_WUQ), 768, 384, P.in[6], idn, idn, gtid, gsz);
  cvtw(P.in[9], 1024, (u16*)(ws + OFF_WUKV), 1024, 256, P.in[8], idn, idn, gtid, gsz);
  cvtw(P.in[12], 1024, (u16*)(ws + OFF_WOA), 1024, 768, nullptr, idn,
       [](int k) { int h = k / 96, d = k % 96; return d < 64 ? h * 64 + d : -1; }, gtid, gsz);
  cvtw(P.in[29], 1024, (u16*)(ws + OFF_WOB), 1024, 512, nullptr, idn, idn, gtid, gsz);
  cvtw(P.in[34], 1024, (u16*)(ws + OFF_WOC), 1024, 512, nullptr, idn, idn, gtid, gsz);
  cvtw(P.in[31], 1024, (u16*)(ws + OFF_WMKV), 1024, 1024, P.in[30], idn, idn, gtid, gsz);
  cvtw(P.in[35], 1024, (u16*)(ws + OFF_WOUT), 1024, 1024, nullptr, idn, idn, gtid, gsz);
  cvtw(P.in[37], 5632, (u16*)(ws + OFF_WUP), 5632, 1024, P.in[36],
       [](int n) { int t = n >> 7, w = n & 127; return w < 64 ? t * 64 + w : 2816 + t * 64 + (w - 64); }, idn, gtid, gsz);
  cvtw(P.in[40], 1024, (u16*)(ws + OFF_WDOWN), 1024, 2816, nullptr, idn, idn, gtid, gsz);
  cvtw(P.in[23], 512, (u16*)(ws + OFF_G2), 512, 128, nullptr, idn, idn, gtid, gsz);
  cvtw(P.in[16], 512, (u16*)(ws + OFF_W2F), 512, 64, nullptr, idn, idn, gtid, gsz);
  cvtw(P.in[20], 512, (u16*)(ws + OFF_W2B), 512, 64, nullptr, idn, idn, gtid, gsz);
  cvtw(P.in[18], 512, (u16*)(ws + OFF_A2F), 512, 64, nullptr, idn, idn, gtid, gsz);
  cvtw(P.in[22], 512, (u16*)(ws + OFF_A2B), 512, 64, nullptr, idn, idn, gtid, gsz);
}

__device__ __forceinline__ void norm_row(const float* __restrict__ src, u16* __restrict__ dst) {
  const int lane = threadIdx.x & 63;
  float4 v0 = *(const float4*)(src + lane * 4);
  float4 v1 = *(const float4*)(src + 256 + lane * 4);
  float4 v2 = *(const float4*)(src + 512 + lane * 4);
  float4 v3 = *(const float4*)(src + 768 + lane * 4);
  float ss = v0.x * v0.x + v0.y * v0.y + v0.z * v0.z + v0.w * v0.w + v1.x * v1.x + v1.y * v1.y + v1.z * v1.z +
             v1.w * v1.w + v2.x * v2.x + v2.y * v2.y + v2.z * v2.z + v2.w * v2.w + v3.x * v3.x + v3.y * v3.y +
             v3.z * v3.z + v3.w * v3.w;
  ss = wave_sum(ss);
  float r = rsqrtf(ss * (1.f / 1024.f) + 1e-6f);
  uint2 o;
  o.x = pack2(v0.x * r, v0.y * r); o.y = pack2(v0.z * r, v0.w * r); *(uint2*)(dst + lane * 4) = o;
  o.x = pack2(v1.x * r, v1.y * r); o.y = pack2(v1.z * r, v1.w * r); *(uint2*)(dst + 256 + lane * 4) = o;
  o.x = pack2(v2.x * r, v2.y * r); o.y = pack2(v2.z * r, v2.w * r); *(uint2*)(dst + 512 + lane * 4) = o;
  o.x = pack2(v3.x * r, v3.y * r); o.y = pack2(v3.z * r, v3.w * r); *(uint2*)(dst + 768 + lane * 4) = o;
}

__device__ __forceinline__ void phase0b(const Params& P) {
  const int wave = threadIdx.x >> 6;
  u16* H = (u16*)(P.ws + OFF_H);
  u16* MH = (u16*)(P.ws + OFF_MH);
  for (int row = blockIdx.x * 4 + wave; row < NT + NMEMROWS; row += gridDim.x * 4) {
    if (row < NT) {
      const float* src = row < NTP ? P.in[0] + (size_t)row * 1024 : P.in[1] + (size_t)(row - NTP) * 1024;
      norm_row(src, H + (size_t)row * 1024);
    } else {
      int mr = row - NT;
      const float* src = mr < 8192 ? P.in[2] + (size_t)mr * 1024 : P.in[3] + (size_t)(mr - 8192) * 1024;
      norm_row(src, MH + (size_t)mr * 1024);
    }
  }
}

__device__ __forceinline__ void phase1(const Params& P, u16* lds) {
  unsigned char* ws = P.ws;
  const u16* H = (const u16*)(ws + OFF_H);
  const u16* Win = (const u16*)(ws + OFF_WIN);
  u16* CQKV = (u16*)(ws + OFF_CQKV);
  u16* RW = (u16*)(ws + OFF_RW);
  u16* XQ = (u16*)(ws + OFF_XQ);
  for (int kk_ = 0;; kk_++) {
    int mt, nt;
    if (!tile_map(kk_, 768, 25, mt, nt)) break;
    Acc acc; acc_zero(acc);
    {
      int m0 = mt * 128, n0 = nt * 128;
      gemm_lin(acc, lds, H + (size_t)m0 * 1024, 1024, Win + (size_t)n0 * 1024, 1024, 1024);
      epi_each(acc, [&](int r0, int c, float v0, float v1, float v2, float v3) {
        int n = n0 + c;
        u16* dst; int ld;
        if (n < 640) { dst = CQKV + n; ld = 672; }
        else if (n < 2560) { dst = RW + (n - 640); ld = 1920; }
        else if (n < 3072) { dst = XQ + (n - 2560); ld = 512; }
        else if (n < 3104) { dst = CQKV + 640 + (n - 3072); ld = 672; }
        else return;
        size_t row = (size_t)(m0 + r0);
        dst[row * ld] = f2bf(v0); dst[(row + 1) * ld] = f2bf(v1); dst[(row + 2) * ld] = f2bf(v2); dst[(row + 3) * ld] = f2bf(v3);
      });
    }
  }
  for (int i2 = blockIdx.x; i2 < 72 * 8; i2 += gridDim.x) {
    Acc acc; acc_zero(acc);
    {
      int mt = i2 / 8, nt = i2 % 8;
      int m0 = mt * 128, n0 = nt * 128;
      gemm_lin(acc, lds, (const u16*)(ws + OFF_MH) + (size_t)m0 * 1024, 1024, (const u16*)(ws + OFF_WMKV) + (size_t)n0 * 1024, 1024, 1024);
      u16* MKV = (u16*)(ws + OFF_MKV);
      epi_each(acc, [&](int r0, int c, float v0, float v1, float v2, float v3) {
        u16* dst = MKV + (size_t)(m0 + r0) * 1024 + n0 + c;
        dst[0] = f2bf(v0); dst[1024] = f2bf(v1); dst[2048] = f2bf(v2); dst[3072] = f2bf(v3);
      });
    }
  }
}

__device__ __forceinline__ void phase2(const Params& P, u16* lds) {
  unsigned char* ws = P.ws;
  const u16* CQKV = (const u16*)(ws + OFF_CQKV);
  u16* Q = (u16*)((unsigned char*)P.out + DO_Q);
  u16* Kb = (u16*)((unsigned char*)P.out + DO_K);
  u16* Vt = (u16*)((unsigned char*)P.out + DO_VT);
  __shared__ float rstd_s[128];
  const int tid = threadIdx.x;
  for (int it = blockIdx.x; it < 768 * 14; it += gridDim.x) {
    int mt = it / 14, nt = it % 14;
    int m0 = mt * 128;
    const bool isq = nt < 6;
    {
      int r = tid >> 1, hf = tid & 1;
      const u16* src = CQKV + (size_t)(m0 + r) * 672 + (isq ? hf * 192 : 384 + hf * 128);
      int nch = isq ? 24 : 16;
      float ss = 0.f;
      for (int c = 0; c < nch; c++) {
        uint4 u = *(const uint4*)(src + c * 8);
        float a;
        a = bflo(u.x); ss += a * a; a = bfhi(u.x); ss += a * a;
        a = bflo(u.y); ss += a * a; a = bfhi(u.y); ss += a * a;
        a = bflo(u.z); ss += a * a; a = bfhi(u.z); ss += a * a;
        a = bflo(u.w); ss += a * a; a = bfhi(u.w); ss += a * a;
      }
      ss += dppf<0xB1>(ss);
      if (hf == 0) rstd_s[r] = rsqrtf(ss / (isq ? 384.f : 256.f) + 1e-6f);
    }
    __syncthreads();
    Acc acc; acc_zero(acc);
    if (isq) {
      int n0 = nt * 128;
      gemm_lin(acc, lds, CQKV + (size_t)m0 * 672, 672, (const u16*)(ws + OFF_WUQ) + (size_t)n0 * 384, 384, 384);
      epi_each(acc, [&](int r0, int c, float v0, float v1, float v2, float v3) {
        u16* dst = Q + (size_t)(m0 + r0) * 768 + n0 + c;
        dst[0] = f2bf(v0 * rstd_s[r0]); dst[768] = f2bf(v1 * rstd_s[r0 + 1]);
        dst[1536] = f2bf(v2 * rstd_s[r0 + 2]); dst[2304] = f2bf(v3 * rstd_s[r0 + 3]);
      });
    } else {
      int head = nt - 6;
      int n0 = head * 128;
      gemm_lin(acc, lds, CQKV + (size_t)m0 * 672 + 384, 672, (const u16*)(ws + OFF_WUKV) + (size_t)n0 * 256, 256, 256);
      int seq, start, T;
      tok_seq(m0, seq, start, T);
      u16* vtb = Vt + vt_base(seq) + (size_t)head * 64 * T + (m0 - start);
      epi_each(acc, [&](int r0, int c, float v0, float v1, float v2, float v3) {
        v0 *= rstd_s[r0]; v1 *= rstd_s[r0 + 1]; v2 *= rstd_s[r0 + 2]; v3 *= rstd_s[r0 + 3];
        if (c < 64) {
          u16* dst = Kb + (size_t)(m0 + r0) * 768 + head * 96 + c;
          dst[0] = f2bf(v0); dst[768] = f2bf(v1); dst[1536] = f2bf(v2); dst[2304] = f2bf(v3);
        } else {
          uint2 o; o.x = pack2(v0, v1); o.y = pack2(v2, v3);
          *(uint2*)(vtb + (size_t)(c - 64) * T + r0) = o;
        }
      });
    }
    __syncthreads();
  }
}

__device__ __forceinline__ void phase3(const Params& P) {
  unsigned char* ws = P.ws;
  const u16* CQKV = (const u16*)(ws + OFF_CQKV);
  u16* Kb = (u16*)((unsigned char*)P.out + DO_K);
  const float* gk = P.in[11];
  const int tid = threadIdx.x;
  const int sub = tid >> 4, i = tid & 15;
  const float inv = powf(10000.f, -(float)i / 16.f);
  const float g0 = gk[4 * i], g1 = gk[4 * i + 1], g2 = gk[4 * i + 2], g3 = gk[4 * i + 3], gr1 = gk[64 + i], gr2 = gk[80 + i];
  for (long pr = (long)blockIdx.x * 16 + sub; pr < (long)NT * 8; pr += (long)gridDim.x * 16) {
    int tok = (int)(pr >> 3), head = (int)(pr & 7);
    u16* kp = Kb + (size_t)tok * 768 + head * 96;
    uint2 u = *(const uint2*)(kp + 4 * i);
    float a0 = bflo(u.x), a1 = bfhi(u.x), a2 = bflo(u.y), a3 = bfhi(u.y);
    float x1 = bf2f(CQKV[(size_t)tok * 672 + 640 + i]);
    float x2 = bf2f(CQKV[(size_t)tok * 672 + 656 + i]);
    float ss = a0 * a0 + a1 * a1 + a2 * a2 + a3 * a3 + x1 * x1 + x2 * x2;
    ss = sum16(ss);
    float r = rsqrtf(ss * (1.f / 96.f) + 1e-6f);
    int seq, start, T;
    tok_seq(tok, seq, start, T);
    float ang = (float)(tok - start) * inv;
    float sn, cs;
    sincosf(ang, &sn, &cs);
    x1 *= r * gr1; x2 *= r * gr2;
    uint2 o; o.x = pack2(a0 * r * g0, a1 * r * g1); o.y = pack2(a2 * r * g2, a3 * r * g3);
    *(uint2*)(kp + 4 * i) = o;
    kp[64 + i] = f2bf(x1 * cs - x2 * sn);
    kp[80 + i] = f2bf(x2 * cs + x1 * sn);
  }
  const u16* MKV = (const u16*)(ws + OFF_MKV);
  u16* MK = (u16*)(ws + OFF_MK);
  u16* MVT = (u16*)(ws + OFF_MVT);
  const float* gxk = P.in[33];
  for (int pr = blockIdx.x * 16 + sub; pr < NMEMROWS * 4; pr += gridDim.x * 16) {
    int row = pr >> 2, head = pr & 3;
    int b = row >> 8, key = row & 255;
    uint4 u = *(const uint4*)(MKV + (size_t)row * 1024 + head * 256 + 8 * i);
    float a0 = bflo(u.x), a1 = bfhi(u.x), a2 = bflo(u.y), a3 = bfhi(u.y), a4 = bflo(u.z), a5 = bfhi(u.z), a6 = bflo(u.w), a7 = bfhi(u.w);
    float ss = a0 * a0 + a1 * a1 + a2 * a2 + a3 * a3 + a4 * a4 + a5 * a5 + a6 * a6 + a7 * a7;
    ss = sum16(ss);
    float r = rsqrtf(ss * (1.f / 128.f) + 1e-6f);
    const float* g = gxk + 8 * i;
    uint4 o;
    o.x = pack2(a0 * r * g[0], a1 * r * g[1]); o.y = pack2(a2 * r * g[2], a3 * r * g[3]);
    o.z = pack2(a4 * r * g[4], a5 * r * g[5]); o.w = pack2(a6 * r * g[6], a7 * r * g[7]);
    *(uint4*)(MK + ((size_t)(b * 4 + head) * 256 + key) * 128 + 8 * i) = o;
  }
  for (long e = (long)blockIdx.x * NTHREADS + tid; e < (long)NMEMROWS * 512; e += (long)gridDim.x * NTHREADS) {
    int row = (int)(e >> 9), c = (int)(e & 511);
    int head = c >> 7, dv = c & 127;
    int b = row >> 8, key = row & 255;
    MVT[((size_t)(b * 4 + head) * 128 + dv) * 256 + key] = MKV[(size_t)row * 1024 + head * 256 + 128 + dv];
  }
}

template <int DQK, int DV, bool ROPE, bool PREF>
__device__ __forceinline__ void attn_item(u16* lds, const u16* Qp, long qld, const u16* Kp, long kld, const u16* Vtp, long vld,
                          int nkeys, const float* __restrict__ gq, float qscale, int tpos0, u16* Op, long old) {
  constexpr int KP = DQK + 8;
  constexpr int KT = 64 * KP;
  constexpr int VT = DV * 72;
  constexpr int BUF = KT + VT;
  constexpr int NS = DQK / 16;
  constexpr int ND = DV / 32;
  constexpr int KCH = DQK / 8;
  constexpr int NKC = 64 * KCH / 256;
  constexpr int NVC = DV * 8 / 256;
  const int tid = threadIdx.x, lane = tid & 63, wave = tid >> 6, h = lane >> 5, lr = lane & 31;

  bf16x8 qf[NS];
  {
    const u16* qp = Qp + (long)(32 * wave + lr) * qld + 8 * h;
    float qv[NS][8];
    float ss = 0.f;
#pragma unroll
    for (int s = 0; s < NS; s++) {
      uint4 u = *(const uint4*)(qp + 16 * s);
      qv[s][0] = bflo(u.x); qv[s][1] = bfhi(u.x); qv[s][2] = bflo(u.y); qv[s][3] = bfhi(u.y);
      qv[s][4] = bflo(u.z); qv[s][5] = bfhi(u.z); qv[s][6] = bflo(u.w); qv[s][7] = bfhi(u.w);
#pragma unroll
      for (int j = 0; j < 8; j++) ss += qv[s][j] * qv[s][j];
    }
    ss += __shfl_xor(ss, 32);
    float r = rsqrtf(ss * (1.f / DQK) + 1e-6f);
#pragma unroll
    for (int s = 0; s < NS; s++)
#pragma unroll
      for (int j = 0; j < 8; j++) qv[s][j] *= r * gq[16 * s + 8 * h + j];
    if (ROPE) {
      float t = (float)(tpos0 + 32 * wave + lr);
#pragma unroll
      for (int j = 0; j < 8; j++) {
        float inv = powf(10000.f, -(float)(8 * h + j) / 16.f);
        float sn, cs;
        sincosf(t * inv, &sn, &cs);
        float x1 = qv[NS - 2][j], x2 = qv[NS - 1][j];
        qv[NS - 2][j] = x1 * cs - x2 * sn;
        qv[NS - 1][j] = x2 * cs + x1 * sn;
      }
    }
#pragma unroll
    for (int s = 0; s < NS; s++) {
      uint4 u;
      u.x = pack2(qv[s][0] * qscale, qv[s][1] * qscale); u.y = pack2(qv[s][2] * qscale, qv[s][3] * qscale);
      u.z = pack2(qv[s][4] * qscale, qv[s][5] * qscale); u.w = pack2(qv[s][6] * qscale, qv[s][7] * qscale);
      qf[s] = *(bf16x8*)&u;
    }
  }

  f32x16 o[ND];
#pragma unroll
  for (int d = 0; d < ND; d++)
#pragma unroll
    for (int r = 0; r < 16; r++) o[d][r] = 0.f;
  float lsum = 0.f;

  uint4 rk[NKC], rv[NVC];
  const int nkt = nkeys >> 6;
#define AGLOAD(kt)                                                                           \
  {                                                                                          \
    _Pragma("unroll") for (int i = 0; i < NKC; i++) {                                        \
      int c = tid + 256 * i; int row = c / KCH, kc = c % KCH;                                \
      rk[i] = *(const uint4*)(Kp + (long)((kt) * 64 + row) * kld + kc * 8);                  \
    }                                                                                        \
    _Pragma("unroll") for (int i = 0; i < NVC; i++) {                                        \
      int c = tid + 256 * i; int row = c >> 3, kc = c & 7;                                   \
      rv[i] = *(const uint4*)(Vtp + (long)row * vld + (kt) * 64 + kc * 8);                   \
    }                                                                                        \
  }
#define ASTORE(b)                                                                            \
  {                                                                                          \
    u16* Kl = lds + (b) * BUF; u16* Vl = Kl + KT;                                            \
    _Pragma("unroll") for (int i = 0; i < NKC; i++) {                                        \
      int c = tid + 256 * i; int row = c / KCH, kc = c % KCH;                                \
      *(uint4*)(Kl + row * KP + kc * 8) = rk[i];                                             \
    }                                                                                        \
    _Pragma("unroll") for (int i = 0; i < NVC; i++) {                                        \
      int c = tid + 256 * i; int row = c >> 3, kc = c & 7;                                   \
      *(uint4*)(Vl + row * 72 + kc * 8) = rv[i];                                             \
    }                                                                                        \
  }
  AGLOAD(0)
  ASTORE(0)
  __syncthreads();
  for (int kt = 0; kt < nkt; kt++) {
    if (PREF) { if (kt + 1 < nkt) AGLOAD(kt + 1) }
    else { if (kt + 1 < nkt) { AGLOAD(kt + 1) ASTORE((kt + 1) & 1) } }
    const u16* Kl = lds + (kt & 1) * BUF;
    const u16* Vl = Kl + KT;
#pragma unroll
    for (int ks = 0; ks < 2; ks++) {
      f32x16 st;
#pragma unroll
      for (int r = 0; r < 16; r++) st[r] = 0.f;
      const u16* kr = Kl + (32 * ks + lr) * KP + 8 * h;
#pragma unroll
      for (int s = 0; s < NS; s++) {
        bf16x8 kf = *(const bf16x8*)(kr + 16 * s);
        st = __builtin_amdgcn_mfma_f32_32x32x16_bf16(kf, qf[s], st, 0, 0, 0);
      }
      float p[16];
#pragma unroll
      for (int r = 0; r < 16; r++) { p[r] = __builtin_amdgcn_exp2f(st[r]); lsum += p[r]; }
#pragma unroll
      for (int s2 = 0; s2 < 2; s2++) {
        uint4 u;
        u.x = pack2(p[8 * s2 + 0], p[8 * s2 + 1]); u.y = pack2(p[8 * s2 + 2], p[8 * s2 + 3]);
        u.z = pack2(p[8 * s2 + 4], p[8 * s2 + 5]); u.w = pack2(p[8 * s2 + 6], p[8 * s2 + 7]);
        bf16x8 pb = *(bf16x8*)&u;
#pragma unroll
        for (int d = 0; d < ND; d++) {
          const u16* vr = Vl + (32 * d + lr) * 72 + 32 * ks + 16 * s2 + 4 * h;
          uint2 v0 = *(const uint2*)(vr);
          uint2 v1 = *(const uint2*)(vr + 8);
          uint4 vv; vv.x = v0.x; vv.y = v0.y; vv.z = v1.x; vv.w = v1.y;
          bf16x8 vf = *(bf16x8*)&vv;
          o[d] = __builtin_amdgcn_mfma_f32_32x32x16_bf16(vf, pb, o[d], 0, 0, 0);
        }
      }
    }
    if (PREF) { if (kt + 1 < nkt) ASTORE((kt + 1) & 1) }
    __syncthreads();
  }
#undef AGLOAD
#undef ASTORE
  lsum += __shfl_xor(lsum, 32);
  float il = 1.f / lsum;
  u16* op = Op + (long)(32 * wave + lr) * old;
#pragma unroll
  for (int d = 0; d < ND; d++)
#pragma unroll
    for (int g = 0; g < 4; g++) {
      uint2 u;
      u.x = pack2(o[d][4 * g] * il, o[d][4 * g + 1] * il);
      u.y = pack2(o[d][4 * g + 2] * il, o[d][4 * g + 3] * il);
      *(uint2*)(op + 32 * d + 8 * g + 4 * h) = u;
    }
}

typedef __attribute__((ext_vector_type(2))) float f32x2;
constexpr int SC_OP = 2048;
constexpr int SC_WR = 0, SC_KK = SC_OP, SC_WD = 2 * SC_OP, SC_KD = 3 * SC_OP, SC_BB = 4 * SC_OP;
constexpr int SC_R = SC_WR, SC_K = SC_KK, SC_LW = SC_WD, SC_LA = SC_KD;
constexpr int SC_V = 5 * SC_OP, SC_BR = SC_V + 2048, SC_CKR = SC_BR + 32, SC_Y = SC_CKR + 32;
constexpr int SC_END = SC_Y + 2048;
constexpr int SC_TW_B = SC_END * 4;
constexpr int SC_AL_B = SC_TW_B + 32 * 72 * 2;
static_assert(SC_AL_B + 32 * 72 * 2 + 960 * 4 <= LDS_BYTES, "scan lds");

__device__ __forceinline__ float fexp(float x) { return __builtin_amdgcn_exp2f(x * 1.4426950408889634f); }
__device__ __forceinline__ float frcp(float x) { return __builtin_amdgcn_rcpf(x); }
__device__ __forceinline__ float ftanh(float x) { return 1.f - 2.f * frcp(1.f + fexp(2.f * x)); }
__device__ __forceinline__ float fsigm(float x) { return frcp(1.f + fexp(-x)); }

struct Raw3 { uint4 c, a, b; };
__device__ __forceinline__ Raw3 ld3(const u16* __restrict__ p, bool hp, bool hn) {
  Raw3 r;
  r.c = *(const uint4*)p;
  r.a = hp ? *(const uint4*)(p - 1920) : make_uint4(0, 0, 0, 0);
  r.b = hn ? *(const uint4*)(p + 1920) : make_uint4(0, 0, 0, 0);
  return r;
}
__device__ __forceinline__ void mixr(const Raw3& r, const float* __restrict__ mp, const float* __restrict__ mn, float* out) {
  float cc[8] = {bflo(r.c.x), bfhi(r.c.x), bflo(r.c.y), bfhi(r.c.y), bflo(r.c.z), bfhi(r.c.z), bflo(r.c.w), bfhi(r.c.w)};
  float aa[8] = {bflo(r.a.x), bfhi(r.a.x), bflo(r.a.y), bfhi(r.a.y), bflo(r.a.z), bfhi(r.a.z), bflo(r.a.w), bfhi(r.a.w)};
  float bb[8] = {bflo(r.b.x), bfhi(r.b.x), bflo(r.b.y), bfhi(r.b.y), bflo(r.b.z), bfhi(r.b.z), bflo(r.b.w), bfhi(r.b.w)};
#pragma unroll
  for (int j = 0; j < 8; j++) out[j] = cc[j] + mp[j] * (aa[j] - cc[j]) + mn[j] * (bb[j] - cc[j]);
}
__device__ __forceinline__ void mix8(const u16* __restrict__ p, bool hp, bool hn, const float* __restrict__ mp,
                                     const float* __restrict__ mn, float* out) {
  Raw3 r = ld3(p, hp, hn);
  mixr(r, mp, mn, out);
}

template <int NRG>
__device__ __forceinline__ void scan_item(const Params& P, unsigned char* ldsb, int seq, int head, int dir, int rg) {
  float* L = (float*)ldsb;
  u16* TWb = (u16*)(ldsb + SC_TW_B);
  u16* ALb = (u16*)(ldsb + SC_AL_B);
  unsigned char* ws = P.ws;
  const u16* RW = (const u16*)(ws + OFF_RW);
  u16* Y = (u16*)(ws + (dir ? OFF_YB : OFF_YF));
  const float* w0 = dir ? P.in[19] : P.in[15];
  const float* a0 = dir ? P.in[21] : P.in[17];
  const u16* w2t = (const u16*)(ws + (dir ? OFF_W2B : OFF_W2F));
  const u16* a2t = (const u16*)(ws + (dir ? OFF_A2B : OFF_A2F));
  const int T = seq < 32 ? 2048 : 8192;
  const int start = seq < 32 ? seq * 2048 : NTP + (seq - 32) * 8192;
  const int tid = threadIdx.x, lane = tid & 63, wave = tid >> 6;
  const int hc = head * 64;
  const int pt = tid >> 3, pc = (tid & 7) * 8;
  const int wlo = dir ? 1600 : 1536, alo = dir ? 1728 : 1664;
  float* CS = (float*)(ldsb + SC_AL_B + 32 * 72 * 2);
  for (int i = tid; i < 960; i += NTHREADS) {
    const int arr = i >> 6, c = i & 63;
    const float* src;
    switch (arr) {
      case 0: src = P.in[13] + hc; break;
      case 1: src = P.in[14] + hc; break;
      case 2: src = P.in[13] + 512 + hc; break;
      case 3: src = P.in[14] + 512 + hc; break;
      case 4: src = P.in[13] + 1024 + hc; break;
      case 5: src = P.in[14] + 1024 + hc; break;
      case 6: src = P.in[13] + wlo; break;
      case 7: src = P.in[14] + wlo; break;
      case 8: src = P.in[13] + alo; break;
      case 9: src = P.in[14] + alo; break;
      case 10: src = w0 + hc; break;
      case 11: src = a0 + hc; break;
      case 12: src = P.in[24] + hc; break;
      case 13: src = P.in[25] + hc; break;
      default: src = P.in[26] + hc; break;
    }
    CS[i] = src[c];
  }
  __syncthreads();
  const float *mpr = CS + pc, *mnr = CS + 64 + pc, *mpk = CS + 128 + pc, *mnk = CS + 192 + pc, *mpv = CS + 256 + pc,
              *mnv = CS + 320 + pc, *mpw = CS + 384 + pc, *mnw = CS + 448 + pc, *mpa = CS + 512 + pc, *mna = CS + 576 + pc,
              *cw0 = CS + 640 + pc, *ca0 = CS + 704 + pc, *ckk = CS + 768 + pc, *cka = CS + 832 + pc, *crk = CS + 896 + pc;
  const int rp = tid >> 3, seg = tid & 7;
  f32x2 st[8];
#pragma unroll
  for (int k = 0; k < 8; k++) st[k] = (f32x2){0.f, 0.f};
  const int nch = T >> 5;
  Raw3 g_r, g_k, g_v, g_w, g_a;
#define SLOAD(chn)                                                                     \
  {                                                                                    \
    const int t0_ = dir ? T - 32 * ((chn) + 1) : 32 * (chn);                           \
    const int t_ = t0_ + pt;                                                           \
    const bool hp_ = t_ > 0, hn_ = t_ < T - 1;                                         \
    const u16* base_ = RW + (size_t)(start + t_) * 1920;                               \
    g_r = ld3(base_ + hc + pc, hp_, hn_); g_k = ld3(base_ + 512 + hc + pc, hp_, hn_);  \
    g_v = ld3(base_ + 1024 + hc + pc, hp_, hn_); g_w = ld3(base_ + wlo + pc, hp_, hn_); \
    g_a = ld3(base_ + alo + pc, hp_, hn_);                                             \
  }
  SLOAD(0)
  for (int ch = 0; ch < nch; ch++) {
    const int t0 = dir ? T - 32 * (ch + 1) : 32 * ch;
    bf16x8 lb0, lb1, lb2, lb3;
    {
      const int mat = wave >> 1, ntile = wave & 1;
      const u16* Bsrc = (mat ? a2t : w2t) + (size_t)(hc + 32 * ntile + (lane & 31)) * 64 + 8 * (lane >> 5);
      lb0 = *(const bf16x8*)(Bsrc); lb1 = *(const bf16x8*)(Bsrc + 16); lb2 = *(const bf16x8*)(Bsrc + 32); lb3 = *(const bf16x8*)(Bsrc + 48);
    }
    {
      float v[8];
      mixr(g_r, mpr, mnr, v);
#pragma unroll
      for (int j = 0; j < 8; j++) L[SC_R + pt * 64 + pc + j] = v[j];
      mixr(g_k, mpk, mnk, v);
#pragma unroll
      for (int j = 0; j < 8; j++) L[SC_K + pt * 64 + pc + j] = v[j];
      mixr(g_v, mpv, mnv, v);
#pragma unroll
      for (int j = 0; j < 8; j++) L[SC_V + pt * 64 + pc + j] = v[j];
      mixr(g_w, mpw, mnw, v);
      uint4 u;
      u.x = pack2(ftanh(v[0]), ftanh(v[1])); u.y = pack2(ftanh(v[2]), ftanh(v[3]));
      u.z = pack2(ftanh(v[4]), ftanh(v[5])); u.w = pack2(ftanh(v[6]), ftanh(v[7]));
      *(uint4*)(TWb + pt * 72 + pc) = u;
      mixr(g_a, mpa, mna, v);
      u.x = pack2(v[0], v[1]); u.y = pack2(v[2], v[3]); u.z = pack2(v[4], v[5]); u.w = pack2(v[6], v[7]);
      *(uint4*)(ALb + pt * 72 + pc) = u;
    }
    __syncthreads();
    {
      const int mat = wave >> 1, ntile = wave & 1;
      const u16* Asrc = (mat ? ALb : TWb) + (lane & 31) * 72 + 8 * (lane >> 5);
      f32x16 c;
#pragma unroll
      for (int r = 0; r < 16; r++) c[r] = 0.f;
      c = __builtin_amdgcn_mfma_f32_32x32x16_bf16(*(const bf16x8*)(Asrc), lb0, c, 0, 0, 0);
      c = __builtin_amdgcn_mfma_f32_32x32x16_bf16(*(const bf16x8*)(Asrc + 16), lb1, c, 0, 0, 0);
      c = __builtin_amdgcn_mfma_f32_32x32x16_bf16(*(const bf16x8*)(Asrc + 32), lb2, c, 0, 0, 0);
      c = __builtin_amdgcn_mfma_f32_32x32x16_bf16(*(const bf16x8*)(Asrc + 48), lb3, c, 0, 0, 0);
      float* dst = L + (mat ? SC_LA : SC_LW);
#pragma unroll
      for (int r = 0; r < 16; r++) {
        int tr = (r & 3) + 8 * (r >> 2) + 4 * (lane >> 5);
        dst[tr * 64 + 32 * ntile + (lane & 31)] = c[r];
      }
    }
    __syncthreads();
    {
      float ssk = 0.f, br = 0.f, kr = 0.f, bon = 0.f;
      float kkr[8], av[8], kdv[8], rr[8], dec[8];
#pragma unroll
      for (int j = 0; j < 8; j++) {
        int o = pt * 64 + pc + j;
        float r = L[SC_R + o], k = L[SC_K + o];
        float wp = cw0[j] + L[SC_LW + o];
        float z = -wp;
        float sp = z > 15.f ? z : 0.6931471805599453f * __builtin_amdgcn_logf(1.f + fexp(z));
        float w = -sp - 0.5f;
        dec[j] = fexp(-fexp(w));
        float a = fsigm(ca0[j] + L[SC_LA + o]);
        av[j] = a;
        kkr[j] = k * ckk[j];
        ssk += kkr[j] * kkr[j];
        kdv[j] = k * (1.f + (a - 1.f) * cka[j]);
        rr[j] = r;
        kr += kdv[j] * r;
        bon += r * kdv[j] * crk[j];
      }
      ssk = sum8(ssk);
      float inrm = __builtin_amdgcn_rsqf(fmaxf(ssk, 1e-24f));
#pragma unroll
      for (int j = 0; j < 8; j++) {
        float kk = kkr[j] * inrm;
        float b = kk * av[j];
        br += b * rr[j];
        int o = pt * 64 + pc + j;
        L[SC_KK + o] = kk;
        L[SC_BB + o] = b;
        L[SC_WR + o] = dec[j] * rr[j];
        L[SC_WD + o] = dec[j];
        L[SC_KD + o] = kdv[j];
      }
      br = sum8(br); kr = sum8(kr); bon = sum8(bon);
      if ((tid & 7) == 0) { L[SC_BR + pt] = br; L[SC_CKR + pt] = kr + bon; }
    }
    __syncthreads();
    if (ch + 1 < nch) SLOAD(ch + 1)
    {
#pragma unroll 1
      for (int qo = 0; qo < 4; qo++) {
        f32x2 yk = (f32x2){0.f, 0.f};
#pragma unroll
        for (int qi = 0; qi < 8; qi++) {
          const int q = qo * 8 + qi;
          const int tt = dir ? 31 - q : q;
          const float* ob = L + tt * 64 + 8 * seg;
          float4 kka = *(const float4*)(ob + SC_KK), kkb = *(const float4*)(ob + SC_KK + 4);
          float4 wra = *(const float4*)(ob + SC_WR), wrb = *(const float4*)(ob + SC_WR + 4);
          float4 wda = *(const float4*)(ob + SC_WD), wdb = *(const float4*)(ob + SC_WD + 4);
          float4 bba = *(const float4*)(ob + SC_BB), bbb = *(const float4*)(ob + SC_BB + 4);
          float4 kda = *(const float4*)(ob + SC_KD), kdb = *(const float4*)(ob + SC_KD + 4);
          float br = L[SC_BR + tt], ckr = L[SC_CKR + tt];
          float kk[8] = {kka.x, kka.y, kka.z, kka.w, kkb.x, kkb.y, kkb.z, kkb.w};
          float wr[8] = {wra.x, wra.y, wra.z, wra.w, wrb.x, wrb.y, wrb.z, wrb.w};
          float wd[8] = {wda.x, wda.y, wda.z, wda.w, wdb.x, wdb.y, wdb.z, wdb.w};
          float bb[8] = {bba.x, bba.y, bba.z, bba.w, bbb.x, bbb.y, bbb.z, bbb.w};
          float kd[8] = {kda.x, kda.y, kda.z, kda.w, kdb.x, kdb.y, kdb.z, kdb.w};
          if (NRG == 1) {
            float2 vv = *(const float2*)(L + SC_V + tt * 64 + 2 * rp);
            f32x2 v2 = (f32x2){vv.x, vv.y};
            f32x2 p1 = st[0] * kk[0], p2 = st[0] * wr[0];
#pragma unroll
            for (int k = 1; k < 8; k++) { p1 += st[k] * kk[k]; p2 += st[k] * wr[k]; }
            p1.x = sum8(p1.x); p1.y = sum8(p1.y); p2.x = sum8(p2.x); p2.y = sum8(p2.y);
            f32x2 y2 = p2 - p1 * br + v2 * ckr;
            if (qi == seg) yk = y2;
#pragma unroll
            for (int k = 0; k < 8; k++) st[k] = st[k] * wd[k] - p1 * bb[k] + v2 * kd[k];
          } else {
            const float v = L[SC_V + tt * 64 + 32 * rg + rp];
            f32x2 q1 = st[0] * (f32x2){kk[0], kk[1]}, q2 = st[0] * (f32x2){wr[0], wr[1]};
#pragma unroll
            for (int i = 1; i < 4; i++) {
              q1 += st[i] * (f32x2){kk[2 * i], kk[2 * i + 1]};
              q2 += st[i] * (f32x2){wr[2 * i], wr[2 * i + 1]};
            }
            const float p1 = sum8(q1.x + q1.y), p2 = sum8(q2.x + q2.y);
            const float y = p2 - p1 * br + v * ckr;
            if (qi == seg) yk.x = y;
#pragma unroll
            for (int i = 0; i < 4; i++)
              st[i] = st[i] * (f32x2){wd[2 * i], wd[2 * i + 1]} - p1 * (f32x2){bb[2 * i], bb[2 * i + 1]} + v * (f32x2){kd[2 * i], kd[2 * i + 1]};
          }
        }
        {
          const int q = qo * 8 + seg;
          const int tt = dir ? 31 - q : q;
          if (NRG == 1) *(float2*)(L + SC_Y + tt * 64 + 2 * rp) = make_float2(yk.x, yk.y);
          else L[SC_Y + tt * 64 + 32 * rg + rp] = yk.x;
        }
      }
    }
    __syncthreads();
    if (NRG == 1 || (pc >> 5) == rg) {
      const float* yp = L + SC_Y + pt * 64 + pc;
      uint4 u;
      u.x = pack2(yp[0], yp[1]); u.y = pack2(yp[2], yp[3]); u.z = pack2(yp[4], yp[5]); u.w = pack2(yp[6], yp[7]);
      *(uint4*)(Y + (size_t)(start + t0 + pt) * 512 + hc + pc) = u;
    }
  }
#undef SLOAD
}

__device__ __forceinline__ void phase4(const Params& P, unsigned char* ldsb) {
  __shared__ int s_item;
  unsigned* ctr = (unsigned*)(P.ws + OFF_CTL);
  u16* lds = (u16*)ldsb;
  u16* Q = (u16*)((unsigned char*)P.out + DO_Q);
  const u16* Kb = (const u16*)((unsigned char*)P.out + DO_K);
  const u16* Vt = (const u16*)((unsigned char*)P.out + DO_VT);
  u16* XQ = (u16*)(P.ws + OFF_XQ);
  const u16* MK = (const u16*)(P.ws + OFF_MK);
  const u16* MVT = (const u16*)(P.ws + OFF_MVT);
  const int total = 128 + 512 * 13;
  const float LOG2E = 1.4426950408889634f;
  while (true) {
    __syncthreads();
    if (threadIdx.x == 0) s_item = (int)atomicAdd(ctr, 1u);
    __syncthreads();
    const int q = s_item;
    if (q >= total) break;
    int kind, idx;
    if (q < 128) { kind = 0; idx = q; }
    else if (q < 640) { kind = 1; idx = q - 128; }
    else if (q < 640 + 2048) { kind = 2; idx = q - 640; }
    else { kind = 3; idx = q - 2688; }
    if (kind == 0) {
      int rg = idx & 1, dir = (idx >> 1) & 1, head = (idx >> 2) & 7, sl = idx >> 5;
      scan_item<2>(P, ldsb, 32 + sl, head, dir, rg);
    } else if (kind == 1) {
      int dir = idx & 1, head = (idx >> 1) & 7, sl = idx >> 4;
      scan_item<1>(P, ldsb, sl, head, dir, 0);
    } else if (kind <= 3) {
      int seq, head, qb, T, start;
      if (kind == 2) { seq = 32 + (idx >> 9); head = (idx >> 6) & 7; qb = idx & 63; T = 8192; start = NTP + (seq - 32) * 8192; }
      else { seq = idx >> 7; head = (idx >> 4) & 7; qb = idx & 15; T = 2048; start = seq * 2048; }
      const size_t tok0 = (size_t)start + qb * 128;
      attn_item<96, 64, true, true>(lds, Q + tok0 * 768 + head * 96, 768, Kb + (size_t)start * 768 + head * 96, 768,
                              Vt + vt_base(seq) + (size_t)head * 64 * T, T, T, P.in[10],
                              0.10206207261596577f * LOG2E, qb * 128, Q + tok0 * 768 + head * 96, 768);
    }
  }
#ifdef SCANREP
  __syncthreads();
  for (int idx = blockIdx.x; idx < 576; idx += gridDim.x) {
    int dir = idx & 1, head = (idx >> 1) & 7, sl = idx >> 4;
    __syncthreads();
    scan_item<1>(P, ldsb, sl, head, dir, 0);
  }
#endif
  __syncthreads();
  for (int idx = blockIdx.x; idx < 3072; idx += gridDim.x) {
    int mt = idx >> 2, head = idx & 3;
    int seq, start, T;
    tok_seq(mt * 128, seq, start, T);
    const size_t tok0 = (size_t)mt * 128;
    attn_item<128, 128, false, false>(lds, XQ + tok0 * 512 + head * 128, 512, MK + (size_t)(seq * 4 + head) * 256 * 128, 128,
                                      MVT + (size_t)(seq * 4 + head) * 128 * 256, 256, 256, P.in[32],
                                      0.08838834764831845f * LOG2E, 0, XQ + tok0 * 512 + head * 128, 512);
  }
}

__device__ __forceinline__ void phase5(const Params& P, u16* lds) {
  __shared__ float st_mean[256], st_rstd[256];
  unsigned char* ws = P.ws;
  const u16* RW = (const u16*)(ws + OFF_RW);
  const u16* YF = (const u16*)(ws + OFF_YF);
  u16* YB = (u16*)(ws + OFF_YB);
  const u16* G2 = (const u16*)(ws + OFF_G2);
  const float* mup = P.in[13] + 1792;
  const float* mun = P.in[14] + 1792;
  const float* lng = P.in[27];
  const float* lnb = P.in[28];
  const int tid = threadIdx.x;
  for (int it = blockIdx.x; it < 768 * 4; it += gridDim.x) {
    int mt = it >> 2, nt = it & 3;
    int m0 = mt * 128, n0 = nt * 128;
    int seq, start, T;
    tok_seq(m0, seq, start, T);
    {
      int r = tid >> 1, hh = tid & 1;
      const u16* pf = YF + (size_t)(m0 + r) * 512 + n0 + hh * 64;
      const u16* pb = YB + (size_t)(m0 + r) * 512 + n0 + hh * 64;
      float sm = 0.f, sq = 0.f;
      for (int c = 0; c < 8; c++) {
        uint4 a = *(const uint4*)(pf + 8 * c), b = *(const uint4*)(pb + 8 * c);
        float y;
        y = bflo(a.x) + bflo(b.x); sm += y; sq += y * y; y = bfhi(a.x) + bfhi(b.x); sm += y; sq += y * y;
        y = bflo(a.y) + bflo(b.y); sm += y; sq += y * y; y = bfhi(a.y) + bfhi(b.y); sm += y; sq += y * y;
        y = bflo(a.z) + bflo(b.z); sm += y; sq += y * y; y = bfhi(a.z) + bfhi(b.z); sm += y; sq += y * y;
        y = bflo(a.w) + bflo(b.w); sm += y; sq += y * y; y = bfhi(a.w) + bfhi(b.w); sm += y; sq += y * y;
      }
      float mean = sm * (1.f / 64.f);
      float var = fmaxf(sq * (1.f / 64.f) - mean * mean, 0.f);
      st_mean[tid] = mean;
      st_rstd[tid] = rsqrtf(var + 64e-5f);
    }
    {
      const int lr = tid >> 3, lk = (tid & 7) * 8;
#pragma unroll
      for (int kb = 0; kb < 2; kb++) {
#pragma unroll
        for (int i = 0; i < 4; i++) {
          int r = lr + 32 * i;
          int t = m0 + r - start;
          float v[8];
          mix8(RW + (size_t)(m0 + r) * 1920 + 1792 + kb * 64 + lk, t > 0, t < T - 1, mup + kb * 64 + lk, mun + kb * 64 + lk, v);
          uint4 u;
          u.x = pack2(sigmoidf_(v[0]), sigmoidf_(v[1])); u.y = pack2(sigmoidf_(v[2]), sigmoidf_(v[3]));
          u.z = pack2(sigmoidf_(v[4]), sigmoidf_(v[5])); u.w = pack2(sigmoidf_(v[6]), sigmoidf_(v[7]));
          *(uint4*)(lds + kb * (2 * LTILE) + r * LROW + lk) = u;
          *(uint4*)(lds + kb * (2 * LTILE) + LTILE + r * LROW + lk) = *(const uint4*)(G2 + (size_t)(n0 + r) * 128 + kb * 64 + lk);
        }
      }
    }
    __syncthreads();
    Acc acc; acc_zero(acc);
    gemm_compute(acc, lds, 0);
    gemm_compute(acc, lds, 1);
    epi_each(acc, [&](int r0, int c, float v0, float v1, float v2, float v3) {
      int hh = c >> 6;
      float g = lng[n0 + c], b = lnb[n0 + c];
      float vv[4] = {v0, v1, v2, v3};
#pragma unroll
      for (int k = 0; k < 4; k++) {
        size_t o = (size_t)(m0 + r0 + k) * 512 + n0 + c;
        float y = bf2f(YF[o]) + bf2f(YB[o]);
        int si = (r0 + k) * 2 + hh;
        float yn = (y - st_mean[si]) * st_rstd[si] * g + b;
        YB[o] = f2bf(yn * vv[k]);
      }
    });
    __syncthreads();
  }
}

__device__ __forceinline__ void merge_branch(Acc& mg, u16* lds, const u16* Hrow, const u16* Wg_rows, const u16* Abr,
                                             const u16* Wbr, int Kb) {
  unsigned* G = (unsigned*)(lds + 2 * LTILE);
  {
    Acc acc; acc_zero(acc);
    gemm_lin<false, false>(acc, lds, Hrow, 1024, Wg_rows, 1024, 1024);
#pragma unroll
    for (int i = 0; i < 2; i++)
#pragma unroll
      for (int j = 0; j < 2; j++)
#pragma unroll
        for (int r = 0; r < 8; r++)
          G[((i * 2 + j) * 8 + r) * 256 + threadIdx.x] = pack2(sigmoidf_(acc.a[i][j][2 * r]), sigmoidf_(acc.a[i][j][2 * r + 1]));
  }
  Acc acc; acc_zero(acc);
  gemm_lin<true, false>(acc, lds, Abr, Kb, Wbr, Kb, Kb);
#pragma unroll
  for (int i = 0; i < 2; i++)
#pragma unroll
    for (int j = 0; j < 2; j++)
#pragma unroll
      for (int r = 0; r < 8; r++) {
        unsigned g = G[((i * 2 + j) * 8 + r) * 256 + threadIdx.x];
        mg.a[i][j][2 * r] += bflo(g) * acc.a[i][j][2 * r];
        mg.a[i][j][2 * r + 1] += bfhi(g) * acc.a[i][j][2 * r + 1];
      }
  __syncthreads();
}
__device__ __forceinline__ void phase6(const Params& P, u16* lds) {
  unsigned char* ws = P.ws;
  const u16* H = (const u16*)(ws + OFF_H);
  const u16* Wg = (const u16*)(ws + OFF_WIN) + (size_t)3200 * 1024;
  u16* MG = (u16*)(ws + OFF_MERGED);
  const u16* A0 = (const u16*)((unsigned char*)P.out + DO_Q);
  const u16* A1 = (const u16*)(ws + OFF_YB);
  const u16* A2 = (const u16*)(ws + OFF_XQ);
  const u16* W0 = (const u16*)(ws + OFF_WOA);
  const u16* W1 = (const u16*)(ws + OFF_WOB);
  const u16* W2 = (const u16*)(ws + OFF_WOC);
  for (int kk_ = 0;; kk_++) {
    int mt, nt;
    if (!tile_map(kk_, 768, 8, mt, nt)) break;
    int m0 = mt * 128, n0 = nt * 128;
    Acc mg; acc_zero(mg);
    const u16* Hrow = H + (size_t)m0 * 1024;
#pragma nounroll
    for (int br = 0; br < 3; br++) {
      const u16* Ab = br == 0 ? A0 + (size_t)m0 * 768 : (br == 1 ? A1 + (size_t)m0 * 512 : A2 + (size_t)m0 * 512);
      const u16* Wb = br == 0 ? W0 + (size_t)n0 * 768 : (br == 1 ? W1 + (size_t)n0 * 512 : W2 + (size_t)n0 * 512);
      merge_branch(mg, lds, Hrow, Wg + (size_t)(br * 1024 + n0) * 1024, Ab, Wb, br == 0 ? 768 : 512);
    }
    epi_each(mg, [&](int r0, int c, float v0, float v1, float v2, float v3) {
      u16* dst = MG + (size_t)(m0 + r0) * 1024 + n0 + c;
      dst[0] = f2bf(v0); dst[1024] = f2bf(v1); dst[2048] = f2bf(v2); dst[3072] = f2bf(v3);
    });
  }
}

__device__ __forceinline__ void phase7(const Params& P, u16* lds) {
  unsigned char* ws = P.ws;
  const u16* MG = (const u16*)(ws + OFF_MERGED);
  const u16* W = (const u16*)(ws + OFF_WOUT);
  for (int kk_ = 0;; kk_++) {
    int mt, nt;
    if (!tile_map(kk_, 768, 8, mt, nt)) break;
    int m0 = mt * 128, n0 = nt * 128;
    Acc acc; acc_zero(acc);
    gemm_lin(acc, lds, MG + (size_t)m0 * 1024, 1024, W + (size_t)n0 * 1024, 1024, 1024);
    const float* xin = m0 < NTP ? P.in[0] + (size_t)m0 * 1024 : P.in[1] + (size_t)(m0 - NTP) * 1024;
    float* xo = P.out + (size_t)m0 * 1024;
    epi_each(acc, [&](int r0, int c, float v0, float v1, float v2, float v3) {
      size_t o = (size_t)r0 * 1024 + n0 + c;
      xo[o] = xin[o] + v0; xo[o + 1024] = xin[o + 1024] + v1; xo[o + 2048] = xin[o + 2048] + v2; xo[o + 3072] = xin[o + 3072] + v3;
    });
  }
}

__device__ __forceinline__ void phase8(const Params& P) {
  const int wave = threadIdx.x >> 6;
  u16* H = (u16*)(P.ws + OFF_H);
  for (int row = blockIdx.x * 4 + wave; row < NT; row += gridDim.x * 4)
    norm_row(P.out + (size_t)row * 1024, H + (size_t)row * 1024);
}

__device__ __forceinline__ float erf_as(float x) {
  const float ax = fabsf(x);
  const float t = __builtin_amdgcn_rcpf(1.f + 0.3275911f * ax);
  const float y = ((((1.061405429f * t - 1.453152027f) * t + 1.421413741f) * t - 0.284496736f) * t + 0.254829592f) * t;
  const float r = 1.f - y * __builtin_amdgcn_exp2f(-ax * ax * 1.4426950408889634f);
  return copysignf(r, x);
}
__device__ __forceinline__ void phase9(const Params& P, u16* lds) {
  unsigned char* ws = P.ws;
  const u16* H = (const u16*)(ws + OFF_H);
  const u16* W = (const u16*)(ws + OFF_WUP);
  u16* ACT = (u16*)(ws + OFF_ACT);
  const float* cw = P.in[38];
  const float* cb = P.in[39];
  float* Lf = (float*)lds;
  const int tid = threadIdx.x, lane = tid & 63, wave = tid >> 6, wm = wave >> 1, wn = wave & 1;
  for (int kk_ = 0;; kk_++) {
    int mt, nt;
    if (!tile_map(kk_, 808, 44, mt, nt)) break;
    int start, T, ti;
    if (mt < 544) { int s = mt / 17; ti = mt % 17; start = s * 2048; T = 2048; }
    else { int m2 = mt - 544; int s = m2 / 66; ti = m2 % 66; start = NTP + s * 8192; T = 8192; }
    const int p0 = 126 * ti - 1;
    const int lr = tid >> 3;
    const u16* pa[4];
#pragma unroll
    for (int i = 0; i < 4; i++) {
      int p = p0 + lr + 32 * i;
      p = p < 0 ? 0 : (p > T - 1 ? T - 1 : p);
      pa[i] = H + (size_t)(start + p) * 1024;
    }
    const u16* Bt = W + (size_t)nt * 128 * 1024;
    Acc acc; acc_zero(acc);
    gemm_main(acc, lds, pa[0], pa[1], pa[2], pa[3], Bt + (size_t)lr * 1024, Bt + (size_t)(lr + 32) * 1024,
              Bt + (size_t)(lr + 64) * 1024, Bt + (size_t)(lr + 96) * 1024, 1024);
    {
      float* dst = Lf + wn * 8192;
#pragma unroll
      for (int i = 0; i < 2; i++)
#pragma unroll
        for (int j = 0; j < 2; j++)
#pragma unroll
          for (int r = 0; r < 16; r++) {
            int rr = 64 * wm + 32 * i + (r & 3) + 8 * (r >> 2) + 4 * (lane >> 5);
            dst[rr * 64 + 32 * j + (lane & 31)] = acc.a[i][j][r];
          }
    }
    __syncthreads();
    {
      const int c = tid & 63, rgp = tid >> 6;
      const int col = nt * 64 + c;
      const float w0 = cw[col], w1 = cw[2816 + col], w2 = cw[2 * 2816 + col], bb = cb[col];
      int rbeg = rgp * 32; if (rbeg < 1) rbeg = 1;
      int rend = rgp * 32 + 32; if (rend > 127) rend = 127;
      auto gval = [&](int r) { int p = p0 + r; return (p >= 0 && p < T) ? Lf[r * 64 + c] : 0.f; };
      float gp = gval(rbeg - 1), gc = gval(rbeg);
      for (int r = rbeg; r < rend; r++) {
        float gn = gval(r + 1);
        int p = p0 + r;
        if (p < T) {
          float cc = w0 * gp + w1 * gc + w2 * gn + bb;
          float a = 0.5f * cc * (1.f + erf_as(cc * 0.70710678118654752f)) * Lf[8192 + r * 64 + c];
          ACT[(size_t)(start + p) * 2816 + col] = f2bf(a);
        }
        gp = gc; gc = gn;
      }
    }
    __syncthreads();
  }
}

__device__ __forceinline__ void phase10(const Params& P, u16* lds) {
  unsigned char* ws = P.ws;
  const u16* ACT = (const u16*)(ws + OFF_ACT);
  const u16* W = (const u16*)(ws + OFF_WDOWN);
  for (int kk_ = 0;; kk_++) {
    int mt, nt;
    if (!tile_map(kk_, 768, 8, mt, nt)) break;
    int m0 = mt * 128, n0 = nt * 128;
    Acc acc; acc_zero(acc);
    gemm_lin(acc, lds, ACT + (size_t)m0 * 2816, 2816, W + (size_t)n0 * 2816, 2816, 2816);
    float* xo = P.out + (size_t)m0 * 1024;
    epi_each(acc, [&](int r0, int c, float v0, float v1, float v2, float v3) {
      size_t o = (size_t)r0 * 1024 + n0 + c;
      xo[o] += v0; xo[o + 1024] += v1; xo[o + 2048] += v2; xo[o + 3072] += v3;
    });
  }
}

constexpr int NPHASE = 11;
__global__ void __launch_bounds__(NTHREADS, 2) fwd_kernel(Params P) {
  extern __shared__ __attribute__((aligned(16))) unsigned char dlds[];
  cg::grid_group grid = cg::this_grid();
  u16* lds = (u16*)dlds;
#ifndef REPMASK
#define REPMASK 0
#endif
#define PH(k, call)                                   \
  if (P.lo <= (k) && (k) < P.hi) {                    \
    call;                                             \
    if ((REPMASK >> (k)) & 1) { grid.sync(); call; }  \
    if ((k) + 1 < P.hi) grid.sync();                  \
  }
  PH(0, (phase0(P), phase0b(P)))
  PH(1, phase1(P, lds))
  PH(2, phase2(P, lds))
  PH(3, phase3(P))
  PH(4, phase4(P, dlds))
  PH(5, phase5(P, lds))
  PH(6, phase6(P, lds))
  PH(7, phase7(P, lds))
  PH(8, phase8(P))
  PH(9, phase9(P, lds))
  PH(10, phase10(P, lds))
#undef PH
}

extern "C" void kernel_launch(void* const* d_in, const int* in_sizes, int n_in, void* d_out, int out_size, void* d_ws,
                              size_t ws_size, hipStream_t stream) {
  static int grid_blocks = 0;
  if (!grid_blocks) {
    int dev = 0, cus = 0, per_cu = 0;
    hipGetDevice(&dev);
    hipDeviceGetAttribute(&cus, hipDeviceAttributeMultiprocessorCount, dev);
    hipFuncSetAttribute((const void*)fwd_kernel, hipFuncAttributeMaxDynamicSharedMemorySize, LDS_BYTES);
    hipOccupancyMaxActiveBlocksPerMultiprocessor(&per_cu, (const void*)fwd_kernel, NTHREADS, LDS_BYTES);
    if (per_cu < 1) per_cu = 1;
    if (per_cu > 2) per_cu = 2;
    grid_blocks = cus * per_cu;
    if (ws_size < WS_END) fprintf(stderr, "workspace too small: %zu < %zu\n", ws_size, (size_t)WS_END);
  }
  if (ws_size < WS_END) return;
  Params p{};
  for (int i = 0; i < 41; i++) p.in[i] = (const float*)d_in[i];
  p.out = (float*)d_out;
  p.ws = (unsigned char*)d_ws;
#if MEGA
  p.lo = 0; p.hi = NPHASE;
  void* args[] = {&p};
  hipError_t e = hipLaunchCooperativeKernel((const void*)fwd_kernel, dim3(grid_blocks), dim3(NTHREADS), args, LDS_BYTES, stream);
  if (e != hipSuccess) fprintf(stderr, "cooperative launch failed: %s (grid %d)\n", hipGetErrorString(e), grid_blocks);
#else
#ifndef PHMAX
#define PHMAX 11
#endif
  for (int k = 0; k < PHMAX; k++) {
    p.lo = k; p.hi = k + 1;
    hipLaunchKernelGGL(fwd_kernel, dim3(grid_blocks), dim3(NTHREADS), LDS_BYTES, stream, p);
  }
#endif
}
```

```cpp
#include <hip/hip_runtime.h>
#include <hip/hip_cooperative_groups.h>
#include <cstdio>
#include <cstdint>
namespace cg = cooperative_groups;

typedef unsigned short u16;
typedef __attribute__((ext_vector_type(8))) short bf16x8;
typedef __attribute__((ext_vector_type(16))) float f32x16;

#ifndef MEGA
#define MEGA 1
#endif

constexpr int NT = 98304;
constexpr int NTP = 65536;
constexpr int NMEMROWS = 9216;
constexpr int NTHREADS = 256;
constexpr int LDS_BYTES = 73728;

constexpr size_t OFF_CTL = 0;
constexpr size_t OFF_WIN = 4096;
constexpr size_t OFF_WUQ = OFF_WIN + (size_t)6272 * 1024 * 2;
constexpr size_t OFF_WUKV = OFF_WUQ + (size_t)768 * 384 * 2;
constexpr size_t OFF_WOA = OFF_WUKV + (size_t)1024 * 256 * 2;
constexpr size_t OFF_WOB = OFF_WOA + (size_t)1024 * 768 * 2;
constexpr size_t OFF_WOC = OFF_WOB + (size_t)1024 * 512 * 2;
constexpr size_t OFF_WMKV = OFF_WOC + (size_t)1024 * 512 * 2;
constexpr size_t OFF_WOUT = OFF_WMKV + (size_t)2048 * 1024 * 2;
constexpr size_t OFF_WUP = OFF_WOUT + (size_t)1024 * 1024 * 2;
constexpr size_t OFF_WDOWN = OFF_WUP + (size_t)5632 * 1024 * 2;
constexpr size_t OFF_G2 = OFF_WDOWN + (size_t)1024 * 2816 * 2;
constexpr size_t OFF_W2F = OFF_G2 + (size_t)512 * 128 * 2;
constexpr size_t OFF_W2B = OFF_W2F + 65536;
constexpr size_t OFF_A2F = OFF_W2B + 65536;
constexpr size_t OFF_A2B = OFF_A2F + 65536;
constexpr size_t OFF_H = 50331648;
static_assert(OFF_A2B + 65536 <= OFF_H, "weights overflow");
constexpr size_t OFF_CQKV = OFF_H + (size_t)NT * 1024 * 2;
constexpr size_t OFF_RW = OFF_CQKV + (size_t)NT * 672 * 2;
constexpr size_t OFF_XQ = OFF_RW + (size_t)NT * 1920 * 2;
constexpr size_t OFF_MH = OFF_XQ + (size_t)NT * 512 * 2;
constexpr size_t OFF_MKV = OFF_MH + (size_t)NMEMROWS * 1024 * 2;
constexpr size_t OFF_MK = OFF_MKV + (size_t)NMEMROWS * 2048 * 2;
constexpr size_t OFF_MVT = OFF_MK + (size_t)NMEMROWS * 512 * 2;
constexpr size_t OFF_YB = OFF_MVT + (size_t)NMEMROWS * 512 * 2;
constexpr size_t WS_END = OFF_YB + (size_t)NT * 512 * 2;
static_assert(WS_END <= (size_t)1073741824, "workspace overflow");
constexpr size_t OFF_YF = OFF_CQKV;
constexpr size_t OFF_MERGED = OFF_RW;
constexpr size_t OFF_ACT = OFF_CQKV;
static_assert((size_t)NT * 2816 * 2 <= OFF_MH - OFF_CQKV, "act overflow");
constexpr size_t DO_Q = 0;
constexpr size_t DO_K = (size_t)NT * 768 * 2;
constexpr size_t DO_VT = DO_K + (size_t)NT * 768 * 2;

struct Params {
  const float* in[41];
  float* out;
  unsigned char* ws;
  int lo, hi;
};

typedef __bf16 bf16x2_t __attribute__((ext_vector_type(2)));
typedef float f32x2_t __attribute__((ext_vector_type(2)));
__device__ __forceinline__ unsigned pack2(float a, float b) {
  f32x2_t f = {a, b};
  bf16x2_t h = __builtin_convertvector(f, bf16x2_t);
  return __builtin_bit_cast(unsigned, h);
}
__device__ __forceinline__ u16 f2bf(float f) { return (u16)(pack2(f, f) & 0xffffu); }
__device__ __forceinline__ float bf2f(u16 b) { return __uint_as_float(((unsigned)b) << 16); }
__device__ __forceinline__ float bflo(unsigned u) { return __uint_as_float(u << 16); }
__device__ __forceinline__ float bfhi(unsigned u) { return __uint_as_float(u & 0xffff0000u); }

template <int CTRL>
__device__ __forceinline__ float dppf(float v) {
  return __int_as_float(__builtin_amdgcn_mov_dpp(__float_as_int(v), CTRL, 0xF, 0xF, true));
}
__device__ __forceinline__ float sum16(float v) {
  v += dppf<0xB1>(v);
  v += dppf<0x4E>(v);
  v += dppf<0x141>(v);
  v += dppf<0x140>(v);
  return v;
}
__device__ __forceinline__ float sum8(float v) {
  v += dppf<0xB1>(v);
  v += dppf<0x4E>(v);
  v += dppf<0x141>(v);
  return v;
}
__device__ __forceinline__ float wave_sum(float v) {
  v = sum16(v);
  v += __shfl_xor(v, 16);
  v += __shfl_xor(v, 32);
  return v;
}
__device__ __forceinline__ float sigmoidf_(float x) { return 1.f / (1.f + __expf(-x)); }

__device__ __forceinline__ void tok_seq(int g, int& seq, int& start, int& T) {
  if (g < NTP) { seq = g >> 11; start = seq << 11; T = 2048; }
  else { int s = (g - NTP) >> 13; seq = 32 + s; start = NTP + (s << 13); T = 8192; }
}
__device__ __forceinline__ size_t vt_base(int seq) {
  return seq < 32 ? (size_t)seq * (512 * 2048) : (size_t)32 * 512 * 2048 + (size_t)(seq - 32) * (512 * 8192);
}

struct Acc { f32x16 a[2][2]; };
constexpr int LROW = 72;
constexpr int LTILE = 128 * LROW;

__device__ __forceinline__ void acc_zero(Acc& acc) {
#pragma unroll
  for (int i = 0; i < 2; i++)
#pragma unroll
    for (int j = 0; j < 2; j++)
#pragma unroll
      for (int r = 0; r < 16; r++) acc.a[i][j][r] = 0.f;
}

__device__ __forceinline__ void gemm_compute(Acc& acc, const u16* lds, int b) {
  const int lane = threadIdx.x & 63, wave = threadIdx.x >> 6, wm = wave >> 1, wn = wave & 1;
  const u16* A = lds + b * (2 * LTILE) + (64 * wm + (lane & 31)) * LROW + 8 * (lane >> 5);
  const u16* B = lds + b * (2 * LTILE) + LTILE + (64 * wn + (lane & 31)) * LROW + 8 * (lane >> 5);
#pragma unroll
  for (int s = 0; s < 4; s++) {
    bf16x8 a0 = *(const bf16x8*)(A + 16 * s);
    bf16x8 a1 = *(const bf16x8*)(A + 32 * LROW + 16 * s);
    bf16x8 b0 = *(const bf16x8*)(B + 16 * s);
    bf16x8 b1 = *(const bf16x8*)(B + 32 * LROW + 16 * s);
    acc.a[0][0] = __builtin_amdgcn_mfma_f32_32x32x16_bf16(a0, b0, acc.a[0][0], 0, 0, 0);
    acc.a[0][1] = __builtin_amdgcn_mfma_f32_32x32x16_bf16(a0, b1, acc.a[0][1], 0, 0, 0);
    acc.a[1][0] = __builtin_amdgcn_mfma_f32_32x32x16_bf16(a1, b0, acc.a[1][0], 0, 0, 0);
    acc.a[1][1] = __builtin_amdgcn_mfma_f32_32x32x16_bf16(a1, b1, acc.a[1][1], 0, 0, 0);
  }
}

template <bool SINGLE = false, bool DEEP = true>
__device__ __forceinline__ void gemm_main(Acc& acc, u16* lds, const u16* pa0, const u16* pa1, const u16* pa2,
                                          const u16* pa3, const u16* pb0, const u16* pb1, const u16* pb2,
                                          const u16* pb3, int K) {
  const int tid = threadIdx.x;
  const int lr = tid >> 3, lk = (tid & 7) * 8;
  uint4 xa0, xa1, xa2, xa3, xb0, xb1, xb2, xb3;
  uint4 ya0, ya1, ya2, ya3, yb0, yb1, yb2, yb3;
  const int nk = K >> 6;
#define GLOAD(S, k0)                                                                         \
  S##a0 = *(const uint4*)(pa0 + (k0) + lk); S##a1 = *(const uint4*)(pa1 + (k0) + lk);         \
  S##a2 = *(const uint4*)(pa2 + (k0) + lk); S##a3 = *(const uint4*)(pa3 + (k0) + lk);         \
  S##b0 = *(const uint4*)(pb0 + (k0) + lk); S##b1 = *(const uint4*)(pb1 + (k0) + lk);         \
  S##b2 = *(const uint4*)(pb2 + (k0) + lk); S##b3 = *(const uint4*)(pb3 + (k0) + lk);
#define SSTORE(S, b)                                                                         \
  {                                                                                          \
    u16* A_ = lds + (b) * (2 * LTILE) + lr * LROW + lk;                                      \
    u16* B_ = A_ + LTILE;                                                                    \
    *(uint4*)(A_) = S##a0; *(uint4*)(A_ + 32 * LROW) = S##a1;                                \
    *(uint4*)(A_ + 64 * LROW) = S##a2; *(uint4*)(A_ + 96 * LROW) = S##a3;                    \
    *(uint4*)(B_) = S##b0; *(uint4*)(B_ + 32 * LROW) = S##b1;                                \
    *(uint4*)(B_ + 64 * LROW) = S##b2; *(uint4*)(B_ + 96 * LROW) = S##b3;                    \
  }
  if (!DEEP) {
    GLOAD(x, 0)
    SSTORE(x, 0)
    __syncthreads();
    for (int kt = 0; kt < nk; kt++) {
      if (kt + 1 < nk) { GLOAD(x, (kt + 1) * 64) }
      gemm_compute(acc, lds, SINGLE ? 0 : (kt & 1));
      if (SINGLE) __syncthreads();
      if (kt + 1 < nk) { SSTORE(x, SINGLE ? 0 : ((kt + 1) & 1)) }
      __syncthreads();
    }
    return;
  }
  GLOAD(x, 0)
  GLOAD(y, 64)
  SSTORE(x, 0)
  __syncthreads();
  for (int kt = 0; kt < nk; kt += 2) {
    if (kt + 2 < nk) { GLOAD(x, (kt + 2) * 64) }
    __builtin_amdgcn_sched_barrier(0);
    gemm_compute(acc, lds, 0);
    if (SINGLE) __syncthreads();
    SSTORE(y, SINGLE ? 0 : 1)
    __syncthreads();
    if (kt + 3 < nk) { GLOAD(y, (kt + 3) * 64) }
    __builtin_amdgcn_sched_barrier(0);
    gemm_compute(acc, lds, SINGLE ? 0 : 1);
    if (SINGLE) __syncthreads();
    if (kt + 2 < nk) { SSTORE(x, 0) }
    __syncthreads();
  }
#undef GLOAD
#undef SSTORE
}

template <bool SINGLE = false, bool DEEP = true>
__device__ __forceinline__ void gemm_lin(Acc& acc, u16* lds, const u16* A, long lda, const u16* B, long ldb, int K) {
  const int lr = threadIdx.x >> 3;
  gemm_main<SINGLE, DEEP>(acc, lds, A + (long)lr * lda, A + (long)(lr + 32) * lda, A + (long)(lr + 64) * lda,
            A + (long)(lr + 96) * lda, B + (long)lr * ldb, B + (long)(lr + 32) * ldb, B + (long)(lr + 64) * ldb,
            B + (long)(lr + 96) * ldb, K);
}

template <class F>
__device__ __forceinline__ void epi_each(const Acc& acc, F f) {
  const int lane = threadIdx.x & 63, wave = threadIdx.x >> 6, wm = wave >> 1, wn = wave & 1;
#pragma unroll
  for (int i = 0; i < 2; i++)
#pragma unroll
    for (int j = 0; j < 2; j++)
#pragma unroll
      for (int g = 0; g < 4; g++) {
        int r0 = 64 * wm + 32 * i + 8 * g + 4 * (lane >> 5);
        int c = 64 * wn + 32 * j + (lane & 31);
        f(r0, c, acc.a[i][j][4 * g + 0], acc.a[i][j][4 * g + 1], acc.a[i][j][4 * g + 2], acc.a[i][j][4 * g + 3]);
      }
}

__device__ __forceinline__ void store_bf16_pairs(u16* colbase, long ld, int c, float v0, float v1, float v2, float v3) {
  const bool odd = c & 1;
  const float sA = odd ? v0 : v2, sB = odd ? v1 : v3;
  const float rA = dppf<0xB1>(sA), rB = dppf<0xB1>(sB);
  if (!odd) {
    *(unsigned*)(colbase) = pack2(v0, rA);
    *(unsigned*)(colbase + ld) = pack2(v1, rB);
  } else {
    *(unsigned*)(colbase + 2 * ld - 1) = pack2(rA, v2);
    *(unsigned*)(colbase + 3 * ld - 1) = pack2(rB, v3);
  }
}

__device__ __forceinline__ bool tile_map(int k, int MT, int NTL, int& mt, int& nt) {
  const int G = gridDim.x;
  if (G & 7) {
    int it = blockIdx.x + k * G;
    if (it >= MT * NTL) return false;
    mt = it / NTL; nt = it % NTL;
    return true;
  }
  const int xcd = blockIdx.x & 7, lb = blockIdx.x >> 3, nbx = G >> 3;
  const int mtx0 = (MT * xcd) >> 3, mtx1 = (MT * (xcd + 1)) >> 3, MTX = mtx1 - mtx0;
  const int idx = lb + k * nbx;
  if (idx >= MTX * NTL) return false;
  const int mg0 = idx / (8 * NTL);
  const int base = mg0 * 8;
  const int gsz = (MTX - base) < 8 ? (MTX - base) : 8;
  const int rem = idx - mg0 * 8 * NTL;
  nt = rem / gsz;
  mt = mtx0 + base + rem % gsz;
  return true;
}

template <class NMap, class KMap>
__device__ __forceinline__ void cvtw(const float* __restrict__ W, int srcN, u16* __restrict__ Wt, int dN, int dK,
                     const float* __restrict__ gain, NMap nmap, KMap kmap, long gtid, long gsz) {
  const int kch = dK >> 3;
  const long total = (long)dN * kch;
  for (long i = gtid; i < total; i += gsz) {
    int n = (int)(i % dN), kc = (int)(i / dN);
    int sn = nmap(n);
    float v[8];
#pragma unroll
    for (int j = 0; j < 8; j++) {
      int sk = kmap(kc * 8 + j);
      float x = 0.f;
      if (sn >= 0 && sk >= 0) {
        x = W[(long)sk * srcN + sn];
        if (gain) x *= gain[sk];
      }
      v[j] = x;
    }
    uint4 o;
    o.x = pack2(v[0], v[1]); o.y = pack2(v[2], v[3]); o.z = pack2(v[4], v[5]); o.w = pack2(v[6], v[7]);
    *(uint4*)(Wt + (long)n * dK + kc * 8) = o;
  }
}

__device__ __forceinline__ void phase0(const Params& P) {
  const long gtid = (long)blockIdx.x * NTHREADS + threadIdx.x, gsz = (long)gridDim.x * NTHREADS;
  unsigned char* ws = P.ws;
  if (gtid == 0) { ((unsigned*)(ws + OFF_CTL))[0] = 0u; }
  auto idn = [](int n) { return n; };
  cvtw(P.in[5], 6176, (u16*)(ws + OFF_WIN), 6272, 1024, P.in[4],
       [](int n) {
         if (n < 640) return n;
         if (n < 2560) return 672 + (n - 640);
         if (n < 3072) return 2592 + (n - 2560);
         if (n < 3104) return 640 + (n - 3072);
         if (n < 3200) return -1;
         return 3104 + (n - 3200);
       },
       idn, gtid, gsz);
  cvtw(P.in[7], 768, (u16*)(ws + OFF_WUQ), 768, 384, P.in[6], idn, idn, gtid, gsz);
  cvtw(P.in[9], 1024, (u16*)(ws + OFF_WUKV), 1024, 256, P.in[8], idn, idn, gtid, gsz);
  cvtw(P.in[12], 1024, (u16*)(ws + OFF_WOA), 1024, 768, nullptr, idn,
       [](int k) { int h = k / 96, d = k % 96; return d < 64 ? h * 64 + d : -1; }, gtid, gsz);
  cvtw(P.in[29], 1024, (u16*)(ws + OFF_WOB), 1024, 512, nullptr, idn, idn, gtid, gsz);
  cvtw(P.in[34], 1024, (u16*)(ws + OFF_WOC), 1024, 512, nullptr, idn, idn, gtid, gsz);
  cvtw(P.in[31], 1024, (u16*)(ws + OFF_WMKV), 1024, 1024, P.in[30], idn, idn, gtid, gsz);
  cvtw(P.in[35], 1024, (u16*)(ws + OFF_WOUT), 1024, 1024, nullptr, idn, idn, gtid, gsz);
  cvtw(P.in[37], 5632, (u16*)(ws + OFF_WUP), 5632, 1024, P.in[36],
       [](int n) { int t = n >> 7, w = n & 127; return w < 64 ? t * 64 + w : 2816 + t * 64 + (w - 64); }, idn, gtid, gsz);
  cvtw(P.in[40], 1024, (u16*)(ws + OFF_WDOWN), 1024, 2816, nullptr, idn, idn, gtid, gsz);
  cvtw(P.in[23], 512, (u16*)(ws + OFF_G2), 512, 128, nullptr, idn, idn, gtid, gsz);
  cvtw(P.in[16], 512, (u16*)(ws + OFF_W2F), 512, 64, nullptr, idn, idn, gtid, gsz);
  cvtw(P.in[20], 512, (u16*)(ws + OFF_W2B), 512, 64, nullptr, idn, idn, gtid, gsz);
  cvtw(P.in[18], 512, (u16*)(ws + OFF_A2F), 512, 64, nullptr, idn, idn, gtid, gsz);
  cvtw(P.in[22], 512, (u16*)(ws + OFF_A2B), 512, 64, nullptr, idn, idn, gtid, gsz);
}

__device__ __forceinline__ void norm_row(const float* __restrict__ src, u16* __restrict__ dst) {
  const int lane = threadIdx.x & 63;
  float4 v0 = *(const float4*)(src + lane * 4);
  float4 v1 = *(const float4*)(src + 256 + lane * 4);
  float4 v2 = *(const float4*)(src + 512 + lane * 4);
  float4 v3 = *(const float4*)(src + 768 + lane * 4);
  float ss = v0.x * v0.x + v0.y * v0.y + v0.z * v0.z + v0.w * v0.w + v1.x * v1.x + v1.y * v1.y + v1.z * v1.z +
             v1.w * v1.w + v2.x * v2.x + v2.y * v2.y + v2.z * v2.z + v2.w * v2.w + v3.x * v3.x + v3.y * v3.y +
             v3.z * v3.z + v3.w * v3.w;
  ss = wave_sum(ss);
  float r = rsqrtf(ss * (1.f / 1024.f) + 1e-6f);
  uint2 o;
  o.x = pack2(v0.x * r, v0.y * r); o.y = pack2(v0.z * r, v0.w * r); *(uint2*)(dst + lane * 4) = o;
  o.x = pack2(v1.x * r, v1.y * r); o.y = pack2(v1.z * r, v1.w * r); *(uint2*)(dst + 256 + lane * 4) = o;
  o.x = pack2(v2.x * r, v2.y * r); o.y = pack2(v2.z * r, v2.w * r); *(uint2*)(dst + 512 + lane * 4) = o;
  o.x = pack2(v3.x * r, v3.y * r); o.y = pack2(v3.z * r, v3.w * r); *(uint2*)(dst + 768 + lane * 4) = o;
}

__device__ __forceinline__ void phase0b(const Params& P) {
  const int wave = threadIdx.x >> 6;
  u16* H = (u16*)(P.ws + OFF_H);
  u16* MH = (u16*)(P.ws + OFF_MH);
  for (int row = blockIdx.x * 4 + wave; row < NT + NMEMROWS; row += gridDim.x * 4) {
    if (row < NT) {
      const float* src = row < NTP ? P.in[0] + (size_t)row * 1024 : P.in[1] + (size_t)(row - NTP) * 1024;
      norm_row(src, H + (size_t)row * 1024);
    } else {
      int mr = row - NT;
      const float* src = mr < 8192 ? P.in[2] + (size_t)mr * 1024 : P.in[3] + (size_t)(mr - 8192) * 1024;
      norm_row(src, MH + (size_t)mr * 1024);
    }
  }
}

__device__ __forceinline__ void phase1(const Params& P, u16* lds) {
  unsigned char* ws = P.ws;
  const u16* H = (const u16*)(ws + OFF_H);
  const u16* Win = (const u16*)(ws + OFF_WIN);
  u16* CQKV = (u16*)(ws + OFF_CQKV);
  u16* RW = (u16*)(ws + OFF_RW);
  u16* XQ = (u16*)(ws + OFF_XQ);
  for (int kk_ = 0;; kk_++) {
    int mt, nt;
    if (!tile_map(kk_, 768, 25, mt, nt)) break;
    Acc acc; acc_zero(acc);
    {
      int m0 = mt * 128, n0 = nt * 128;
      gemm_lin(acc, lds, H + (size_t)m0 * 1024, 1024, Win + (size_t)n0 * 1024, 1024, 1024);
      epi_each(acc, [&](int r0, int c, float v0, float v1, float v2, float v3) {
        int n = n0 + c;
        u16* dst; int ld;
        if (n < 640) { dst = CQKV + n; ld = 672; }
        else if (n < 2560) { dst = RW + (n - 640); ld = 1920; }
        else if (n < 3072) { dst = XQ + (n - 2560); ld = 512; }
        else if (n < 3104) { dst = CQKV + 640 + (n - 3072); ld = 672; }
        else return;
        store_bf16_pairs(dst + (size_t)(m0 + r0) * ld, ld, c, v0, v1, v2, v3);
      });
    }
  }
  for (int i2 = blockIdx.x; i2 < 72 * 8; i2 += gridDim.x) {
    Acc acc; acc_zero(acc);
    {
      int mt = i2 / 8, nt = i2 % 8;
      int m0 = mt * 128, n0 = nt * 128;
      gemm_lin(acc, lds, (const u16*)(ws + OFF_MH) + (size_t)m0 * 1024, 1024, (const u16*)(ws + OFF_WMKV) + (size_t)n0 * 1024, 1024, 1024);
      u16* MKV = (u16*)(ws + OFF_MKV);
      epi_each(acc, [&](int r0, int c, float v0, float v1, float v2, float v3) {
        u16* dst = MKV + (size_t)(m0 + r0) * 1024 + n0 + c;
        dst[0] = f2bf(v0); dst[1024] = f2bf(v1); dst[2048] = f2bf(v2); dst[3072] = f2bf(v3);
      });
    }
  }
}

__device__ __forceinline__ void phase2(const Params& P, u16* lds) {
  unsigned char* ws = P.ws;
  const u16* CQKV = (const u16*)(ws + OFF_CQKV);
  u16* Q = (u16*)((unsigned char*)P.out + DO_Q);
  u16* Kb = (u16*)((unsigned char*)P.out + DO_K);
  u16* Vt = (u16*)((unsigned char*)P.out + DO_VT);
  __shared__ float rstd_s[128];
  const int tid = threadIdx.x;
  for (int it = blockIdx.x; it < 768 * 14; it += gridDim.x) {
    int mt = it / 14, nt = it % 14;
    int m0 = mt * 128;
    const bool isq = nt < 6;
    {
      int r = tid >> 1, hf = tid & 1;
      const u16* src = CQKV + (size_t)(m0 + r) * 672 + (isq ? hf * 192 : 384 + hf * 128);
      int nch = isq ? 24 : 16;
      float ss = 0.f;
      for (int c = 0; c < nch; c++) {
        uint4 u = *(const uint4*)(src + c * 8);
        float a;
        a = bflo(u.x); ss += a * a; a = bfhi(u.x); ss += a * a;
        a = bflo(u.y); ss += a * a; a = bfhi(u.y); ss += a * a;
        a = bflo(u.z); ss += a * a; a = bfhi(u.z); ss += a * a;
        a = bflo(u.w); ss += a * a; a = bfhi(u.w); ss += a * a;
      }
      ss += dppf<0xB1>(ss);
      if (hf == 0) rstd_s[r] = rsqrtf(ss / (isq ? 384.f : 256.f) + 1e-6f);
    }
    __syncthreads();
    Acc acc; acc_zero(acc);
    if (isq) {
      int n0 = nt * 128;
      gemm_lin(acc, lds, CQKV + (size_t)m0 * 672, 672, (const u16*)(ws + OFF_WUQ) + (size_t)n0 * 384, 384, 384);
      epi_each(acc, [&](int r0, int c, float v0, float v1, float v2, float v3) {
        store_bf16_pairs(Q + (size_t)(m0 + r0) * 768 + n0 + c, 768, c, v0 * rstd_s[r0], v1 * rstd_s[r0 + 1],
                         v2 * rstd_s[r0 + 2], v3 * rstd_s[r0 + 3]);
      });
    } else {
      int head = nt - 6;
      int n0 = head * 128;
      gemm_lin(acc, lds, CQKV + (size_t)m0 * 672 + 384, 672, (const u16*)(ws + OFF_WUKV) + (size_t)n0 * 256, 256, 256);
      int seq, start, T;
      tok_seq(m0, seq, start, T);
      u16* vtb = Vt + vt_base(seq) + (size_t)head * 64 * T + (m0 - start);
      epi_each(acc, [&](int r0, int c, float v0, float v1, float v2, float v3) {
        v0 *= rstd_s[r0]; v1 *= rstd_s[r0 + 1]; v2 *= rstd_s[r0 + 2]; v3 *= rstd_s[r0 + 3];
        if (c < 64) {
          u16* dst = Kb + (size_t)(m0 + r0) * 768 + head * 96 + c;
          dst[0] = f2bf(v0); dst[768] = f2bf(v1); dst[1536] = f2bf(v2); dst[2304] = f2bf(v3);
        } else {
          uint2 o; o.x = pack2(v0, v1); o.y = pack2(v2, v3);
          *(uint2*)(vtb + (size_t)(c - 64) * T + r0) = o;
        }
      });
    }
    __syncthreads();
  }
}

__device__ __forceinline__ void phase3(const Params& P) {
  unsigned char* ws = P.ws;
  const u16* CQKV = (const u16*)(ws + OFF_CQKV);
  u16* Kb = (u16*)((unsigned char*)P.out + DO_K);
  const float* gk = P.in[11];
  const int tid = threadIdx.x;
  const int sub = tid >> 4, i = tid & 15;
  const float inv = powf(10000.f, -(float)i / 16.f);
  const float g0 = gk[4 * i], g1 = gk[4 * i + 1], g2 = gk[4 * i + 2], g3 = gk[4 * i + 3], gr1 = gk[64 + i], gr2 = gk[80 + i];
  for (long pr = (long)blockIdx.x * 16 + sub; pr < (long)NT * 8; pr += (long)gridDim.x * 16) {
    int tok = (int)(pr >> 3), head = (int)(pr & 7);
    u16* kp = Kb + (size_t)tok * 768 + head * 96;
    uint2 u = *(const uint2*)(kp + 4 * i);
    float a0 = bflo(u.x), a1 = bfhi(u.x), a2 = bflo(u.y), a3 = bfhi(u.y);
    float x1 = bf2f(CQKV[(size_t)tok * 672 + 640 + i]);
    float x2 = bf2f(CQKV[(size_t)tok * 672 + 656 + i]);
    float ss = a0 * a0 + a1 * a1 + a2 * a2 + a3 * a3 + x1 * x1 + x2 * x2;
    ss = sum16(ss);
    float r = rsqrtf(ss * (1.f / 96.f) + 1e-6f);
    int seq, start, T;
    tok_seq(tok, seq, start, T);
    float ang = (float)(tok - start) * inv;
    float sn, cs;
    sincosf(ang, &sn, &cs);
    x1 *= r * gr1; x2 *= r * gr2;
    uint2 o; o.x = pack2(a0 * r * g0, a1 * r * g1); o.y = pack2(a2 * r * g2, a3 * r * g3);
    *(uint2*)(kp + 4 * i) = o;
    kp[64 + i] = f2bf(x1 * cs - x2 * sn);
    kp[80 + i] = f2bf(x2 * cs + x1 * sn);
  }
  const u16* MKV = (const u16*)(ws + OFF_MKV);
  u16* MK = (u16*)(ws + OFF_MK);
  u16* MVT = (u16*)(ws + OFF_MVT);
  const float* gxk = P.in[33];
  for (int pr = blockIdx.x * 16 + sub; pr < NMEMROWS * 4; pr += gridDim.x * 16) {
    int row = pr >> 2, head = pr & 3;
    int b = row >> 8, key = row & 255;
    uint4 u = *(const uint4*)(MKV + (size_t)row * 1024 + head * 256 + 8 * i);
    float a0 = bflo(u.x), a1 = bfhi(u.x), a2 = bflo(u.y), a3 = bfhi(u.y), a4 = bflo(u.z), a5 = bfhi(u.z), a6 = bflo(u.w), a7 = bfhi(u.w);
    float ss = a0 * a0 + a1 * a1 + a2 * a2 + a3 * a3 + a4 * a4 + a5 * a5 + a6 * a6 + a7 * a7;
    ss = sum16(ss);
    float r = rsqrtf(ss * (1.f / 128.f) + 1e-6f);
    const float* g = gxk + 8 * i;
    uint4 o;
    o.x = pack2(a0 * r * g[0], a1 * r * g[1]); o.y = pack2(a2 * r * g[2], a3 * r * g[3]);
    o.z = pack2(a4 * r * g[4], a5 * r * g[5]); o.w = pack2(a6 * r * g[6], a7 * r * g[7]);
    *(uint4*)(MK + ((size_t)(b * 4 + head) * 256 + key) * 128 + 8 * i) = o;
  }
  for (long e = (long)blockIdx.x * NTHREADS + tid; e < (long)NMEMROWS * 512; e += (long)gridDim.x * NTHREADS) {
    int row = (int)(e >> 9), c = (int)(e & 511);
    int head = c >> 7, dv = c & 127;
    int b = row >> 8, key = row & 255;
    MVT[((size_t)(b * 4 + head) * 128 + dv) * 256 + key] = MKV[(size_t)row * 1024 + head * 256 + 128 + dv];
  }
}

template <int DQK, int DV, bool ROPE, bool PREF>
__device__ __forceinline__ void attn_item(u16* lds, const u16* Qp, long qld, const u16* Kp, long kld, const u16* Vtp, long vld,
                          int nkeys, const float* __restrict__ gq, float qscale, int tpos0, u16* Op, long old) {
  constexpr int KP = DQK + 8;
  constexpr int KT = 64 * KP;
  constexpr int VT = DV * 72;
  constexpr int BUF = KT + VT;
  constexpr int NS = DQK / 16;
  constexpr int ND = DV / 32;
  constexpr int KCH = DQK / 8;
  constexpr int NKC = 64 * KCH / 256;
  constexpr int NVC = DV * 8 / 256;
  const int tid = threadIdx.x, lane = tid & 63, wave = tid >> 6, h = lane >> 5, lr = lane & 31;

  bf16x8 qf[NS];
  {
    const u16* qp = Qp + (long)(32 * wave + lr) * qld + 8 * h;
    float qv[NS][8];
    float ss = 0.f;
#pragma unroll
    for (int s = 0; s < NS; s++) {
      uint4 u = *(const uint4*)(qp + 16 * s);
      qv[s][0] = bflo(u.x); qv[s][1] = bfhi(u.x); qv[s][2] = bflo(u.y); qv[s][3] = bfhi(u.y);
      qv[s][4] = bflo(u.z); qv[s][5] = bfhi(u.z); qv[s][6] = bflo(u.w); qv[s][7] = bfhi(u.w);
#pragma unroll
      for (int j = 0; j < 8; j++) ss += qv[s][j] * qv[s][j];
    }
    ss += __shfl_xor(ss, 32);
    float r = rsqrtf(ss * (1.f / DQK) + 1e-6f);
#pragma unroll
    for (int s = 0; s < NS; s++)
#pragma unroll
      for (int j = 0; j < 8; j++) qv[s][j] *= r * gq[16 * s + 8 * h + j];
    if (ROPE) {
      float t = (float)(tpos0 + 32 * wave + lr);
#pragma unroll
      for (int j = 0; j < 8; j++) {
        float inv = powf(10000.f, -(float)(8 * h + j) / 16.f);
        float sn, cs;
        sincosf(t * inv, &sn, &cs);
        float x1 = qv[NS - 2][j], x2 = qv[NS - 1][j];
        qv[NS - 2][j] = x1 * cs - x2 * sn;
        qv[NS - 1][j] = x2 * cs + x1 * sn;
      }
    }
#pragma unroll
    for (int s = 0; s < NS; s++) {
      uint4 u;
      u.x = pack2(qv[s][0] * qscale, qv[s][1] * qscale); u.y = pack2(qv[s][2] * qscale, qv[s][3] * qscale);
      u.z = pack2(qv[s][4] * qscale, qv[s][5] * qscale); u.w = pack2(qv[s][6] * qscale, qv[s][7] * qscale);
      qf[s] = *(bf16x8*)&u;
    }
  }

  f32x16 o[ND];
#pragma unroll
  for (int d = 0; d < ND; d++)
#pragma unroll
    for (int r = 0; r < 16; r++) o[d][r] = 0.f;
  float lsum = 0.f;

  uint4 rk[NKC], rv[NVC];
  const int nkt = nkeys >> 6;
#define AGLOAD(kt)                                                                           \
  {                                                                                          \
    _Pragma("unroll") for (int i = 0; i < NKC; i++) {                                        \
      int c = tid + 256 * i; int row = c / KCH, kc = c % KCH;                                \
      rk[i] = *(const uint4*)(Kp + (long)((kt) * 64 + row) * kld + kc * 8);                  \
    }                                                                                        \
    _Pragma("unroll") for (int i = 0; i < NVC; i++) {                                        \
      int c = tid + 256 * i; int row = c >> 3, kc = c & 7;                                   \
      rv[i] = *(const uint4*)(Vtp + (long)row * vld + (kt) * 64 + kc * 8);                   \
    }                                                                                        \
  }
#define ASTORE(b)                                                                            \
  {                                                                                          \
    u16* Kl = lds + (b) * BUF; u16* Vl = Kl + KT;                                            \
    _Pragma("unroll") for (int i = 0; i < NKC; i++) {                                        \
      int c = tid + 256 * i; int row = c / KCH, kc = c % KCH;                                \
      *(uint4*)(Kl + row * KP + kc * 8) = rk[i];                                             \
    }                                                                                        \
    _Pragma("unroll") for (int i = 0; i < NVC; i++) {                                        \
      int c = tid + 256 * i; int row = c >> 3, kc = c & 7;                                   \
      *(uint4*)(Vl + row * 72 + kc * 8) = rv[i];                                             \
    }                                                                                        \
  }
  AGLOAD(0)
  ASTORE(0)
  __syncthreads();
  for (int kt = 0; kt < nkt; kt++) {
    if (PREF) { if (kt + 1 < nkt) AGLOAD(kt + 1) }
    else { if (kt + 1 < nkt) { AGLOAD(kt + 1) ASTORE((kt + 1) & 1) } }
    const u16* Kl = lds + (kt & 1) * BUF;
    const u16* Vl = Kl + KT;
#pragma unroll
    for (int ks = 0; ks < 2; ks++) {
      f32x16 st;
#pragma unroll
      for (int r = 0; r < 16; r++) st[r] = 0.f;
      const u16* kr = Kl + (32 * ks + lr) * KP + 8 * h;
#pragma unroll
      for (int s = 0; s < NS; s++) {
        bf16x8 kf = *(const bf16x8*)(kr + 16 * s);
        st = __builtin_amdgcn_mfma_f32_32x32x16_bf16(kf, qf[s], st, 0, 0, 0);
      }
      float p[16];
#pragma unroll
      for (int r = 0; r < 16; r++) { p[r] = __builtin_amdgcn_exp2f(st[r]); lsum += p[r]; }
#pragma unroll
      for (int s2 = 0; s2 < 2; s2++) {
        uint4 u;
        u.x = pack2(p[8 * s2 + 0], p[8 * s2 + 1]); u.y = pack2(p[8 * s2 + 2], p[8 * s2 + 3]);
        u.z = pack2(p[8 * s2 + 4], p[8 * s2 + 5]); u.w = pack2(p[8 * s2 + 6], p[8 * s2 + 7]);
        bf16x8 pb = *(bf16x8*)&u;
#pragma unroll
        for (int d = 0; d < ND; d++) {
          const u16* vr = Vl + (32 * d + lr) * 72 + 32 * ks + 16 * s2 + 4 * h;
          uint2 v0 = *(const uint2*)(vr);
          uint2 v1 = *(const uint2*)(vr + 8);
          uint4 vv; vv.x = v0.x; vv.y = v0.y; vv.z = v1.x; vv.w = v1.y;
          bf16x8 vf = *(bf16x8*)&vv;
          o[d] = __builtin_amdgcn_mfma_f32_32x32x16_bf16(vf, pb, o[d], 0, 0, 0);
        }
      }
    }
    if (PREF) { if (kt + 1 < nkt) ASTORE((kt + 1) & 1) }
    __syncthreads();
  }
#undef AGLOAD
#undef ASTORE
  lsum += __shfl_xor(lsum, 32);
  float il = 1.f / lsum;
  u16* op = Op + (long)(32 * wave + lr) * old;
#pragma unroll
  for (int d = 0; d < ND; d++)
#pragma unroll
    for (int g = 0; g < 4; g++) {
      uint2 u;
      u.x = pack2(o[d][4 * g] * il, o[d][4 * g + 1] * il);
      u.y = pack2(o[d][4 * g + 2] * il, o[d][4 * g + 3] * il);
      *(uint2*)(op + 32 * d + 8 * g + 4 * h) = u;
    }
}

typedef __attribute__((ext_vector_type(2))) float f32x2;
constexpr int SC_OP = 2048;
constexpr int SC_WR = 0, SC_KK = SC_OP, SC_WD = 2 * SC_OP, SC_KD = 3 * SC_OP, SC_BB = 4 * SC_OP;
constexpr int SC_R = SC_WR, SC_K = SC_KK, SC_LW = SC_WD, SC_LA = SC_KD;
constexpr int SC_V = 5 * SC_OP, SC_BR = SC_V + 2048, SC_CKR = SC_BR + 32, SC_Y = SC_CKR + 32;
constexpr int SC_END = SC_Y + 2048;
constexpr int SC_TW_B = SC_END * 4;
constexpr int SC_AL_B = SC_TW_B + 32 * 72 * 2;
static_assert(SC_AL_B + 32 * 72 * 2 + 960 * 4 <= LDS_BYTES, "scan lds");

__device__ __forceinline__ float fexp(float x) { return __builtin_amdgcn_exp2f(x * 1.4426950408889634f); }
__device__ __forceinline__ float frcp(float x) { return __builtin_amdgcn_rcpf(x); }
__device__ __forceinline__ float ftanh(float x) { return 1.f - 2.f * frcp(1.f + fexp(2.f * x)); }
__device__ __forceinline__ float fsigm(float x) { return frcp(1.f + fexp(-x)); }

struct Raw3 { uint4 c, a, b; };
__device__ __forceinline__ Raw3 ld3(const u16* __restrict__ p, bool hp, bool hn) {
  Raw3 r;
  r.c = *(const uint4*)p;
  r.a = hp ? *(const uint4*)(p - 1920) : make_uint4(0, 0, 0, 0);
  r.b = hn ? *(const uint4*)(p + 1920) : make_uint4(0, 0, 0, 0);
  return r;
}
__device__ __forceinline__ void mixr(const Raw3& r, const float* __restrict__ mp, const float* __restrict__ mn, float* out) {
  float cc[8] = {bflo(r.c.x), bfhi(r.c.x), bflo(r.c.y), bfhi(r.c.y), bflo(r.c.z), bfhi(r.c.z), bflo(r.c.w), bfhi(r.c.w)};
  float aa[8] = {bflo(r.a.x), bfhi(r.a.x), bflo(r.a.y), bfhi(r.a.y), bflo(r.a.z), bfhi(r.a.z), bflo(r.a.w), bfhi(r.a.w)};
  float bb[8] = {bflo(r.b.x), bfhi(r.b.x), bflo(r.b.y), bfhi(r.b.y), bflo(r.b.z), bfhi(r.b.z), bflo(r.b.w), bfhi(r.b.w)};
#pragma unroll
  for (int j = 0; j < 8; j++) out[j] = cc[j] + mp[j] * (aa[j] - cc[j]) + mn[j] * (bb[j] - cc[j]);
}
__device__ __forceinline__ void mix8(const u16* __restrict__ p, bool hp, bool hn, const float* __restrict__ mp,
                                     const float* __restrict__ mn, float* out) {
  Raw3 r = ld3(p, hp, hn);
  mixr(r, mp, mn, out);
}

template <int NRG>
__device__ __forceinline__ void scan_item(const Params& P, unsigned char* ldsb, int seq, int head, int dir, int rg) {
  float* L = (float*)ldsb;
  u16* TWb = (u16*)(ldsb + SC_TW_B);
  u16* ALb = (u16*)(ldsb + SC_AL_B);
  unsigned char* ws = P.ws;
  const u16* RW = (const u16*)(ws + OFF_RW);
  u16* Y = (u16*)(ws + (dir ? OFF_YB : OFF_YF));
  const float* w0 = dir ? P.in[19] : P.in[15];
  const float* a0 = dir ? P.in[21] : P.in[17];
  const u16* w2t = (const u16*)(ws + (dir ? OFF_W2B : OFF_W2F));
  const u16* a2t = (const u16*)(ws + (dir ? OFF_A2B : OFF_A2F));
  const int T = seq < 32 ? 2048 : 8192;
  const int start = seq < 32 ? seq * 2048 : NTP + (seq - 32) * 8192;
  const int tid = threadIdx.x, lane = tid & 63, wave = tid >> 6;
  const int hc = head * 64;
  const int pt = tid >> 3, pc = (tid & 7) * 8;
  const int wlo = dir ? 1600 : 1536, alo = dir ? 1728 : 1664;
  float* CS = (float*)(ldsb + SC_AL_B + 32 * 72 * 2);
  for (int i = tid; i < 960; i += NTHREADS) {
    const int arr = i >> 6, c = i & 63;
    const float* src;
    switch (arr) {
      case 0: src = P.in[13] + hc; break;
      case 1: src = P.in[14] + hc; break;
      case 2: src = P.in[13] + 512 + hc; break;
      case 3: src = P.in[14] + 512 + hc; break;
      case 4: src = P.in[13] + 1024 + hc; break;
      case 5: src = P.in[14] + 1024 + hc; break;
      case 6: src = P.in[13] + wlo; break;
      case 7: src = P.in[14] + wlo; break;
      case 8: src = P.in[13] + alo; break;
      case 9: src = P.in[14] + alo; break;
      case 10: src = w0 + hc; break;
      case 11: src = a0 + hc; break;
      case 12: src = P.in[24] + hc; break;
      case 13: src = P.in[25] + hc; break;
      default: src = P.in[26] + hc; break;
    }
    CS[i] = src[c];
  }
  __syncthreads();
  const float *mpr = CS + pc, *mnr = CS + 64 + pc, *mpk = CS + 128 + pc, *mnk = CS + 192 + pc, *mpv = CS + 256 + pc,
              *mnv = CS + 320 + pc, *mpw = CS + 384 + pc, *mnw = CS + 448 + pc, *mpa = CS + 512 + pc, *mna = CS + 576 + pc,
              *cw0 = CS + 640 + pc, *ca0 = CS + 704 + pc, *ckk = CS + 768 + pc, *cka = CS + 832 + pc, *crk = CS + 896 + pc;
  const int rp = tid >> 3, seg = tid & 7;
  f32x2 st[8];
#pragma unroll
  for (int k = 0; k < 8; k++) st[k] = (f32x2){0.f, 0.f};
  const int nch = T >> 5;
  Raw3 g_r, g_k, g_v, g_w, g_a;
#define SLOAD(chn)                                                                     \
  {                                                                                    \
    const int t0_ = dir ? T - 32 * ((chn) + 1) : 32 * (chn);                           \
    const int t_ = t0_ + pt;                                                           \
    const bool hp_ = t_ > 0, hn_ = t_ < T - 1;                                         \
    const u16* base_ = RW + (size_t)(start + t_) * 1920;                               \
    g_r = ld3(base_ + hc + pc, hp_, hn_); g_k = ld3(base_ + 512 + hc + pc, hp_, hn_);  \
    g_v = ld3(base_ + 1024 + hc + pc, hp_, hn_); g_w = ld3(base_ + wlo + pc, hp_, hn_); \
    g_a = ld3(base_ + alo + pc, hp_, hn_);                                             \
  }
  SLOAD(0)
  for (int ch = 0; ch < nch; ch++) {
    const int t0 = dir ? T - 32 * (ch + 1) : 32 * ch;
    bf16x8 lb0, lb1, lb2, lb3;
    {
      const int mat = wave >> 1, ntile = wave & 1;
      const u16* Bsrc = (mat ? a2t : w2t) + (size_t)(hc + 32 * ntile + (lane & 31)) * 64 + 8 * (lane >> 5);
      lb0 = *(const bf16x8*)(Bsrc); lb1 = *(const bf16x8*)(Bsrc + 16); lb2 = *(const bf16x8*)(Bsrc + 32); lb3 = *(const bf16x8*)(Bsrc + 48);
    }
    {
      float v[8];
      mixr(g_r, mpr, mnr, v);
#pragma unroll
      for (int j = 0; j < 8; j++) L[SC_R + pt * 64 + pc + j] = v[j];
      mixr(g_k, mpk, mnk, v);
#pragma unroll
      for (int j = 0; j < 8; j++) L[SC_K + pt * 64 + pc + j] = v[j];
      mixr(g_v, mpv, mnv, v);
#pragma unroll
      for (int j = 0; j < 8; j++) L[SC_V + pt * 64 + pc + j] = v[j];
      mixr(g_w, mpw, mnw, v);
      uint4 u;
      u.x = pack2(ftanh(v[0]), ftanh(v[1])); u.y = pack2(ftanh(v[2]), ftanh(v[3]));
      u.z = pack2(ftanh(v[4]), ftanh(v[5])); u.w = pack2(ftanh(v[6]), ftanh(v[7]));
      *(uint4*)(TWb + pt * 72 + pc) = u;
      mixr(g_a, mpa, mna, v);
      u.x = pack2(v[0], v[1]); u.y = pack2(v[2], v[3]); u.z = pack2(v[4], v[5]); u.w = pack2(v[6], v[7]);
      *(uint4*)(ALb + pt * 72 + pc) = u;
    }
    __syncthreads();
    {
      const int mat = wave >> 1, ntile = wave & 1;
      const u16* Asrc = (mat ? ALb : TWb) + (lane & 31) * 72 + 8 * (lane >> 5);
      f32x16 c;
#pragma unroll
      for (int r = 0; r < 16; r++) c[r] = 0.f;
      c = __builtin_amdgcn_mfma_f32_32x32x16_bf16(*(const bf16x8*)(Asrc), lb0, c, 0, 0, 0);
      c = __builtin_amdgcn_mfma_f32_32x32x16_bf16(*(const bf16x8*)(Asrc + 16), lb1, c, 0, 0, 0);
      c = __builtin_amdgcn_mfma_f32_32x32x16_bf16(*(const bf16x8*)(Asrc + 32), lb2, c, 0, 0, 0);
      c = __builtin_amdgcn_mfma_f32_32x32x16_bf16(*(const bf16x8*)(Asrc + 48), lb3, c, 0, 0, 0);
      float* dst = L + (mat ? SC_LA : SC_LW);
#pragma unroll
      for (int r = 0; r < 16; r++) {
        int tr = (r & 3) + 8 * (r >> 2) + 4 * (lane >> 5);
        dst[tr * 64 + 32 * ntile + (lane & 31)] = c[r];
      }
    }
    __syncthreads();
    {
      float ssk = 0.f, br = 0.f, kr = 0.f, bon = 0.f;
      float kkr[8], av[8], kdv[8], rr[8], dec[8];
#pragma unroll
      for (int j = 0; j < 8; j++) {
        int o = pt * 64 + pc + j;
        float r = L[SC_R + o], k = L[SC_K + o];
        float wp = cw0[j] + L[SC_LW + o];
        float z = -wp;
        float sp = z > 15.f ? z : 0.6931471805599453f * __builtin_amdgcn_logf(1.f + fexp(z));
        float w = -sp - 0.5f;
        dec[j] = fexp(-fexp(w));
        float a = fsigm(ca0[j] + L[SC_LA + o]);
        av[j] = a;
        kkr[j] = k * ckk[j];
        ssk += kkr[j] * kkr[j];
        kdv[j] = k * (1.f + (a - 1.f) * cka[j]);
        rr[j] = r;
        kr += kdv[j] * r;
        bon += r * kdv[j] * crk[j];
      }
      ssk = sum8(ssk);
      float inrm = __builtin_amdgcn_rsqf(fmaxf(ssk, 1e-24f));
#pragma unroll
      for (int j = 0; j < 8; j++) {
        float kk = kkr[j] * inrm;
        float b = kk * av[j];
        br += b * rr[j];
        int o = pt * 64 + pc + j;
        L[SC_KK + o] = kk;
        L[SC_BB + o] = b;
        L[SC_WR + o] = dec[j] * rr[j];
        L[SC_WD + o] = dec[j];
        L[SC_KD + o] = kdv[j];
      }
      br = sum8(br); kr = sum8(kr); bon = sum8(bon);
      if ((tid & 7) == 0) { L[SC_BR + pt] = br; L[SC_CKR + pt] = kr + bon; }
    }
    __syncthreads();
    if (ch + 1 < nch) SLOAD(ch + 1)
    {
#pragma unroll 1
      for (int qo = 0; qo < 4; qo++) {
        f32x2 yk = (f32x2){0.f, 0.f};
#pragma unroll
        for (int qi = 0; qi < 8; qi++) {
          const int q = qo * 8 + qi;
          const int tt = dir ? 31 - q : q;
          const float* ob = L + tt * 64 + 8 * seg;
          float4 kka = *(const float4*)(ob + SC_KK), kkb = *(const float4*)(ob + SC_KK + 4);
          float4 wra = *(const float4*)(ob + SC_WR), wrb = *(const float4*)(ob + SC_WR + 4);
          float4 wda = *(const float4*)(ob + SC_WD), wdb = *(const float4*)(ob + SC_WD + 4);
          float4 bba = *(const float4*)(ob + SC_BB), bbb = *(const float4*)(ob + SC_BB + 4);
          float4 kda = *(const float4*)(ob + SC_KD), kdb = *(const float4*)(ob + SC_KD + 4);
          float br = L[SC_BR + tt], ckr = L[SC_CKR + tt];
          float kk[8] = {kka.x, kka.y, kka.z, kka.w, kkb.x, kkb.y, kkb.z, kkb.w};
          float wr[8] = {wra.x, wra.y, wra.z, wra.w, wrb.x, wrb.y, wrb.z, wrb.w};
          float wd[8] = {wda.x, wda.y, wda.z, wda.w, wdb.x, wdb.y, wdb.z, wdb.w};
          float bb[8] = {bba.x, bba.y, bba.z, bba.w, bbb.x, bbb.y, bbb.z, bbb.w};
          float kd[8] = {kda.x, kda.y, kda.z, kda.w, kdb.x, kdb.y, kdb.z, kdb.w};
          if (NRG == 1) {
            float2 vv = *(const float2*)(L + SC_V + tt * 64 + 2 * rp);
            f32x2 v2 = (f32x2){vv.x, vv.y};
            f32x2 p1 = st[0] * kk[0], p2 = st[0] * wr[0];
#pragma unroll
            for (int k = 1; k < 8; k++) { p1 += st[k] * kk[k]; p2 += st[k] * wr[k]; }
            p1.x = sum8(p1.x); p1.y = sum8(p1.y); p2.x = sum8(p2.x); p2.y = sum8(p2.y);
            f32x2 y2 = p2 - p1 * br + v2 * ckr;
            if (qi == seg) yk = y2;
#pragma unroll
            for (int k = 0; k < 8; k++) st[k] = st[k] * wd[k] - p1 * bb[k] + v2 * kd[k];
          } else {
            const float v = L[SC_V + tt * 64 + 32 * rg + rp];
            f32x2 q1 = st[0] * (f32x2){kk[0], kk[1]}, q2 = st[0] * (f32x2){wr[0], wr[1]};
#pragma unroll
            for (int i = 1; i < 4; i++) {
              q1 += st[i] * (f32x2){kk[2 * i], kk[2 * i + 1]};
              q2 += st[i] * (f32x2){wr[2 * i], wr[2 * i + 1]};
            }
            const float p1 = sum8(q1.x + q1.y), p2 = sum8(q2.x + q2.y);
            const float y = p2 - p1 * br + v * ckr;
            if (qi == seg) yk.x = y;
#pragma unroll
            for (int i = 0; i < 4; i++)
              st[i] = st[i] * (f32x2){wd[2 * i], wd[2 * i + 1]} - p1 * (f32x2){bb[2 * i], bb[2 * i + 1]} + v * (f32x2){kd[2 * i], kd[2 * i + 1]};
          }
        }
        {
          const int q = qo * 8 + seg;
          const int tt = dir ? 31 - q : q;
          if (NRG == 1) *(float2*)(L + SC_Y + tt * 64 + 2 * rp) = make_float2(yk.x, yk.y);
          else L[SC_Y + tt * 64 + 32 * rg + rp] = yk.x;
        }
      }
    }
    __syncthreads();
    if (NRG == 1 || (pc >> 5) == rg) {
      const float* yp = L + SC_Y + pt * 64 + pc;
      uint4 u;
      u.x = pack2(yp[0], yp[1]); u.y = pack2(yp[2], yp[3]); u.z = pack2(yp[4], yp[5]); u.w = pack2(yp[6], yp[7]);
      *(uint4*)(Y + (size_t)(start + t0 + pt) * 512 + hc + pc) = u;
    }
  }
#undef SLOAD
}

__device__ __forceinline__ void phase4(const Params& P, unsigned char* ldsb) {
  __shared__ int s_item;
  unsigned* ctr = (unsigned*)(P.ws + OFF_CTL);
  u16* lds = (u16*)ldsb;
  u16* Q = (u16*)((unsigned char*)P.out + DO_Q);
  const u16* Kb = (const u16*)((unsigned char*)P.out + DO_K);
  const u16* Vt = (const u16*)((unsigned char*)P.out + DO_VT);
  u16* XQ = (u16*)(P.ws + OFF_XQ);
  const u16* MK = (const u16*)(P.ws + OFF_MK);
  const u16* MVT = (const u16*)(P.ws + OFF_MVT);
  const int total = 576 + 6144;
  const float LOG2E = 1.4426950408889634f;
  while (true) {
    __syncthreads();
    if (threadIdx.x == 0) s_item = (int)atomicAdd(ctr, 1u);
    __syncthreads();
    const int q = s_item;
    if (q >= total) break;
    int kind, idx;
    if (q < 576) { kind = 1; idx = q; }
    else if (q < 576 + 2048) { kind = 2; idx = q - 576; }
    else { kind = 3; idx = q - 2624; }
    if (kind == 1) {
      int i2 = idx < 64 ? idx : idx - 64;
      int dir = i2 & 1, head = (i2 >> 1) & 7, sl = i2 >> 4;
      scan_item<1>(P, ldsb, idx < 64 ? 32 + sl : sl, head, dir, 0);
    } else if (kind <= 3) {
      int seq, head, qb, T, start;
      if (kind == 2) { seq = 32 + (idx >> 9); head = (idx >> 6) & 7; qb = idx & 63; T = 8192; start = NTP + (seq - 32) * 8192; }
      else { seq = idx >> 7; head = (idx >> 4) & 7; qb = idx & 15; T = 2048; start = seq * 2048; }
      const size_t tok0 = (size_t)start + qb * 128;
      attn_item<96, 64, true, true>(lds, Q + tok0 * 768 + head * 96, 768, Kb + (size_t)start * 768 + head * 96, 768,
                              Vt + vt_base(seq) + (size_t)head * 64 * T, T, T, P.in[10],
                              0.10206207261596577f * LOG2E, qb * 128, Q + tok0 * 768 + head * 96, 768);
    }
  }
#ifdef SCANREP
  __syncthreads();
  for (int idx = blockIdx.x; idx < 576; idx += gridDim.x) {
    int dir = idx & 1, head = (idx >> 1) & 7, sl = idx >> 4;
    __syncthreads();
    scan_item<1>(P, ldsb, sl, head, dir, 0);
  }
#endif
  __syncthreads();
  for (int idx = blockIdx.x; idx < 3072; idx += gridDim.x) {
    int mt = idx >> 2, head = idx & 3;
    int seq, start, T;
    tok_seq(mt * 128, seq, start, T);
    const size_t tok0 = (size_t)mt * 128;
    attn_item<128, 128, false, false>(lds, XQ + tok0 * 512 + head * 128, 512, MK + (size_t)(seq * 4 + head) * 256 * 128, 128,
                                      MVT + (size_t)(seq * 4 + head) * 128 * 256, 256, 256, P.in[32],
                                      0.08838834764831845f * LOG2E, 0, XQ + tok0 * 512 + head * 128, 512);
  }
}

__device__ __forceinline__ void phase5(const Params& P, u16* lds) {
  __shared__ float st_mean[256], st_rstd[256];
  unsigned char* ws = P.ws;
  const u16* RW = (const u16*)(ws + OFF_RW);
  const u16* YF = (const u16*)(ws + OFF_YF);
  u16* YB = (u16*)(ws + OFF_YB);
  const u16* G2 = (const u16*)(ws + OFF_G2);
  const float* mup = P.in[13] + 1792;
  const float* mun = P.in[14] + 1792;
  const float* lng = P.in[27];
  const float* lnb = P.in[28];
  const int tid = threadIdx.x;
  for (int it = blockIdx.x; it < 768 * 4; it += gridDim.x) {
    int mt = it >> 2, nt = it & 3;
    int m0 = mt * 128, n0 = nt * 128;
    int seq, start, T;
    tok_seq(m0, seq, start, T);
    {
      int r = tid >> 1, hh = tid & 1;
      const u16* pf = YF + (size_t)(m0 + r) * 512 + n0 + hh * 64;
      const u16* pb = YB + (size_t)(m0 + r) * 512 + n0 + hh * 64;
      float sm = 0.f, sq = 0.f;
      for (int c = 0; c < 8; c++) {
        uint4 a = *(const uint4*)(pf + 8 * c), b = *(const uint4*)(pb + 8 * c);
        float y;
        y = bflo(a.x) + bflo(b.x); sm += y; sq += y * y; y = bfhi(a.x) + bfhi(b.x); sm += y; sq += y * y;
        y = bflo(a.y) + bflo(b.y); sm += y; sq += y * y; y = bfhi(a.y) + bfhi(b.y); sm += y; sq += y * y;
        y = bflo(a.z) + bflo(b.z); sm += y; sq += y * y; y = bfhi(a.z) + bfhi(b.z); sm += y; sq += y * y;
        y = bflo(a.w) + bflo(b.w); sm += y; sq += y * y; y = bfhi(a.w) + bfhi(b.w); sm += y; sq += y * y;
      }
      float mean = sm * (1.f / 64.f);
      float var = fmaxf(sq * (1.f / 64.f) - mean * mean, 0.f);
      st_mean[tid] = mean;
      st_rstd[tid] = rsqrtf(var + 64e-5f);
    }
    {
      const int lr = tid >> 3, lk = (tid & 7) * 8;
#pragma unroll
      for (int kb = 0; kb < 2; kb++) {
#pragma unroll
        for (int i = 0; i < 4; i++) {
          int r = lr + 32 * i;
          int t = m0 + r - start;
          float v[8];
          mix8(RW + (size_t)(m0 + r) * 1920 + 1792 + kb * 64 + lk, t > 0, t < T - 1, mup + kb * 64 + lk, mun + kb * 64 + lk, v);
          uint4 u;
          u.x = pack2(sigmoidf_(v[0]), sigmoidf_(v[1])); u.y = pack2(sigmoidf_(v[2]), sigmoidf_(v[3]));
          u.z = pack2(sigmoidf_(v[4]), sigmoidf_(v[5])); u.w = pack2(sigmoidf_(v[6]), sigmoidf_(v[7]));
          *(uint4*)(lds + kb * (2 * LTILE) + r * LROW + lk) = u;
          *(uint4*)(lds + kb * (2 * LTILE) + LTILE + r * LROW + lk) = *(const uint4*)(G2 + (size_t)(n0 + r) * 128 + kb * 64 + lk);
        }
      }
    }
    __syncthreads();
    Acc acc; acc_zero(acc);
    gemm_compute(acc, lds, 0);
    gemm_compute(acc, lds, 1);
    epi_each(acc, [&](int r0, int c, float v0, float v1, float v2, float v3) {
      int hh = c >> 6;
      float g = lng[n0 + c], b = lnb[n0 + c];
      float vv[4] = {v0, v1, v2, v3};
#pragma unroll
      for (int k = 0; k < 4; k++) {
        size_t o = (size_t)(m0 + r0 + k) * 512 + n0 + c;
        float y = bf2f(YF[o]) + bf2f(YB[o]);
        int si = (r0 + k) * 2 + hh;
        float yn = (y - st_mean[si]) * st_rstd[si] * g + b;
        YB[o] = f2bf(yn * vv[k]);
      }
    });
    __syncthreads();
  }
}

__device__ __forceinline__ void merge_branch(Acc& mg, u16* lds, const u16* Hrow, const u16* Wg_rows, const u16* Abr,
                                             const u16* Wbr, int Kb) {
  unsigned* G = (unsigned*)(lds + 2 * LTILE);
  {
    Acc acc; acc_zero(acc);
    gemm_lin<false, false>(acc, lds, Hrow, 1024, Wg_rows, 1024, 1024);
#pragma unroll
    for (int i = 0; i < 2; i++)
#pragma unroll
      for (int j = 0; j < 2; j++)
#pragma unroll
        for (int r = 0; r < 8; r++)
          G[((i * 2 + j) * 8 + r) * 256 + threadIdx.x] = pack2(sigmoidf_(acc.a[i][j][2 * r]), sigmoidf_(acc.a[i][j][2 * r + 1]));
  }
  Acc acc; acc_zero(acc);
  gemm_lin<true, false>(acc, lds, Abr, Kb, Wbr, Kb, Kb);
#pragma unroll
  for (int i = 0; i < 2; i++)
#pragma unroll
    for (int j = 0; j < 2; j++)
#pragma unroll
      for (int r = 0; r < 8; r++) {
        unsigned g = G[((i * 2 + j) * 8 + r) * 256 + threadIdx.x];
        mg.a[i][j][2 * r] += bflo(g) * acc.a[i][j][2 * r];
        mg.a[i][j][2 * r + 1] += bfhi(g) * acc.a[i][j][2 * r + 1];
      }
  __syncthreads();
}
__device__ __forceinline__ void phase6(const Params& P, u16* lds) {
  unsigned char* ws = P.ws;
  const u16* H = (const u16*)(ws + OFF_H);
  const u16* Wg = (const u16*)(ws + OFF_WIN) + (size_t)3200 * 1024;
  u16* MG = (u16*)(ws + OFF_MERGED);
  const u16* A0 = (const u16*)((unsigned char*)P.out + DO_Q);
  const u16* A1 = (const u16*)(ws + OFF_YB);
  const u16* A2 = (const u16*)(ws + OFF_XQ);
  const u16* W0 = (const u16*)(ws + OFF_WOA);
  const u16* W1 = (const u16*)(ws + OFF_WOB);
  const u16* W2 = (const u16*)(ws + OFF_WOC);
  for (int kk_ = 0;; kk_++) {
    int mt, nt;
    if (!tile_map(kk_, 768, 8, mt, nt)) break;
    int m0 = mt * 128, n0 = nt * 128;
    Acc mg; acc_zero(mg);
    const u16* Hrow = H + (size_t)m0 * 1024;
#pragma nounroll
    for (int br = 0; br < 3; br++) {
      const u16* Ab = br == 0 ? A0 + (size_t)m0 * 768 : (br == 1 ? A1 + (size_t)m0 * 512 : A2 + (size_t)m0 * 512);
      const u16* Wb = br == 0 ? W0 + (size_t)n0 * 768 : (br == 1 ? W1 + (size_t)n0 * 512 : W2 + (size_t)n0 * 512);
      merge_branch(mg, lds, Hrow, Wg + (size_t)(br * 1024 + n0) * 1024, Ab, Wb, br == 0 ? 768 : 512);
    }
    epi_each(mg, [&](int r0, int c, float v0, float v1, float v2, float v3) {
      store_bf16_pairs(MG + (size_t)(m0 + r0) * 1024 + n0 + c, 1024, c, v0, v1, v2, v3);
    });
  }
}

__device__ __forceinline__ void phase7(const Params& P, u16* lds) {
  unsigned char* ws = P.ws;
  const u16* MG = (const u16*)(ws + OFF_MERGED);
  const u16* W = (const u16*)(ws + OFF_WOUT);
  for (int kk_ = 0;; kk_++) {
    int mt, nt;
    if (!tile_map(kk_, 768, 8, mt, nt)) break;
    int m0 = mt * 128, n0 = nt * 128;
    Acc acc; acc_zero(acc);
    gemm_lin(acc, lds, MG + (size_t)m0 * 1024, 1024, W + (size_t)n0 * 1024, 1024, 1024);
    const float* xin = m0 < NTP ? P.in[0] + (size_t)m0 * 1024 : P.in[1] + (size_t)(m0 - NTP) * 1024;
    float* xo = P.out + (size_t)m0 * 1024;
    epi_each(acc, [&](int r0, int c, float v0, float v1, float v2, float v3) {
      size_t o = (size_t)r0 * 1024 + n0 + c;
      xo[o] = xin[o] + v0; xo[o + 1024] = xin[o + 1024] + v1; xo[o + 2048] = xin[o + 2048] + v2; xo[o + 3072] = xin[o + 3072] + v3;
    });
  }
}

__device__ __forceinline__ void phase8(const Params& P) {
  const int wave = threadIdx.x >> 6;
  u16* H = (u16*)(P.ws + OFF_H);
  for (int row = blockIdx.x * 4 + wave; row < NT; row += gridDim.x * 4)
    norm_row(P.out + (size_t)row * 1024, H + (size_t)row * 1024);
}

__device__ __forceinline__ float erf_as(float x) {
  const float ax = fabsf(x);
  const float t = __builtin_amdgcn_rcpf(1.f + 0.3275911f * ax);
  const float y = ((((1.061405429f * t - 1.453152027f) * t + 1.421413741f) * t - 0.284496736f) * t + 0.254829592f) * t;
  const float r = 1.f - y * __builtin_amdgcn_exp2f(-ax * ax * 1.4426950408889634f);
  return copysignf(r, x);
}
__device__ __forceinline__ void phase9(const Params& P, u16* lds) {
  unsigned char* ws = P.ws;
  const u16* H = (const u16*)(ws + OFF_H);
  const u16* W = (const u16*)(ws + OFF_WUP);
  u16* ACT = (u16*)(ws + OFF_ACT);
  const float* cw = P.in[38];
  const float* cb = P.in[39];
  float* Lf = (float*)lds;
  const int tid = threadIdx.x, lane = tid & 63, wave = tid >> 6, wm = wave >> 1, wn = wave & 1;
  for (int kk_ = 0;; kk_++) {
    int mt, nt;
    if (!tile_map(kk_, 808, 44, mt, nt)) break;
    int start, T, ti;
    if (mt < 544) { int s = mt / 17; ti = mt % 17; start = s * 2048; T = 2048; }
    else { int m2 = mt - 544; int s = m2 / 66; ti = m2 % 66; start = NTP + s * 8192; T = 8192; }
    const int p0 = 126 * ti - 1;
    const int lr = tid >> 3;
    const u16* pa[4];
#pragma unroll
    for (int i = 0; i < 4; i++) {
      int p = p0 + lr + 32 * i;
      p = p < 0 ? 0 : (p > T - 1 ? T - 1 : p);
      pa[i] = H + (size_t)(start + p) * 1024;
    }
    const u16* Bt = W + (size_t)nt * 128 * 1024;
    Acc acc; acc_zero(acc);
    gemm_main(acc, lds, pa[0], pa[1], pa[2], pa[3], Bt + (size_t)lr * 1024, Bt + (size_t)(lr + 32) * 1024,
              Bt + (size_t)(lr + 64) * 1024, Bt + (size_t)(lr + 96) * 1024, 1024);
    {
      float* dst = Lf + wn * 8192;
#pragma unroll
      for (int i = 0; i < 2; i++)
#pragma unroll
        for (int j = 0; j < 2; j++)
#pragma unroll
          for (int r = 0; r < 16; r++) {
            int rr = 64 * wm + 32 * i + (r & 3) + 8 * (r >> 2) + 4 * (lane >> 5);
            dst[rr * 64 + 32 * j + (lane & 31)] = acc.a[i][j][r];
          }
    }
    __syncthreads();
    {
      const int c = tid & 63, rgp = tid >> 6;
      const int col = nt * 64 + c;
      const float w0 = cw[col], w1 = cw[2816 + col], w2 = cw[2 * 2816 + col], bb = cb[col];
      int rbeg = rgp * 32; if (rbeg < 1) rbeg = 1;
      int rend = rgp * 32 + 32; if (rend > 127) rend = 127;
      auto gval = [&](int r) { int p = p0 + r; return (p >= 0 && p < T) ? Lf[r * 64 + c] : 0.f; };
      float gp = gval(rbeg - 1), gc = gval(rbeg);
      for (int r = rbeg; r < rend; r++) {
        float gn = gval(r + 1);
        int p = p0 + r;
        if (p < T) {
          float cc = w0 * gp + w1 * gc + w2 * gn + bb;
          float a = 0.5f * cc * (1.f + erf_as(cc * 0.70710678118654752f)) * Lf[8192 + r * 64 + c];
          ACT[(size_t)(start + p) * 2816 + col] = f2bf(a);
        }
        gp = gc; gc = gn;
      }
    }
    __syncthreads();
  }
}

__device__ __forceinline__ void phase10(const Params& P, u16* lds) {
  unsigned char* ws = P.ws;
  const u16* ACT = (const u16*)(ws + OFF_ACT);
  const u16* W = (const u16*)(ws + OFF_WDOWN);
  for (int kk_ = 0;; kk_++) {
    int mt, nt;
    if (!tile_map(kk_, 768, 8, mt, nt)) break;
    int m0 = mt * 128, n0 = nt * 128;
    Acc acc; acc_zero(acc);
    gemm_lin(acc, lds, ACT + (size_t)m0 * 2816, 2816, W + (size_t)n0 * 2816, 2816, 2816);
    float* xo = P.out + (size_t)m0 * 1024;
    epi_each(acc, [&](int r0, int c, float v0, float v1, float v2, float v3) {
      size_t o = (size_t)r0 * 1024 + n0 + c;
      xo[o] += v0; xo[o + 1024] += v1; xo[o + 2048] += v2; xo[o + 3072] += v3;
    });
  }
}

constexpr int NPHASE = 11;
__global__ void __launch_bounds__(NTHREADS, 2) fwd_kernel(Params P) {
  extern __shared__ __attribute__((aligned(16))) unsigned char dlds[];
  cg::grid_group grid = cg::this_grid();
  u16* lds = (u16*)dlds;
#ifndef REPMASK
#define REPMASK 0
#endif
#define PH(k, call)                                   \
  if (P.lo <= (k) && (k) < P.hi) {                    \
    call;                                             \
    if ((REPMASK >> (k)) & 1) { grid.sync(); call; }  \
    if ((k) + 1 < P.hi) grid.sync();                  \
  }
  PH(0, (phase0(P), phase0b(P)))
  PH(1, phase1(P, lds))
  PH(2, phase2(P, lds))
  PH(3, phase3(P))
  PH(4, phase4(P, dlds))
  PH(5, phase5(P, lds))
  PH(6, phase6(P, lds))
  PH(7, phase7(P, lds))
  PH(8, phase8(P))
  PH(9, phase9(P, lds))
  PH(10, phase10(P, lds))
#undef PH
}

extern "C" void kernel_launch(void* const* d_in, const int* in_sizes, int n_in, void* d_out, int out_size, void* d_ws,
                              size_t ws_size, hipStream_t stream) {
  static int grid_blocks = 0;
  if (!grid_blocks) {
    int dev = 0, cus = 0, per_cu = 0;
    hipGetDevice(&dev);
    hipDeviceGetAttribute(&cus, hipDeviceAttributeMultiprocessorCount, dev);
    hipFuncSetAttribute((const void*)fwd_kernel, hipFuncAttributeMaxDynamicSharedMemorySize, LDS_BYTES);
    hipOccupancyMaxActiveBlocksPerMultiprocessor(&per_cu, (const void*)fwd_kernel, NTHREADS, LDS_BYTES);
    if (per_cu < 1) per_cu = 1;
    if (per_cu > 2) per_cu = 2;
    grid_blocks = cus * per_cu;
    if (ws_size < WS_END) fprintf(stderr, "workspace too small: %zu < %zu\n", ws_size, (size_t)WS_END);
  }
  if (ws_size < WS_END) return;
  Params p{};
  for (int i = 0; i < 41; i++) p.in[i] = (const float*)d_in[i];
  p.out = (float*)d_out;
  p.ws = (unsigned char*)d_ws;
#if MEGA
  p.lo = 0; p.hi = NPHASE;
  void* args[] = {&p};
  hipError_t e = hipLaunchCooperativeKernel((const void*)fwd_kernel, dim3(grid_blocks), dim3(NTHREADS), args, LDS_BYTES, stream);
  if (e != hipSuccess) fprintf(stderr, "cooperative launch failed: %s (grid %d)\n", hipGetErrorString(e), grid_blocks);
#else
#ifndef PHMAX
#define PHMAX 11
#endif
  for (int k = 0; k < PHMAX; k++) {
    p.lo = k; p.hi = k + 1;
    hipLaunchKernelGGL(fwd_kernel, dim3(grid_blocks), dim3(NTHREADS), LDS_BYTES, stream, p);
  }
#endif
}
```

```cpp
#include <hip/hip_runtime.h>
#include <hip/hip_cooperative_groups.h>
#include <cstdio>
#include <cstdint>
namespace cg = cooperative_groups;

typedef unsigned short u16;
typedef __attribute__((ext_vector_type(8))) short bf16x8;
typedef __attribute__((ext_vector_type(16))) float f32x16;

#ifndef MEGA
#define MEGA 1
#endif

constexpr int NT = 98304;
constexpr int NTP = 65536;
constexpr int NMEMROWS = 9216;
constexpr int NTHREADS = 256;
constexpr int LDS_BYTES = 73728;

constexpr size_t OFF_CTL = 0;
constexpr size_t OFF_WIN = 4096;
constexpr size_t OFF_WUQ = OFF_WIN + (size_t)6272 * 1024 * 2;
constexpr size_t OFF_WUKV = OFF_WUQ + (size_t)768 * 384 * 2;
constexpr size_t OFF_WOA = OFF_WUKV + (size_t)1024 * 256 * 2;
constexpr size_t OFF_WOB = OFF_WOA + (size_t)1024 * 768 * 2;
constexpr size_t OFF_WOC = OFF_WOB + (size_t)1024 * 512 * 2;
constexpr size_t OFF_WMKV = OFF_WOC + (size_t)1024 * 512 * 2;
constexpr size_t OFF_WOUT = OFF_WMKV + (size_t)2048 * 1024 * 2;
constexpr size_t OFF_WUP = OFF_WOUT + (size_t)1024 * 1024 * 2;
constexpr size_t OFF_WDOWN = OFF_WUP + (size_t)5632 * 1024 * 2;
constexpr size_t OFF_G2 = OFF_WDOWN + (size_t)1024 * 2816 * 2;
constexpr size_t OFF_W2F = OFF_G2 + (size_t)512 * 128 * 2;
constexpr size_t OFF_W2B = OFF_W2F + 65536;
constexpr size_t OFF_A2F = OFF_W2B + 65536;
constexpr size_t OFF_A2B = OFF_A2F + 65536;
constexpr size_t OFF_H = 50331648;
static_assert(OFF_A2B + 65536 <= OFF_H, "weights overflow");
constexpr size_t OFF_CQKV = OFF_H + (size_t)NT * 1024 * 2;
constexpr size_t OFF_RW = OFF_CQKV + (size_t)NT * 672 * 2;
constexpr size_t OFF_XQ = OFF_RW + (size_t)NT * 1920 * 2;
constexpr size_t OFF_MH = OFF_XQ + (size_t)NT * 512 * 2;
constexpr size_t OFF_MKV = OFF_MH + (size_t)NMEMROWS * 1024 * 2;
constexpr size_t OFF_MK = OFF_MKV + (size_t)NMEMROWS * 2048 * 2;
constexpr size_t OFF_MVT = OFF_MK + (size_t)NMEMROWS * 512 * 2;
constexpr size_t OFF_YB = OFF_MVT + (size_t)NMEMROWS * 512 * 2;
constexpr size_t WS_END = OFF_YB + (size_t)NT * 512 * 2;
static_assert(WS_END <= (size_t)1073741824, "workspace overflow");
constexpr size_t OFF_YF = OFF_CQKV;
constexpr size_t OFF_MERGED = OFF_RW;
constexpr size_t OFF_ACT = OFF_CQKV;
static_assert((size_t)NT * 2816 * 2 <= OFF_MH - OFF_CQKV, "act overflow");
constexpr size_t DO_Q = 0;
constexpr size_t DO_K = (size_t)NT * 768 * 2;
constexpr size_t DO_VT = DO_K + (size_t)NT * 768 * 2;

struct Params {
  const float* in[41];
  float* out;
  unsigned char* ws;
  int lo, hi;
};

typedef __bf16 bf16x2_t __attribute__((ext_vector_type(2)));
typedef float f32x2_t __attribute__((ext_vector_type(2)));
__device__ __forceinline__ unsigned pack2(float a, float b) {
  f32x2_t f = {a, b};
  bf16x2_t h = __builtin_convertvector(f, bf16x2_t);
  return __builtin_bit_cast(unsigned, h);
}
__device__ __forceinline__ u16 f2bf(float f) { return (u16)(pack2(f, f) & 0xffffu); }
__device__ __forceinline__ float bf2f(u16 b) { return __uint_as_float(((unsigned)b) << 16); }
__device__ __forceinline__ float bflo(unsigned u) { return __uint_as_float(u << 16); }
__device__ __forceinline__ float bfhi(unsigned u) { return __uint_as_float(u & 0xffff0000u); }

template <int CTRL>
__device__ __forceinline__ float dppf(float v) {
  return __int_as_float(__builtin_amdgcn_mov_dpp(__float_as_int(v), CTRL, 0xF, 0xF, true));
}
__device__ __forceinline__ float sum16(float v) {
  v += dppf<0xB1>(v);
  v += dppf<0x4E>(v);
  v += dppf<0x141>(v);
  v += dppf<0x140>(v);
  return v;
}
__device__ __forceinline__ float sum8(float v) {
  v += dppf<0xB1>(v);
  v += dppf<0x4E>(v);
  v += dppf<0x141>(v);
  return v;
}
__device__ __forceinline__ float wave_sum(float v) {
  v = sum16(v);
  v += __shfl_xor(v, 16);
  v += __shfl_xor(v, 32);
  return v;
}
__device__ __forceinline__ float sigmoidf_(float x) { return 1.f / (1.f + __expf(-x)); }

__device__ __forceinline__ void tok_seq(int g, int& seq, int& start, int& T) {
  if (g < NTP) { seq = g >> 11; start = seq << 11; T = 2048; }
  else { int s = (g - NTP) >> 13; seq = 32 + s; start = NTP + (s << 13); T = 8192; }
}
__device__ __forceinline__ size_t vt_base(int seq) {
  return seq < 32 ? (size_t)seq * (512 * 2048) : (size_t)32 * 512 * 2048 + (size_t)(seq - 32) * (512 * 8192);
}

struct Acc { f32x16 a[2][2]; };
constexpr int LROW = 72;
constexpr int LTILE = 128 * LROW;

__device__ __forceinline__ void acc_zero(Acc& acc) {
#pragma unroll
  for (int i = 0; i < 2; i++)
#pragma unroll
    for (int j = 0; j < 2; j++)
#pragma unroll
      for (int r = 0; r < 16; r++) acc.a[i][j][r] = 0.f;
}

__device__ __forceinline__ void gemm_compute(Acc& acc, const u16* lds, int b) {
  const int lane = threadIdx.x & 63, wave = threadIdx.x >> 6, wm = wave >> 1, wn = wave & 1;
  const u16* A = lds + b * (2 * LTILE) + (64 * wm + (lane & 31)) * LROW + 8 * (lane >> 5);
  const u16* B = lds + b * (2 * LTILE) + LTILE + (64 * wn + (lane & 31)) * LROW + 8 * (lane >> 5);
#pragma unroll
  for (int s = 0; s < 4; s++) {
    bf16x8 a0 = *(const bf16x8*)(A + 16 * s);
    bf16x8 a1 = *(const bf16x8*)(A + 32 * LROW + 16 * s);
    bf16x8 b0 = *(const bf16x8*)(B + 16 * s);
    bf16x8 b1 = *(const bf16x8*)(B + 32 * LROW + 16 * s);
    acc.a[0][0] = __builtin_amdgcn_mfma_f32_32x32x16_bf16(a0, b0, acc.a[0][0], 0, 0, 0);
    acc.a[0][1] = __builtin_amdgcn_mfma_f32_32x32x16_bf16(a0, b1, acc.a[0][1], 0, 0, 0);
    acc.a[1][0] = __builtin_amdgcn_mfma_f32_32x32x16_bf16(a1, b0, acc.a[1][0], 0, 0, 0);
    acc.a[1][1] = __builtin_amdgcn_mfma_f32_32x32x16_bf16(a1, b1, acc.a[1][1], 0, 0, 0);
  }
}

template <bool SINGLE = false, bool DEEP = true>
__device__ __forceinline__ void gemm_main(Acc& acc, u16* lds, const u16* pa0, const u16* pa1, const u16* pa2,
                                          const u16* pa3, const u16* pb0, const u16* pb1, const u16* pb2,
                                          const u16* pb3, int K) {
  const int tid = threadIdx.x;
  const int lr = tid >> 3, lk = (tid & 7) * 8;
  uint4 xa0, xa1, xa2, xa3, xb0, xb1, xb2, xb3;
  uint4 ya0, ya1, ya2, ya3, yb0, yb1, yb2, yb3;
  const int nk = K >> 6;
#define GLOAD(S, k0)                                                                         \
  S##a0 = *(const uint4*)(pa0 + (k0) + lk); S##a1 = *(const uint4*)(pa1 + (k0) + lk);         \
  S##a2 = *(const uint4*)(pa2 + (k0) + lk); S##a3 = *(const uint4*)(pa3 + (k0) + lk);         \
  S##b0 = *(const uint4*)(pb0 + (k0) + lk); S##b1 = *(const uint4*)(pb1 + (k0) + lk);         \
  S##b2 = *(const uint4*)(pb2 + (k0) + lk); S##b3 = *(const uint4*)(pb3 + (k0) + lk);
#define SSTORE(S, b)                                                                         \
  {                                                                                          \
    u16* A_ = lds + (b) * (2 * LTILE) + lr * LROW + lk;                                      \
    u16* B_ = A_ + LTILE;                                                                    \
    *(uint4*)(A_) = S##a0; *(uint4*)(A_ + 32 * LROW) = S##a1;                                \
    *(uint4*)(A_ + 64 * LROW) = S##a2; *(uint4*)(A_ + 96 * LROW) = S##a3;                    \
    *(uint4*)(B_) = S##b0; *(uint4*)(B_ + 32 * LROW) = S##b1;                                \
    *(uint4*)(B_ + 64 * LROW) = S##b2; *(uint4*)(B_ + 96 * LROW) = S##b3;                    \
  }
  if (!DEEP) {
    GLOAD(x, 0)
    SSTORE(x, 0)
    __syncthreads();
    for (int kt = 0; kt < nk; kt++) {
      if (kt + 1 < nk) { GLOAD(x, (kt + 1) * 64) }
      gemm_compute(acc, lds, SINGLE ? 0 : (kt & 1));
      if (SINGLE) __syncthreads();
      if (kt + 1 < nk) { SSTORE(x, SINGLE ? 0 : ((kt + 1) & 1)) }
      __syncthreads();
    }
    return;
  }
  GLOAD(x, 0)
  GLOAD(y, 64)
  SSTORE(x, 0)
  __syncthreads();
  for (int kt = 0; kt < nk; kt += 2) {
    if (kt + 2 < nk) { GLOAD(x, (kt + 2) * 64) }
    __builtin_amdgcn_sched_barrier(0);
    gemm_compute(acc, lds, 0);
    if (SINGLE) __syncthreads();
    SSTORE(y, SINGLE ? 0 : 1)
    __syncthreads();
    if (kt + 3 < nk) { GLOAD(y, (kt + 3) * 64) }
    __builtin_amdgcn_sched_barrier(0);
    gemm_compute(acc, lds, SINGLE ? 0 : 1);
    if (SINGLE) __syncthreads();
    if (kt + 2 < nk) { SSTORE(x, 0) }
    __syncthreads();
  }
#undef GLOAD
#undef SSTORE
}

template <bool SINGLE = false, bool DEEP = true>
__device__ __forceinline__ void gemm_lin(Acc& acc, u16* lds, const u16* A, long lda, const u16* B, long ldb, int K) {
  const int lr = threadIdx.x >> 3;
  gemm_main<SINGLE, DEEP>(acc, lds, A + (long)lr * lda, A + (long)(lr + 32) * lda, A + (long)(lr + 64) * lda,
            A + (long)(lr + 96) * lda, B + (long)lr * ldb, B + (long)(lr + 32) * ldb, B + (long)(lr + 64) * ldb,
            B + (long)(lr + 96) * ldb, K);
}

template <class F>
__device__ __forceinline__ void epi_each(const Acc& acc, F f) {
  const int lane = threadIdx.x & 63, wave = threadIdx.x >> 6, wm = wave >> 1, wn = wave & 1;
#pragma unroll
  for (int i = 0; i < 2; i++)
#pragma unroll
    for (int j = 0; j < 2; j++)
#pragma unroll
      for (int g = 0; g < 4; g++) {
        int r0 = 64 * wm + 32 * i + 8 * g + 4 * (lane >> 5);
        int c = 64 * wn + 32 * j + (lane & 31);
        f(r0, c, acc.a[i][j][4 * g + 0], acc.a[i][j][4 * g + 1], acc.a[i][j][4 * g + 2], acc.a[i][j][4 * g + 3]);
      }
}

__device__ __forceinline__ void store_bf16_pairs(u16* colbase, long ld, int c, float v0, float v1, float v2, float v3) {
  const bool odd = c & 1;
  const float sA = odd ? v0 : v2, sB = odd ? v1 : v3;
  const float rA = dppf<0xB1>(sA), rB = dppf<0xB1>(sB);
  if (!odd) {
    *(unsigned*)(colbase) = pack2(v0, rA);
    *(unsigned*)(colbase + ld) = pack2(v1, rB);
  } else {
    *(unsigned*)(colbase + 2 * ld - 1) = pack2(rA, v2);
    *(unsigned*)(colbase + 3 * ld - 1) = pack2(rB, v3);
  }
}

__device__ __forceinline__ bool tile_map(int k, int MT, int NTL, int& mt, int& nt) {
  const int G = gridDim.x;
  if (G & 7) {
    int it = blockIdx.x + k * G;
    if (it >= MT * NTL) return false;
    mt = it / NTL; nt = it % NTL;
    return true;
  }
  const int xcd = blockIdx.x & 7, lb = blockIdx.x >> 3, nbx = G >> 3;
  const int mtx0 = (MT * xcd) >> 3, mtx1 = (MT * (xcd + 1)) >> 3, MTX = mtx1 - mtx0;
  const int idx = lb + k * nbx;
  if (idx >= MTX * NTL) return false;
  const int mg0 = idx / (8 * NTL);
  const int base = mg0 * 8;
  const int gsz = (MTX - base) < 8 ? (MTX - base) : 8;
  const int rem = idx - mg0 * 8 * NTL;
  nt = rem / gsz;
  mt = mtx0 + base + rem % gsz;
  return true;
}

template <class NMap, class KMap>
__device__ __forceinline__ void cvtw(const float* __restrict__ W, int srcN, u16* __restrict__ Wt, int dN, int dK,
                     const float* __restrict__ gain, NMap nmap, KMap kmap, long gtid, long gsz) {
  const int kch = dK >> 3;
  const long total = (long)dN * kch;
  for (long i = gtid; i < total; i += gsz) {
    int n = (int)(i % dN), kc = (int)(i / dN);
    int sn = nmap(n);
    float v[8];
#pragma unroll
    for (int j = 0; j < 8; j++) {
      int sk = kmap(kc * 8 + j);
      float x = 0.f;
      if (sn >= 0 && sk >= 0) {
        x = W[(long)sk * srcN + sn];
        if (gain) x *= gain[sk];
      }
      v[j] = x;
    }
    uint4 o;
    o.x = pack2(v[0], v[1]); o.y = pack2(v[2], v[3]); o.z = pack2(v[4], v[5]); o.w = pack2(v[6], v[7]);
    *(uint4*)(Wt + (long)n * dK + kc * 8) = o;
  }
}

__device__ __forceinline__ void phase0(const Params& P) {
  const long gtid = (long)blockIdx.x * NTHREADS + threadIdx.x, gsz = (long)gridDim.x * NTHREADS;
  unsigned char* ws = P.ws;
  if (gtid == 0) { ((unsigned*)(ws + OFF_CTL))[0] = 0u; ((unsigned*)(ws + OFF_CTL))[16] = 0u; }
  auto idn = [](int n) { return n; };
  cvtw(P.in[5], 6176, (u16*)(ws + OFF_WIN), 6272, 1024, P.in[4],
       [](int n) {
         if (n < 640) return n;
         if (n < 2560) return 672 + (n - 640);
         if (n < 3072) return 2592 + (n - 2560);
         if (n < 3104) return 640 + (n - 3072);
         if (n < 3200) return -1;
         return 3104 + (n - 3200);
       },
       idn, gtid, gsz);
  cvtw(P.in[7], 768, (u16*)(ws + OFF_WUQ), 768, 384, P.in[6], idn, idn, gtid, gsz);
  cvtw(P.in[9], 1024, (u16*)(ws + OFF_WUKV), 1024, 256, P.in[8], idn, idn, gtid, gsz);
  cvtw(P.in[12], 1024, (u16*)(ws + OFF_WOA), 1024, 768, nullptr, idn,
       [](int k) { int h = k / 96, d = k % 96; return d < 64 ? h * 64 + d : -1; }, gtid, gsz);
  cvtw(P.in[29], 1024, (u16*)(ws + OFF_WOB), 1024, 512, nullptr, idn, idn, gtid, gsz);
  cvtw(P.in[34], 1024, (u16*)(ws + OFF_WOC), 1024, 512, nullptr, idn, idn, gtid, gsz);
  cvtw(P.in[31], 1024, (u16*)(ws + OFF_WMKV), 1024, 1024, P.in[30], idn, idn, gtid, gsz);
  cvtw(P.in[35], 1024, (u16*)(ws + OFF_WOUT), 1024, 1024, nullptr, idn, idn, gtid, gsz);
  cvtw(P.in[37], 5632, (u16*)(ws + OFF_WUP), 5632, 1024, P.in[36],
       [](int n) { int t = n >> 7, w = n & 127; return w < 64 ? t * 64 + w : 2816 + t * 64 + (w - 64); }, idn, gtid, gsz);
  cvtw(P.in[40], 1024, (u16*)(ws + OFF_WDOWN), 1024, 2816, nullptr, idn, idn, gtid, gsz);
  cvtw(P.in[23], 512, (u16*)(ws + OFF_G2), 512, 128, nullptr, idn, idn, gtid, gsz);
  cvtw(P.in[16], 512, (u16*)(ws + OFF_W2F), 512, 64, nullptr, idn, idn, gtid, gsz);
  cvtw(P.in[20], 512, (u16*)(ws + OFF_W2B), 512, 64, nullptr, idn, idn, gtid, gsz);
  cvtw(P.in[18], 512, (u16*)(ws + OFF_A2F), 512, 64, nullptr, idn, idn, gtid, gsz);
  cvtw(P.in[22], 512, (u16*)(ws + OFF_A2B), 512, 64, nullptr, idn, idn, gtid, gsz);
}

__device__ __forceinline__ void norm_row(const float* __restrict__ src, u16* __restrict__ dst) {
  const int lane = threadIdx.x & 63;
  float4 v0 = *(const float4*)(src + lane * 4);
  float4 v1 = *(const float4*)(src + 256 + lane * 4);
  float4 v2 = *(const float4*)(src + 512 + lane * 4);
  float4 v3 = *(const float4*)(src + 768 + lane * 4);
  float ss = v0.x * v0.x + v0.y * v0.y + v0.z * v0.z + v0.w * v0.w + v1.x * v1.x + v1.y * v1.y + v1.z * v1.z +
             v1.w * v1.w + v2.x * v2.x + v2.y * v2.y + v2.z * v2.z + v2.w * v2.w + v3.x * v3.x + v3.y * v3.y +
             v3.z * v3.z + v3.w * v3.w;
  ss = wave_sum(ss);
  float r = rsqrtf(ss * (1.f / 1024.f) + 1e-6f);
  uint2 o;
  o.x = pack2(v0.x * r, v0.y * r); o.y = pack2(v0.z * r, v0.w * r); *(uint2*)(dst + lane * 4) = o;
  o.x = pack2(v1.x * r, v1.y * r); o.y = pack2(v1.z * r, v1.w * r); *(uint2*)(dst + 256 + lane * 4) = o;
  o.x = pack2(v2.x * r, v2.y * r); o.y = pack2(v2.z * r, v2.w * r); *(uint2*)(dst + 512 + lane * 4) = o;
  o.x = pack2(v3.x * r, v3.y * r); o.y = pack2(v3.z * r, v3.w * r); *(uint2*)(dst + 768 + lane * 4) = o;
}

__device__ __forceinline__ void phase0b(const Params& P) {
  const int wave = threadIdx.x >> 6;
  u16* H = (u16*)(P.ws + OFF_H);
  u16* MH = (u16*)(P.ws + OFF_MH);
  for (int row = blockIdx.x * 4 + wave; row < NT + NMEMROWS; row += gridDim.x * 4) {
    if (row < NT) {
      const float* src = row < NTP ? P.in[0] + (size_t)row * 1024 : P.in[1] + (size_t)(row - NTP) * 1024;
      norm_row(src, H + (size_t)row * 1024);
    } else {
      int mr = row - NT;
      const float* src = mr < 8192 ? P.in[2] + (size_t)mr * 1024 : P.in[3] + (size_t)(mr - 8192) * 1024;
      norm_row(src, MH + (size_t)mr * 1024);
    }
  }
}

__device__ __forceinline__ void phase1(const Params& P, u16* lds) {
  unsigned char* ws = P.ws;
  const u16* H = (const u16*)(ws + OFF_H);
  const u16* Win = (const u16*)(ws + OFF_WIN);
  u16* CQKV = (u16*)(ws + OFF_CQKV);
  u16* RW = (u16*)(ws + OFF_RW);
  u16* XQ = (u16*)(ws + OFF_XQ);
  for (int kk_ = 0;; kk_++) {
    int mt, nt;
    if (!tile_map(kk_, 768, 25, mt, nt)) break;
    Acc acc; acc_zero(acc);
    {
      int m0 = mt * 128, n0 = nt * 128;
      gemm_lin(acc, lds, H + (size_t)m0 * 1024, 1024, Win + (size_t)n0 * 1024, 1024, 1024);
      epi_each(acc, [&](int r0, int c, float v0, float v1, float v2, float v3) {
        int n = n0 + c;
        u16* dst; int ld;
        if (n < 640) { dst = CQKV + n; ld = 672; }
        else if (n < 2560) { dst = RW + (n - 640); ld = 1920; }
        else if (n < 3072) { dst = XQ + (n - 2560); ld = 512; }
        else if (n < 3104) { dst = CQKV + 640 + (n - 3072); ld = 672; }
        else return;
        store_bf16_pairs(dst + (size_t)(m0 + r0) * ld, ld, c, v0, v1, v2, v3);
      });
    }
  }
  for (int i2 = blockIdx.x; i2 < 72 * 8; i2 += gridDim.x) {
    Acc acc; acc_zero(acc);
    {
      int mt = i2 / 8, nt = i2 % 8;
      int m0 = mt * 128, n0 = nt * 128;
      gemm_lin(acc, lds, (const u16*)(ws + OFF_MH) + (size_t)m0 * 1024, 1024, (const u16*)(ws + OFF_WMKV) + (size_t)n0 * 1024, 1024, 1024);
      u16* MKV = (u16*)(ws + OFF_MKV);
      epi_each(acc, [&](int r0, int c, float v0, float v1, float v2, float v3) {
        u16* dst = MKV + (size_t)(m0 + r0) * 1024 + n0 + c;
        dst[0] = f2bf(v0); dst[1024] = f2bf(v1); dst[2048] = f2bf(v2); dst[3072] = f2bf(v3);
      });
    }
  }
}

__device__ __forceinline__ void phase2(const Params& P, u16* lds) {
  unsigned char* ws = P.ws;
  const u16* CQKV = (const u16*)(ws + OFF_CQKV);
  u16* Q = (u16*)((unsigned char*)P.out + DO_Q);
  u16* Kb = (u16*)((unsigned char*)P.out + DO_K);
  u16* Vt = (u16*)((unsigned char*)P.out + DO_VT);
  __shared__ float rstd_s[128];
  const int tid = threadIdx.x;
  for (int it = blockIdx.x; it < 768 * 14; it += gridDim.x) {
    int mt = it / 14, nt = it % 14;
    int m0 = mt * 128;
    const bool isq = nt < 6;
    {
      int r = tid >> 1, hf = tid & 1;
      const u16* src = CQKV + (size_t)(m0 + r) * 672 + (isq ? hf * 192 : 384 + hf * 128);
      int nch = isq ? 24 : 16;
      float ss = 0.f;
      for (int c = 0; c < nch; c++) {
        uint4 u = *(const uint4*)(src + c * 8);
        float a;
        a = bflo(u.x); ss += a * a; a = bfhi(u.x); ss += a * a;
        a = bflo(u.y); ss += a * a; a = bfhi(u.y); ss += a * a;
        a = bflo(u.z); ss += a * a; a = bfhi(u.z); ss += a * a;
        a = bflo(u.w); ss += a * a; a = bfhi(u.w); ss += a * a;
      }
      ss += dppf<0xB1>(ss);
      if (hf == 0) rstd_s[r] = rsqrtf(ss / (isq ? 384.f : 256.f) + 1e-6f);
    }
    __syncthreads();
    Acc acc; acc_zero(acc);
    if (isq) {
      int n0 = nt * 128;
      gemm_lin(acc, lds, CQKV + (size_t)m0 * 672, 672, (const u16*)(ws + OFF_WUQ) + (size_t)n0 * 384, 384, 384);
      epi_each(acc, [&](int r0, int c, float v0, float v1, float v2, float v3) {
        store_bf16_pairs(Q + (size_t)(m0 + r0) * 768 + n0 + c, 768, c, v0 * rstd_s[r0], v1 * rstd_s[r0 + 1],
                         v2 * rstd_s[r0 + 2], v3 * rstd_s[r0 + 3]);
      });
    } else {
      int head = nt - 6;
      int n0 = head * 128;
      gemm_lin(acc, lds, CQKV + (size_t)m0 * 672 + 384, 672, (const u16*)(ws + OFF_WUKV) + (size_t)n0 * 256, 256, 256);
      int seq, start, T;
      tok_seq(m0, seq, start, T);
      u16* vtb = Vt + vt_base(seq) + (size_t)head * 64 * T + (m0 - start);
      epi_each(acc, [&](int r0, int c, float v0, float v1, float v2, float v3) {
        v0 *= rstd_s[r0]; v1 *= rstd_s[r0 + 1]; v2 *= rstd_s[r0 + 2]; v3 *= rstd_s[r0 + 3];
        if (c < 64) {
          u16* dst = Kb + (size_t)(m0 + r0) * 768 + head * 96 + c;
          dst[0] = f2bf(v0); dst[768] = f2bf(v1); dst[1536] = f2bf(v2); dst[2304] = f2bf(v3);
        } else {
          uint2 o; o.x = pack2(v0, v1); o.y = pack2(v2, v3);
          *(uint2*)(vtb + (size_t)(c - 64) * T + r0) = o;
        }
      });
    }
    __syncthreads();
  }
}

__device__ __forceinline__ void phase3(const Params& P) {
  unsigned char* ws = P.ws;
  const u16* CQKV = (const u16*)(ws + OFF_CQKV);
  u16* Kb = (u16*)((unsigned char*)P.out + DO_K);
  const float* gk = P.in[11];
  const int tid = threadIdx.x;
  const int sub = tid >> 4, i = tid & 15;
  const float inv = powf(10000.f, -(float)i / 16.f);
  const float g0 = gk[4 * i], g1 = gk[4 * i + 1], g2 = gk[4 * i + 2], g3 = gk[4 * i + 3], gr1 = gk[64 + i], gr2 = gk[80 + i];
  for (long pr = (long)blockIdx.x * 16 + sub; pr < (long)NT * 8; pr += (long)gridDim.x * 16) {
    int tok = (int)(pr >> 3), head = (int)(pr & 7);
    u16* kp = Kb + (size_t)tok * 768 + head * 96;
    uint2 u = *(const uint2*)(kp + 4 * i);
    float a0 = bflo(u.x), a1 = bfhi(u.x), a2 = bflo(u.y), a3 = bfhi(u.y);
    float x1 = bf2f(CQKV[(size_t)tok * 672 + 640 + i]);
    float x2 = bf2f(CQKV[(size_t)tok * 672 + 656 + i]);
    float ss = a0 * a0 + a1 * a1 + a2 * a2 + a3 * a3 + x1 * x1 + x2 * x2;
    ss = sum16(ss);
    float r = rsqrtf(ss * (1.f / 96.f) + 1e-6f);
    int seq, start, T;
    tok_seq(tok, seq, start, T);
    float ang = (float)(tok - start) * inv;
    float sn, cs;
    sincosf(ang, &sn, &cs);
    x1 *= r * gr1; x2 *= r * gr2;
    uint2 o; o.x = pack2(a0 * r * g0, a1 * r * g1); o.y = pack2(a2 * r * g2, a3 * r * g3);
    *(uint2*)(kp + 4 * i) = o;
    kp[64 + i] = f2bf(x1 * cs - x2 * sn);
    kp[80 + i] = f2bf(x2 * cs + x1 * sn);
  }
  const u16* MKV = (const u16*)(ws + OFF_MKV);
  u16* MK = (u16*)(ws + OFF_MK);
  u16* MVT = (u16*)(ws + OFF_MVT);
  const float* gxk = P.in[33];
  for (int pr = blockIdx.x * 16 + sub; pr < NMEMROWS * 4; pr += gridDim.x * 16) {
    int row = pr >> 2, head = pr & 3;
    int b = row >> 8, key = row & 255;
    uint4 u = *(const uint4*)(MKV + (size_t)row * 1024 + head * 256 + 8 * i);
    float a0 = bflo(u.x), a1 = bfhi(u.x), a2 = bflo(u.y), a3 = bfhi(u.y), a4 = bflo(u.z), a5 = bfhi(u.z), a6 = bflo(u.w), a7 = bfhi(u.w);
    float ss = a0 * a0 + a1 * a1 + a2 * a2 + a3 * a3 + a4 * a4 + a5 * a5 + a6 * a6 + a7 * a7;
    ss = sum16(ss);
    float r = rsqrtf(ss * (1.f / 128.f) + 1e-6f);
    const float* g = gxk + 8 * i;
    uint4 o;
    o.x = pack2(a0 * r * g[0], a1 * r * g[1]); o.y = pack2(a2 * r * g[2], a3 * r * g[3]);
    o.z = pack2(a4 * r * g[4], a5 * r * g[5]); o.w = pack2(a6 * r * g[6], a7 * r * g[7]);
    *(uint4*)(MK + ((size_t)(b * 4 + head) * 256 + key) * 128 + 8 * i) = o;
  }
  for (long e = (long)blockIdx.x * NTHREADS + tid; e < (long)NMEMROWS * 512; e += (long)gridDim.x * NTHREADS) {
    int row = (int)(e >> 9), c = (int)(e & 511);
    int head = c >> 7, dv = c & 127;
    int b = row >> 8, key = row & 255;
    MVT[((size_t)(b * 4 + head) * 128 + dv) * 256 + key] = MKV[(size_t)row * 1024 + head * 256 + 128 + dv];
  }
}

template <int DQK, int DV, bool ROPE, bool PREF>
__device__ __forceinline__ void attn_item(u16* lds, const u16* Qp, long qld, const u16* Kp, long kld, const u16* Vtp, long vld,
                          int nkeys, const float* __restrict__ gq, float qscale, int tpos0, u16* Op, long old) {
  constexpr int KP = DQK + 8;
  constexpr int KT = 64 * KP;
  constexpr int VT = DV * 72;
  constexpr int BUF = KT + VT;
  constexpr int NS = DQK / 16;
  constexpr int ND = DV / 32;
  constexpr int KCH = DQK / 8;
  constexpr int NKC = 64 * KCH / 256;
  constexpr int NVC = DV * 8 / 256;
  const int tid = threadIdx.x, lane = tid & 63, wave = tid >> 6, h = lane >> 5, lr = lane & 31;

  bf16x8 qf[NS];
  {
    const u16* qp = Qp + (long)(32 * wave + lr) * qld + 8 * h;
    float qv[NS][8];
    float ss = 0.f;
#pragma unroll
    for (int s = 0; s < NS; s++) {
      uint4 u = *(const uint4*)(qp + 16 * s);
      qv[s][0] = bflo(u.x); qv[s][1] = bfhi(u.x); qv[s][2] = bflo(u.y); qv[s][3] = bfhi(u.y);
      qv[s][4] = bflo(u.z); qv[s][5] = bfhi(u.z); qv[s][6] = bflo(u.w); qv[s][7] = bfhi(u.w);
#pragma unroll
      for (int j = 0; j < 8; j++) ss += qv[s][j] * qv[s][j];
    }
    ss += __shfl_xor(ss, 32);
    float r = rsqrtf(ss * (1.f / DQK) + 1e-6f);
#pragma unroll
    for (int s = 0; s < NS; s++)
#pragma unroll
      for (int j = 0; j < 8; j++) qv[s][j] *= r * gq[16 * s + 8 * h + j];
    if (ROPE) {
      float t = (float)(tpos0 + 32 * wave + lr);
#pragma unroll
      for (int j = 0; j < 8; j++) {
        float inv = powf(10000.f, -(float)(8 * h + j) / 16.f);
        float sn, cs;
        sincosf(t * inv, &sn, &cs);
        float x1 = qv[NS - 2][j], x2 = qv[NS - 1][j];
        qv[NS - 2][j] = x1 * cs - x2 * sn;
        qv[NS - 1][j] = x2 * cs + x1 * sn;
      }
    }
#pragma unroll
    for (int s = 0; s < NS; s++) {
      uint4 u;
      u.x = pack2(qv[s][0] * qscale, qv[s][1] * qscale); u.y = pack2(qv[s][2] * qscale, qv[s][3] * qscale);
      u.z = pack2(qv[s][4] * qscale, qv[s][5] * qscale); u.w = pack2(qv[s][6] * qscale, qv[s][7] * qscale);
      qf[s] = *(bf16x8*)&u;
    }
  }

  f32x16 o[ND];
#pragma unroll
  for (int d = 0; d < ND; d++)
#pragma unroll
    for (int r = 0; r < 16; r++) o[d][r] = 0.f;
  float lsum = 0.f;

  uint4 rk[NKC], rv[NVC];
  const int nkt = nkeys >> 6;
#define AGLOAD(kt)                                                                           \
  {                                                                                          \
    _Pragma("unroll") for (int i = 0; i < NKC; i++) {                                        \
      int c = tid + 256 * i; int row = c / KCH, kc = c % KCH;                                \
      rk[i] = *(const uint4*)(Kp + (long)((kt) * 64 + row) * kld + kc * 8);                  \
    }                                                                                        \
    _Pragma("unroll") for (int i = 0; i < NVC; i++) {                                        \
      int c = tid + 256 * i; int row = c >> 3, kc = c & 7;                                   \
      rv[i] = *(const uint4*)(Vtp + (long)row * vld + (kt) * 64 + kc * 8);                   \
    }                                                                                        \
  }
#define ASTORE(b)                                                                            \
  {                                                                                          \
    u16* Kl = lds + (b) * BUF; u16* Vl = Kl + KT;                                            \
    _Pragma("unroll") for (int i = 0; i < NKC; i++) {                                        \
      int c = tid + 256 * i; int row = c / KCH, kc = c % KCH;                                \
      *(uint4*)(Kl + row * KP + kc * 8) = rk[i];                                             \
    }                                                                                        \
    _Pragma("unroll") for (int i = 0; i < NVC; i++) {                                        \
      int c = tid + 256 * i; int row = c >> 3, kc = c & 7;                                   \
      *(uint4*)(Vl + row * 72 + kc * 8) = rv[i];                                             \
    }                                                                                        \
  }
  AGLOAD(0)
  ASTORE(0)
  __syncthreads();
  for (int kt = 0; kt < nkt; kt++) {
    if (PREF) { if (kt + 1 < nkt) AGLOAD(kt + 1) }
    else { if (kt + 1 < nkt) { AGLOAD(kt + 1) ASTORE((kt + 1) & 1) } }
    const u16* Kl = lds + (kt & 1) * BUF;
    const u16* Vl = Kl + KT;
#pragma unroll
    for (int ks = 0; ks < 2; ks++) {
      f32x16 st;
#pragma unroll
      for (int r = 0; r < 16; r++) st[r] = 0.f;
      const u16* kr = Kl + (32 * ks + lr) * KP + 8 * h;
#pragma unroll
      for (int s = 0; s < NS; s++) {
        bf16x8 kf = *(const bf16x8*)(kr + 16 * s);
        st = __builtin_amdgcn_mfma_f32_32x32x16_bf16(kf, qf[s], st, 0, 0, 0);
      }
      float p[16];
#pragma unroll
      for (int r = 0; r < 16; r++) { p[r] = __builtin_amdgcn_exp2f(st[r]); lsum += p[r]; }
#pragma unroll
      for (int s2 = 0; s2 < 2; s2++) {
        uint4 u;
        u.x = pack2(p[8 * s2 + 0], p[8 * s2 + 1]); u.y = pack2(p[8 * s2 + 2], p[8 * s2 + 3]);
        u.z = pack2(p[8 * s2 + 4], p[8 * s2 + 5]); u.w = pack2(p[8 * s2 + 6], p[8 * s2 + 7]);
        bf16x8 pb = *(bf16x8*)&u;
#pragma unroll
        for (int d = 0; d < ND; d++) {
          const u16* vr = Vl + (32 * d + lr) * 72 + 32 * ks + 16 * s2 + 4 * h;
          uint2 v0 = *(const uint2*)(vr);
          uint2 v1 = *(const uint2*)(vr + 8);
          uint4 vv; vv.x = v0.x; vv.y = v0.y; vv.z = v1.x; vv.w = v1.y;
          bf16x8 vf = *(bf16x8*)&vv;
          o[d] = __builtin_amdgcn_mfma_f32_32x32x16_bf16(vf, pb, o[d], 0, 0, 0);
        }
      }
    }
    if (PREF) { if (kt + 1 < nkt) ASTORE((kt + 1) & 1) }
    __syncthreads();
  }
#undef AGLOAD
#undef ASTORE
  lsum += __shfl_xor(lsum, 32);
  float il = 1.f / lsum;
  u16* op = Op + (long)(32 * wave + lr) * old;
#pragma unroll
  for (int d = 0; d < ND; d++)
#pragma unroll
    for (int g = 0; g < 4; g++) {
      uint2 u;
      u.x = pack2(o[d][4 * g] * il, o[d][4 * g + 1] * il);
      u.y = pack2(o[d][4 * g + 2] * il, o[d][4 * g + 3] * il);
      *(uint2*)(op + 32 * d + 8 * g + 4 * h) = u;
    }
}

typedef __attribute__((ext_vector_type(2))) float f32x2;
constexpr int SC_OP = 2048;
constexpr int SC_WR = 0, SC_KK = SC_OP, SC_WD = 2 * SC_OP, SC_KD = 3 * SC_OP, SC_BB = 4 * SC_OP;
constexpr int SC_R = SC_WR, SC_K = SC_KK, SC_LW = SC_WD, SC_LA = SC_KD;
constexpr int SC_V = 5 * SC_OP, SC_BR = SC_V + 2048, SC_CKR = SC_BR + 32, SC_Y = SC_CKR + 32;
constexpr int SC_END = SC_Y + 2048;
constexpr int SC_TW_B = SC_END * 4;
constexpr int SC_AL_B = SC_TW_B + 32 * 72 * 2;
static_assert(SC_AL_B + 32 * 72 * 2 + 960 * 4 <= LDS_BYTES, "scan lds");

__device__ __forceinline__ float fexp(float x) { return __builtin_amdgcn_exp2f(x * 1.4426950408889634f); }
__device__ __forceinline__ float frcp(float x) { return __builtin_amdgcn_rcpf(x); }
__device__ __forceinline__ float ftanh(float x) { return 1.f - 2.f * frcp(1.f + fexp(2.f * x)); }
__device__ __forceinline__ float fsigm(float x) { return frcp(1.f + fexp(-x)); }

struct Raw3 { uint4 c, a, b; };
__device__ __forceinline__ Raw3 ld3(const u16* __restrict__ p, bool hp, bool hn) {
  Raw3 r;
  r.c = *(const uint4*)p;
  r.a = hp ? *(const uint4*)(p - 1920) : make_uint4(0, 0, 0, 0);
  r.b = hn ? *(const uint4*)(p + 1920) : make_uint4(0, 0, 0, 0);
  return r;
}
__device__ __forceinline__ void mixr(const Raw3& r, const float* __restrict__ mp, const float* __restrict__ mn, float* out) {
  float cc[8] = {bflo(r.c.x), bfhi(r.c.x), bflo(r.c.y), bfhi(r.c.y), bflo(r.c.z), bfhi(r.c.z), bflo(r.c.w), bfhi(r.c.w)};
  float aa[8] = {bflo(r.a.x), bfhi(r.a.x), bflo(r.a.y), bfhi(r.a.y), bflo(r.a.z), bfhi(r.a.z), bflo(r.a.w), bfhi(r.a.w)};
  float bb[8] = {bflo(r.b.x), bfhi(r.b.x), bflo(r.b.y), bfhi(r.b.y), bflo(r.b.z), bfhi(r.b.z), bflo(r.b.w), bfhi(r.b.w)};
#pragma unroll
  for (int j = 0; j < 8; j++) out[j] = cc[j] + mp[j] * (aa[j] - cc[j]) + mn[j] * (bb[j] - cc[j]);
}
__device__ __forceinline__ void mix8(const u16* __restrict__ p, bool hp, bool hn, const float* __restrict__ mp,
                                     const float* __restrict__ mn, float* out) {
  Raw3 r = ld3(p, hp, hn);
  mixr(r, mp, mn, out);
}

template <int NRG>
__device__ __forceinline__ void scan_item(const Params& P, unsigned char* ldsb, int seq, int head, int dir, int rg) {
  float* L = (float*)ldsb;
  u16* TWb = (u16*)(ldsb + SC_TW_B);
  u16* ALb = (u16*)(ldsb + SC_AL_B);
  unsigned char* ws = P.ws;
  const u16* RW = (const u16*)(ws + OFF_RW);
  u16* Y = (u16*)(ws + (dir ? OFF_YB : OFF_YF));
  const float* w0 = dir ? P.in[19] : P.in[15];
  const float* a0 = dir ? P.in[21] : P.in[17];
  const u16* w2t = (const u16*)(ws + (dir ? OFF_W2B : OFF_W2F));
  const u16* a2t = (const u16*)(ws + (dir ? OFF_A2B : OFF_A2F));
  const int T = seq < 32 ? 2048 : 8192;
  const int start = seq < 32 ? seq * 2048 : NTP + (seq - 32) * 8192;
  const int tid = threadIdx.x, lane = tid & 63, wave = tid >> 6;
  const int hc = head * 64;
  const int pt = tid >> 3, pc = (tid & 7) * 8;
  const int wlo = dir ? 1600 : 1536, alo = dir ? 1728 : 1664;
  float* CS = (float*)(ldsb + SC_AL_B + 32 * 72 * 2);
  for (int i = tid; i < 960; i += NTHREADS) {
    const int arr = i >> 6, c = i & 63;
    const float* src;
    switch (arr) {
      case 0: src = P.in[13] + hc; break;
      case 1: src = P.in[14] + hc; break;
      case 2: src = P.in[13] + 512 + hc; break;
      case 3: src = P.in[14] + 512 + hc; break;
      case 4: src = P.in[13] + 1024 + hc; break;
      case 5: src = P.in[14] + 1024 + hc; break;
      case 6: src = P.in[13] + wlo; break;
      case 7: src = P.in[14] + wlo; break;
      case 8: src = P.in[13] + alo; break;
      case 9: src = P.in[14] + alo; break;
      case 10: src = w0 + hc; break;
      case 11: src = a0 + hc; break;
      case 12: src = P.in[24] + hc; break;
      case 13: src = P.in[25] + hc; break;
      default: src = P.in[26] + hc; break;
    }
    CS[i] = src[c];
  }
  __syncthreads();
  const float *mpr = CS + pc, *mnr = CS + 64 + pc, *mpk = CS + 128 + pc, *mnk = CS + 192 + pc, *mpv = CS + 256 + pc,
              *mnv = CS + 320 + pc, *mpw = CS + 384 + pc, *mnw = CS + 448 + pc, *mpa = CS + 512 + pc, *mna = CS + 576 + pc,
              *cw0 = CS + 640 + pc, *ca0 = CS + 704 + pc, *ckk = CS + 768 + pc, *cka = CS + 832 + pc, *crk = CS + 896 + pc;
  const int rp = tid >> 3, seg = tid & 7;
  f32x2 st[8];
#pragma unroll
  for (int k = 0; k < 8; k++) st[k] = (f32x2){0.f, 0.f};
  const int nch = T >> 5;
  Raw3 g_r, g_k, g_v, g_w, g_a;
#define SLOAD(chn)                                                                     \
  {                                                                                    \
    const int t0_ = dir ? T - 32 * ((chn) + 1) : 32 * (chn);                           \
    const int t_ = t0_ + pt;                                                           \
    const bool hp_ = t_ > 0, hn_ = t_ < T - 1;                                         \
    const u16* base_ = RW + (size_t)(start + t_) * 1920;                               \
    g_r = ld3(base_ + hc + pc, hp_, hn_); g_k = ld3(base_ + 512 + hc + pc, hp_, hn_);  \
    g_v = ld3(base_ + 1024 + hc + pc, hp_, hn_); g_w = ld3(base_ + wlo + pc, hp_, hn_); \
    g_a = ld3(base_ + alo + pc, hp_, hn_);                                             \
  }
  SLOAD(0)
  for (int ch = 0; ch < nch; ch++) {
    const int t0 = dir ? T - 32 * (ch + 1) : 32 * ch;
    bf16x8 lb0, lb1, lb2, lb3;
    {
      const int mat = wave >> 1, ntile = wave & 1;
      const u16* Bsrc = (mat ? a2t : w2t) + (size_t)(hc + 32 * ntile + (lane & 31)) * 64 + 8 * (lane >> 5);
      lb0 = *(const bf16x8*)(Bsrc); lb1 = *(const bf16x8*)(Bsrc + 16); lb2 = *(const bf16x8*)(Bsrc + 32); lb3 = *(const bf16x8*)(Bsrc + 48);
    }
    {
      float v[8];
      mixr(g_r, mpr, mnr, v);
#pragma unroll
      for (int j = 0; j < 8; j++) L[SC_R + pt * 64 + pc + j] = v[j];
      mixr(g_k, mpk, mnk, v);
#pragma unroll
      for (int j = 0; j < 8; j++) L[SC_K + pt * 64 + pc + j] = v[j];
      mixr(g_v, mpv, mnv, v);
#pragma unroll
      for (int j = 0; j < 8; j++) L[SC_V + pt * 64 + pc + j] = v[j];
      mixr(g_w, mpw, mnw, v);
      uint4 u;
      u.x = pack2(ftanh(v[0]), ftanh(v[1])); u.y = pack2(ftanh(v[2]), ftanh(v[3]));
      u.z = pack2(ftanh(v[4]), ftanh(v[5])); u.w = pack2(ftanh(v[6]), ftanh(v[7]));
      *(uint4*)(TWb + pt * 72 + pc) = u;
      mixr(g_a, mpa, mna, v);
      u.x = pack2(v[0], v[1]); u.y = pack2(v[2], v[3]); u.z = pack2(v[4], v[5]); u.w = pack2(v[6], v[7]);
      *(uint4*)(ALb + pt * 72 + pc) = u;
    }
    __syncthreads();
    {
      const int mat = wave >> 1, ntile = wave & 1;
      const u16* Asrc = (mat ? ALb : TWb) + (lane & 31) * 72 + 8 * (lane >> 5);
      f32x16 c;
#pragma unroll
      for (int r = 0; r < 16; r++) c[r] = 0.f;
      c = __builtin_amdgcn_mfma_f32_32x32x16_bf16(*(const bf16x8*)(Asrc), lb0, c, 0, 0, 0);
      c = __builtin_amdgcn_mfma_f32_32x32x16_bf16(*(const bf16x8*)(Asrc + 16), lb1, c, 0, 0, 0);
      c = __builtin_amdgcn_mfma_f32_32x32x16_bf16(*(const bf16x8*)(Asrc + 32), lb2, c, 0, 0, 0);
      c = __builtin_amdgcn_mfma_f32_32x32x16_bf16(*(const bf16x8*)(Asrc + 48), lb3, c, 0, 0, 0);
      float* dst = L + (mat ? SC_LA : SC_LW);
#pragma unroll
      for (int r = 0; r < 16; r++) {
        int tr = (r & 3) + 8 * (r >> 2) + 4 * (lane >> 5);
        dst[tr * 64 + 32 * ntile + (lane & 31)] = c[r];
      }
    }
    __syncthreads();
    {
      float ssk = 0.f, br = 0.f, kr = 0.f, bon = 0.f;
      float kkr[8], av[8], kdv[8], rr[8], dec[8];
#pragma unroll
      for (int j = 0; j < 8; j++) {
        int o = pt * 64 + pc + j;
        float r = L[SC_R + o], k = L[SC_K + o];
        float wp = cw0[j] + L[SC_LW + o];
        float z = -wp;
        float sp = z > 15.f ? z : 0.6931471805599453f * __builtin_amdgcn_logf(1.f + fexp(z));
        float w = -sp - 0.5f;
        dec[j] = fexp(-fexp(w));
        float a = fsigm(ca0[j] + L[SC_LA + o]);
        av[j] = a;
        kkr[j] = k * ckk[j];
        ssk += kkr[j] * kkr[j];
        kdv[j] = k * (1.f + (a - 1.f) * cka[j]);
        rr[j] = r;
        kr += kdv[j] * r;
        bon += r * kdv[j] * crk[j];
      }
      ssk = sum8(ssk);
      float inrm = __builtin_amdgcn_rsqf(fmaxf(ssk, 1e-24f));
#pragma unroll
      for (int j = 0; j < 8; j++) {
        float kk = kkr[j] * inrm;
        float b = kk * av[j];
        br += b * rr[j];
        int o = pt * 64 + pc + j;
        L[SC_KK + o] = kk;
        L[SC_BB + o] = b;
        L[SC_WR + o] = dec[j] * rr[j];
        L[SC_WD + o] = dec[j];
        L[SC_KD + o] = kdv[j];
      }
      br = sum8(br); kr = sum8(kr); bon = sum8(bon);
      if ((tid & 7) == 0) { L[SC_BR + pt] = br; L[SC_CKR + pt] = kr + bon; }
    }
    __syncthreads();
    if (ch + 1 < nch) SLOAD(ch + 1)
    {
#pragma unroll 1
      for (int qo = 0; qo < 4; qo++) {
        f32x2 yk = (f32x2){0.f, 0.f};
#pragma unroll
        for (int qi = 0; qi < 8; qi++) {
          const int q = qo * 8 + qi;
          const int tt = dir ? 31 - q : q;
          const float* ob = L + tt * 64 + 8 * seg;
          float4 kka = *(const float4*)(ob + SC_KK), kkb = *(const float4*)(ob + SC_KK + 4);
          float4 wra = *(const float4*)(ob + SC_WR), wrb = *(const float4*)(ob + SC_WR + 4);
          float4 wda = *(const float4*)(ob + SC_WD), wdb = *(const float4*)(ob + SC_WD + 4);
          float4 bba = *(const float4*)(ob + SC_BB), bbb = *(const float4*)(ob + SC_BB + 4);
          float4 kda = *(const float4*)(ob + SC_KD), kdb = *(const float4*)(ob + SC_KD + 4);
          float br = L[SC_BR + tt], ckr = L[SC_CKR + tt];
          float kk[8] = {kka.x, kka.y, kka.z, kka.w, kkb.x, kkb.y, kkb.z, kkb.w};
          float wr[8] = {wra.x, wra.y, wra.z, wra.w, wrb.x, wrb.y, wrb.z, wrb.w};
          float wd[8] = {wda.x, wda.y, wda.z, wda.w, wdb.x, wdb.y, wdb.z, wdb.w};
          float bb[8] = {bba.x, bba.y, bba.z, bba.w, bbb.x, bbb.y, bbb.z, bbb.w};
          float kd[8] = {kda.x, kda.y, kda.z, kda.w, kdb.x, kdb.y, kdb.z, kdb.w};
          if (NRG == 1) {
            float2 vv = *(const float2*)(L + SC_V + tt * 64 + 2 * rp);
            f32x2 v2 = (f32x2){vv.x, vv.y};
            f32x2 p1 = st[0] * kk[0], p2 = st[0] * wr[0];
#pragma unroll
            for (int k = 1; k < 8; k++) { p1 += st[k] * kk[k]; p2 += st[k] * wr[k]; }
            p1.x = sum8(p1.x); p1.y = sum8(p1.y); p2.x = sum8(p2.x); p2.y = sum8(p2.y);
            f32x2 y2 = p2 - p1 * br + v2 * ckr;
            if (qi == seg) yk = y2;
#pragma unroll
            for (int k = 0; k < 8; k++) st[k] = st[k] * wd[k] - p1 * bb[k] + v2 * kd[k];
          } else {
            const float v = L[SC_V + tt * 64 + 32 * rg + rp];
            f32x2 q1 = st[0] * (f32x2){kk[0], kk[1]}, q2 = st[0] * (f32x2){wr[0], wr[1]};
#pragma unroll
            for (int i = 1; i < 4; i++) {
              q1 += st[i] * (f32x2){kk[2 * i], kk[2 * i + 1]};
              q2 += st[i] * (f32x2){wr[2 * i], wr[2 * i + 1]};
            }
            const float p1 = sum8(q1.x + q1.y), p2 = sum8(q2.x + q2.y);
            const float y = p2 - p1 * br + v * ckr;
            if (qi == seg) yk.x = y;
#pragma unroll
            for (int i = 0; i < 4; i++)
              st[i] = st[i] * (f32x2){wd[2 * i], wd[2 * i + 1]} - p1 * (f32x2){bb[2 * i], bb[2 * i + 1]} + v * (f32x2){kd[2 * i], kd[2 * i + 1]};
          }
        }
        {
          const int q = qo * 8 + seg;
          const int tt = dir ? 31 - q : q;
          if (NRG == 1) *(float2*)(L + SC_Y + tt * 64 + 2 * rp) = make_float2(yk.x, yk.y);
          else L[SC_Y + tt * 64 + 32 * rg + rp] = yk.x;
        }
      }
    }
    __syncthreads();
    if (NRG == 1 || (pc >> 5) == rg) {
      const float* yp = L + SC_Y + pt * 64 + pc;
      uint4 u;
      u.x = pack2(yp[0], yp[1]); u.y = pack2(yp[2], yp[3]); u.z = pack2(yp[4], yp[5]); u.w = pack2(yp[6], yp[7]);
      *(uint4*)(Y + (size_t)(start + t0 + pt) * 512 + hc + pc) = u;
    }
  }
#undef SLOAD
}

__device__ __forceinline__ void phase4(const Params& P, unsigned char* ldsb) {
  __shared__ int s_item;
  unsigned* ctr = (unsigned*)(P.ws + OFF_CTL);
  u16* lds = (u16*)ldsb;
  u16* Q = (u16*)((unsigned char*)P.out + DO_Q);
  const u16* Kb = (const u16*)((unsigned char*)P.out + DO_K);
  const u16* Vt = (const u16*)((unsigned char*)P.out + DO_VT);
  u16* XQ = (u16*)(P.ws + OFF_XQ);
  const u16* MK = (const u16*)(P.ws + OFF_MK);
  const u16* MVT = (const u16*)(P.ws + OFF_MVT);
  const int total = 576 + 6144;
  const float LOG2E = 1.4426950408889634f;
  while (true) {
    __syncthreads();
    if (threadIdx.x == 0) s_item = (int)atomicAdd(ctr, 1u);
    __syncthreads();
    const int q = s_item;
    if (q >= total) break;
    int kind, idx;
    if (q < 576) { kind = 1; idx = q; }
    else if (q < 576 + 2048) { kind = 2; idx = q - 576; }
    else { kind = 3; idx = q - 2624; }
    if (kind == 1) {
      int i2 = idx < 64 ? idx : idx - 64;
      int dir = i2 & 1, head = (i2 >> 1) & 7, sl = i2 >> 4;
      scan_item<1>(P, ldsb, idx < 64 ? 32 + sl : sl, head, dir, 0);
    } else if (kind <= 3) {
      int seq, head, qb, T, start;
      if (kind == 2) { seq = 32 + (idx >> 9); head = (idx >> 6) & 7; qb = idx & 63; T = 8192; start = NTP + (seq - 32) * 8192; }
      else { seq = idx >> 7; head = (idx >> 4) & 7; qb = idx & 15; T = 2048; start = seq * 2048; }
      const size_t tok0 = (size_t)start + qb * 128;
      attn_item<96, 64, true, true>(lds, Q + tok0 * 768 + head * 96, 768, Kb + (size_t)start * 768 + head * 96, 768,
                              Vt + vt_base(seq) + (size_t)head * 64 * T, T, T, P.in[10],
                              0.10206207261596577f * LOG2E, qb * 128, Q + tok0 * 768 + head * 96, 768);
    }
  }
#ifdef SCANREP
  __syncthreads();
  for (int idx = blockIdx.x; idx < 576; idx += gridDim.x) {
    int dir = idx & 1, head = (idx >> 1) & 7, sl = idx >> 4;
    __syncthreads();
    scan_item<1>(P, ldsb, sl, head, dir, 0);
  }
#endif
  __syncthreads();
  unsigned* ctr2 = (unsigned*)(P.ws + OFF_CTL) + 16;
  while (true) {
    __syncthreads();
    if (threadIdx.x == 0) s_item = (int)atomicAdd(ctr2, 1u);
    __syncthreads();
    const int idx = s_item;
    if (idx >= 3072) break;
    int mt = idx >> 2, head = idx & 3;
    int seq, start, T;
    tok_seq(mt * 128, seq, start, T);
    const size_t tok0 = (size_t)mt * 128;
    attn_item<128, 128, false, false>(lds, XQ + tok0 * 512 + head * 128, 512, MK + (size_t)(seq * 4 + head) * 256 * 128, 128,
                                      MVT + (size_t)(seq * 4 + head) * 128 * 256, 256, 256, P.in[32],
                                      0.08838834764831845f * LOG2E, 0, XQ + tok0 * 512 + head * 128, 512);
  }
}

__device__ __forceinline__ void phase5(const Params& P, u16* lds) {
  __shared__ float st_mean[256], st_rstd[256];
  unsigned char* ws = P.ws;
  const u16* RW = (const u16*)(ws + OFF_RW);
  const u16* YF = (const u16*)(ws + OFF_YF);
  u16* YB = (u16*)(ws + OFF_YB);
  const u16* G2 = (const u16*)(ws + OFF_G2);
  const float* mup = P.in[13] + 1792;
  const float* mun = P.in[14] + 1792;
  const float* lng = P.in[27];
  const float* lnb = P.in[28];
  const int tid = threadIdx.x;
  for (int it = blockIdx.x; it < 768 * 4; it += gridDim.x) {
    int mt = it >> 2, nt = it & 3;
    int m0 = mt * 128, n0 = nt * 128;
    int seq, start, T;
    tok_seq(m0, seq, start, T);
    {
      int r = tid >> 1, hh = tid & 1;
      const u16* pf = YF + (size_t)(m0 + r) * 512 + n0 + hh * 64;
      const u16* pb = YB + (size_t)(m0 + r) * 512 + n0 + hh * 64;
      float sm = 0.f, sq = 0.f;
      for (int c = 0; c < 8; c++) {
        uint4 a = *(const uint4*)(pf + 8 * c), b = *(const uint4*)(pb + 8 * c);
        float y;
        y = bflo(a.x) + bflo(b.x); sm += y; sq += y * y; y = bfhi(a.x) + bfhi(b.x); sm += y; sq += y * y;
        y = bflo(a.y) + bflo(b.y); sm += y; sq += y * y; y = bfhi(a.y) + bfhi(b.y); sm += y; sq += y * y;
        y = bflo(a.z) + bflo(b.z); sm += y; sq += y * y; y = bfhi(a.z) + bfhi(b.z); sm += y; sq += y * y;
        y = bflo(a.w) + bflo(b.w); sm += y; sq += y * y; y = bfhi(a.w) + bfhi(b.w); sm += y; sq += y * y;
      }
      float mean = sm * (1.f / 64.f);
      float var = fmaxf(sq * (1.f / 64.f) - mean * mean, 0.f);
      st_mean[tid] = mean;
      st_rstd[tid] = rsqrtf(var + 64e-5f);
    }
    {
      const int lr = tid >> 3, lk = (tid & 7) * 8;
#pragma unroll
      for (int kb = 0; kb < 2; kb++) {
#pragma unroll
        for (int i = 0; i < 4; i++) {
          int r = lr + 32 * i;
          int t = m0 + r - start;
          float v[8];
          mix8(RW + (size_t)(m0 + r) * 1920 + 1792 + kb * 64 + lk, t > 0, t < T - 1, mup + kb * 64 + lk, mun + kb * 64 + lk, v);
          uint4 u;
          u.x = pack2(sigmoidf_(v[0]), sigmoidf_(v[1])); u.y = pack2(sigmoidf_(v[2]), sigmoidf_(v[3]));
          u.z = pack2(sigmoidf_(v[4]), sigmoidf_(v[5])); u.w = pack2(sigmoidf_(v[6]), sigmoidf_(v[7]));
          *(uint4*)(lds + kb * (2 * LTILE) + r * LROW + lk) = u;
          *(uint4*)(lds + kb * (2 * LTILE) + LTILE + r * LROW + lk) = *(const uint4*)(G2 + (size_t)(n0 + r) * 128 + kb * 64 + lk);
        }
      }
    }
    __syncthreads();
    Acc acc; acc_zero(acc);
    gemm_compute(acc, lds, 0);
    gemm_compute(acc, lds, 1);
    epi_each(acc, [&](int r0, int c, float v0, float v1, float v2, float v3) {
      int hh = c >> 6;
      float g = lng[n0 + c], b = lnb[n0 + c];
      float vv[4] = {v0, v1, v2, v3};
#pragma unroll
      for (int k = 0; k < 4; k++) {
        size_t o = (size_t)(m0 + r0 + k) * 512 + n0 + c;
        float y = bf2f(YF[o]) + bf2f(YB[o]);
        int si = (r0 + k) * 2 + hh;
        float yn = (y - st_mean[si]) * st_rstd[si] * g + b;
        YB[o] = f2bf(yn * vv[k]);
      }
    });
    __syncthreads();
  }
}

__device__ __forceinline__ void merge_branch(Acc& mg, u16* lds, const u16* Hrow, const u16* Wg_rows, const u16* Abr,
                                             const u16* Wbr, int Kb) {
  unsigned* G = (unsigned*)(lds + 2 * LTILE);
  {
    Acc acc; acc_zero(acc);
    gemm_lin<false, false>(acc, lds, Hrow, 1024, Wg_rows, 1024, 1024);
#pragma unroll
    for (int i = 0; i < 2; i++)
#pragma unroll
      for (int j = 0; j < 2; j++)
#pragma unroll
        for (int r = 0; r < 8; r++)
          G[((i * 2 + j) * 8 + r) * 256 + threadIdx.x] = pack2(sigmoidf_(acc.a[i][j][2 * r]), sigmoidf_(acc.a[i][j][2 * r + 1]));
  }
  Acc acc; acc_zero(acc);
  gemm_lin<true, false>(acc, lds, Abr, Kb, Wbr, Kb, Kb);
#pragma unroll
  for (int i = 0; i < 2; i++)
#pragma unroll
    for (int j = 0; j < 2; j++)
#pragma unroll
      for (int r = 0; r < 8; r++) {
        unsigned g = G[((i * 2 + j) * 8 + r) * 256 + threadIdx.x];
        mg.a[i][j][2 * r] += bflo(g) * acc.a[i][j][2 * r];
        mg.a[i][j][2 * r + 1] += bfhi(g) * acc.a[i][j][2 * r + 1];
      }
  __syncthreads();
}
__device__ __forceinline__ void phase6(const Params& P, u16* lds) {
  unsigned char* ws = P.ws;
  const u16* H = (const u16*)(ws + OFF_H);
  const u16* Wg = (const u16*)(ws + OFF_WIN) + (size_t)3200 * 1024;
  u16* MG = (u16*)(ws + OFF_MERGED);
  const u16* A0 = (const u16*)((unsigned char*)P.out + DO_Q);
  const u16* A1 = (const u16*)(ws + OFF_YB);
  const u16* A2 = (const u16*)(ws + OFF_XQ);
  const u16* W0 = (const u16*)(ws + OFF_WOA);
  const u16* W1 = (const u16*)(ws + OFF_WOB);
  const u16* W2 = (const u16*)(ws + OFF_WOC);
  for (int kk_ = 0;; kk_++) {
    int mt, nt;
    if (!tile_map(kk_, 768, 8, mt, nt)) break;
    int m0 = mt * 128, n0 = nt * 128;
    Acc mg; acc_zero(mg);
    const u16* Hrow = H + (size_t)m0 * 1024;
#pragma nounroll
    for (int br = 0; br < 3; br++) {
      const u16* Ab = br == 0 ? A0 + (size_t)m0 * 768 : (br == 1 ? A1 + (size_t)m0 * 512 : A2 + (size_t)m0 * 512);
      const u16* Wb = br == 0 ? W0 + (size_t)n0 * 768 : (br == 1 ? W1 + (size_t)n0 * 512 : W2 + (size_t)n0 * 512);
      merge_branch(mg, lds, Hrow, Wg + (size_t)(br * 1024 + n0) * 1024, Ab, Wb, br == 0 ? 768 : 512);
    }
    epi_each(mg, [&](int r0, int c, float v0, float v1, float v2, float v3) {
      store_bf16_pairs(MG + (size_t)(m0 + r0) * 1024 + n0 + c, 1024, c, v0, v1, v2, v3);
    });
  }
}

__device__ __forceinline__ void phase7(const Params& P, u16* lds) {
  unsigned char* ws = P.ws;
  const u16* MG = (const u16*)(ws + OFF_MERGED);
  const u16* W = (const u16*)(ws + OFF_WOUT);
  for (int kk_ = 0;; kk_++) {
    int mt, nt;
    if (!tile_map(kk_, 768, 8, mt, nt)) break;
    int m0 = mt * 128, n0 = nt * 128;
    Acc acc; acc_zero(acc);
    gemm_lin(acc, lds, MG + (size_t)m0 * 1024, 1024, W + (size_t)n0 * 1024, 1024, 1024);
    const float* xin = m0 < NTP ? P.in[0] + (size_t)m0 * 1024 : P.in[1] + (size_t)(m0 - NTP) * 1024;
    float* xo = P.out + (size_t)m0 * 1024;
    epi_each(acc, [&](int r0, int c, float v0, float v1, float v2, float v3) {
      size_t o = (size_t)r0 * 1024 + n0 + c;
      xo[o] = xin[o] + v0; xo[o + 1024] = xin[o + 1024] + v1; xo[o + 2048] = xin[o + 2048] + v2; xo[o + 3072] = xin[o + 3072] + v3;
    });
  }
}

__device__ __forceinline__ void phase8(const Params& P) {
  const int wave = threadIdx.x >> 6;
  u16* H = (u16*)(P.ws + OFF_H);
  for (int row = blockIdx.x * 4 + wave; row < NT; row += gridDim.x * 4)
    norm_row(P.out + (size_t)row * 1024, H + (size_t)row * 1024);
}

__device__ __forceinline__ float erf_as(float x) {
  const float ax = fabsf(x);
  const float t = __builtin_amdgcn_rcpf(1.f + 0.3275911f * ax);
  const float y = ((((1.061405429f * t - 1.453152027f) * t + 1.421413741f) * t - 0.284496736f) * t + 0.254829592f) * t;
  const float r = 1.f - y * __builtin_amdgcn_exp2f(-ax * ax * 1.4426950408889634f);
  return copysignf(r, x);
}
__device__ __forceinline__ void phase9(const Params& P, u16* lds) {
  unsigned char* ws = P.ws;
  const u16* H = (const u16*)(ws + OFF_H);
  const u16* W = (const u16*)(ws + OFF_WUP);
  u16* ACT = (u16*)(ws + OFF_ACT);
  const float* cw = P.in[38];
  const float* cb = P.in[39];
  float* Lf = (float*)lds;
  const int tid = threadIdx.x, lane = tid & 63, wave = tid >> 6, wm = wave >> 1, wn = wave & 1;
  for (int kk_ = 0;; kk_++) {
    int mt, nt;
    if (!tile_map(kk_, 808, 44, mt, nt)) break;
    int start, T, ti;
    if (mt < 544) { int s = mt / 17; ti = mt % 17; start = s * 2048; T = 2048; }
    else { int m2 = mt - 544; int s = m2 / 66; ti = m2 % 66; start = NTP + s * 8192; T = 8192; }
    const int p0 = 126 * ti - 1;
    const int lr = tid >> 3;
    const u16* pa[4];
#pragma unroll
    for (int i = 0; i < 4; i++) {
      int p = p0 + lr + 32 * i;
      p = p < 0 ? 0 : (p > T - 1 ? T - 1 : p);
      pa[i] = H + (size_t)(start + p) * 1024;
    }
    const u16* Bt = W + (size_t)nt * 128 * 1024;
    Acc acc; acc_zero(acc);
    gemm_main(acc, lds, pa[0], pa[1], pa[2], pa[3], Bt + (size_t)lr * 1024, Bt + (size_t)(lr + 32) * 1024,
              Bt + (size_t)(lr + 64) * 1024, Bt + (size_t)(lr + 96) * 1024, 1024);
    {
      float* dst = Lf + wn * 8192;
#pragma unroll
      for (int i = 0; i < 2; i++)
#pragma unroll
        for (int j = 0; j < 2; j++)
#pragma unroll
          for (int r = 0; r < 16; r++) {
            int rr = 64 * wm + 32 * i + (r & 3) + 8 * (r >> 2) + 4 * (lane >> 5);
            dst[rr * 64 + 32 * j + (lane & 31)] = acc.a[i][j][r];
          }
    }
    __syncthreads();
    {
      const int c = tid & 63, rgp = tid >> 6;
      const int col = nt * 64 + c;
      const float w0 = cw[col], w1 = cw[2816 + col], w2 = cw[2 * 2816 + col], bb = cb[col];
      int rbeg = rgp * 32; if (rbeg < 1) rbeg = 1;
      int rend = rgp * 32 + 32; if (rend > 127) rend = 127;
      auto gval = [&](int r) { int p = p0 + r; return (p >= 0 && p < T) ? Lf[r * 64 + c] : 0.f; };
      float gp = gval(rbeg - 1), gc = gval(rbeg);
      for (int r = rbeg; r < rend; r++) {
        float gn = gval(r + 1);
        int p = p0 + r;
        if (p < T) {
          float cc = w0 * gp + w1 * gc + w2 * gn + bb;
          float a = 0.5f * cc * (1.f + erf_as(cc * 0.70710678118654752f)) * Lf[8192 + r * 64 + c];
          ACT[(size_t)(start + p) * 2816 + col] = f2bf(a);
        }
        gp = gc; gc = gn;
      }
    }
    __syncthreads();
  }
}

__device__ __forceinline__ void phase10(const Params& P, u16* lds) {
  unsigned char* ws = P.ws;
  const u16* ACT = (const u16*)(ws + OFF_ACT);
  const u16* W = (const u16*)(ws + OFF_WDOWN);
  for (int kk_ = 0;; kk_++) {
    int mt, nt;
    if (!tile_map(kk_, 768, 8, mt, nt)) break;
    int m0 = mt * 128, n0 = nt * 128;
    Acc acc; acc_zero(acc);
    gemm_lin(acc, lds, ACT + (size_t)m0 * 2816, 2816, W + (size_t)n0 * 2816, 2816, 2816);
    float* xo = P.out + (size_t)m0 * 1024;
    epi_each(acc, [&](int r0, int c, float v0, float v1, float v2, float v3) {
      size_t o = (size_t)r0 * 1024 + n0 + c;
      xo[o] += v0; xo[o + 1024] += v1; xo[o + 2048] += v2; xo[o + 3072] += v3;
    });
  }
}

constexpr int NPHASE = 11;
__global__ void __launch_bounds__(NTHREADS, 2) fwd_kernel(Params P) {
  extern __shared__ __attribute__((aligned(16))) unsigned char dlds[];
  cg::grid_group grid = cg::this_grid();
  u16* lds = (u16*)dlds;
#ifndef REPMASK
#define REPMASK 0
#endif
#define PH(k, call)                                   \
  if (P.lo <= (k) && (k) < P.hi) {                    \
    call;                                             \
    if ((REPMASK >> (k)) & 1) { grid.sync(); call; }  \
    if ((k) + 1 < P.hi) grid.sync();                  \
  }
  PH(0, (phase0(P), phase0b(P)))
  PH(1, phase1(P, lds))
  PH(2, phase2(P, lds))
  PH(3, phase3(P))
  PH(4, phase4(P, dlds))
  PH(5, phase5(P, lds))
  PH(6, phase6(P, lds))
  PH(7, phase7(P, lds))
  PH(8, phase8(P))
  PH(9, phase9(P, lds))
  PH(10, phase10(P, lds))
#undef PH
}

extern "C" void kernel_launch(void* const* d_in, const int* in_sizes, int n_in, void* d_out, int out_size, void* d_ws,
                              size_t ws_size, hipStream_t stream) {
  static int grid_blocks = 0;
  if (!grid_blocks) {
    int dev = 0, cus = 0, per_cu = 0;
    hipGetDevice(&dev);
    hipDeviceGetAttribute(&cus, hipDeviceAttributeMultiprocessorCount, dev);
    hipFuncSetAttribute((const void*)fwd_kernel, hipFuncAttributeMaxDynamicSharedMemorySize, LDS_BYTES);
    hipOccupancyMaxActiveBlocksPerMultiprocessor(&per_cu, (const void*)fwd_kernel, NTHREADS, LDS_BYTES);
    if (per_cu < 1) per_cu = 1;
    if (per_cu > 2) per_cu = 2;
    grid_blocks = cus * per_cu;
    if (ws_size < WS_END) fprintf(stderr, "workspace too small: %zu < %zu\n", ws_size, (size_t)WS_END);
  }
  if (ws_size < WS_END) return;
  Params p{};
  for (int i = 0; i < 41; i++) p.in[i] = (const float*)d_in[i];
  p.out = (float*)d_out;
  p.ws = (unsigned char*)d_ws;
#if MEGA
  p.lo = 0; p.hi = NPHASE;
  void* args[] = {&p};
  hipError_t e = hipLaunchCooperativeKernel((const void*)fwd_kernel, dim3(grid_blocks), dim3(NTHREADS), args, LDS_BYTES, stream);
  if (e != hipSuccess) fprintf(stderr, "cooperative launch failed: %s (grid %d)\n", hipGetErrorString(e), grid_blocks);
#else
#ifndef PHMAX
#define PHMAX 11
#endif
  for (int k = 0; k < PHMAX; k++) {
    p.lo = k; p.hi = k + 1;
    hipLaunchKernelGGL(fwd_kernel, dim3(grid_blocks), dim3(NTHREADS), LDS_BYTES, stream, p);
  }
#endif
}
```

```cpp
#include <hip/hip_runtime.h>
#include <hip/hip_cooperative_groups.h>
#include <cstdio>
#include <cstdint>
namespace cg = cooperative_groups;

typedef unsigned short u16;
typedef __attribute__((ext_vector_type(8))) short bf16x8;
typedef __attribute__((ext_vector_type(16))) float f32x16;

#ifndef MEGA
#define MEGA 1
#endif

constexpr int NT = 98304;
constexpr int NTP = 65536;
constexpr int NMEMROWS = 9216;
constexpr int NTHREADS = 256;
constexpr int LDS_BYTES = 73728;

constexpr size_t OFF_CTL = 0;
constexpr size_t OFF_WIN = 4096;
constexpr size_t OFF_WUQ = OFF_WIN + (size_t)6272 * 1024 * 2;
constexpr size_t OFF_WUKV = OFF_WUQ + (size_t)768 * 384 * 2;
constexpr size_t OFF_WOA = OFF_WUKV + (size_t)1024 * 256 * 2;
constexpr size_t OFF_WOB = OFF_WOA + (size_t)1024 * 768 * 2;
constexpr size_t OFF_WOC = OFF_WOB + (size_t)1024 * 512 * 2;
constexpr size_t OFF_WMKV = OFF_WOC + (size_t)1024 * 512 * 2;
constexpr size_t OFF_WOUT = OFF_WMKV + (size_t)2048 * 1024 * 2;
constexpr size_t OFF_WUP = OFF_WOUT + (size_t)1024 * 1024 * 2;
constexpr size_t OFF_WDOWN = OFF_WUP + (size_t)5632 * 1024 * 2;
constexpr size_t OFF_G2 = OFF_WDOWN + (size_t)1024 * 2816 * 2;
constexpr size_t OFF_W2F = OFF_G2 + (size_t)512 * 128 * 2;
constexpr size_t OFF_W2B = OFF_W2F + 65536;
constexpr size_t OFF_A2F = OFF_W2B + 65536;
constexpr size_t OFF_A2B = OFF_A2F + 65536;
constexpr size_t OFF_RS = OFF_A2B + 65536;
constexpr size_t OFF_H = 50331648;
static_assert(OFF_RS + (size_t)NT * 4 <= OFF_H, "rs");
constexpr size_t OFF_CQKV = OFF_H + (size_t)NT * 1024 * 2;
constexpr size_t OFF_RW = OFF_CQKV + (size_t)NT * 672 * 2;
constexpr size_t OFF_XQ = OFF_RW + (size_t)NT * 1920 * 2;
constexpr size_t OFF_MH = OFF_XQ + (size_t)NT * 512 * 2;
constexpr size_t OFF_MKV = OFF_MH + (size_t)NMEMROWS * 1024 * 2;
constexpr size_t OFF_MK = OFF_MKV + (size_t)NMEMROWS * 2048 * 2;
constexpr size_t OFF_MVT = OFF_MK + (size_t)NMEMROWS * 512 * 2;
constexpr size_t OFF_YB = OFF_MVT + (size_t)NMEMROWS * 512 * 2;
constexpr size_t WS_END = OFF_YB + (size_t)NT * 512 * 2;
static_assert(WS_END <= (size_t)1073741824, "workspace overflow");
constexpr size_t OFF_YF = OFF_CQKV;
constexpr size_t OFF_MERGED = OFF_RW;
constexpr size_t OFF_ACT = OFF_CQKV;
static_assert((size_t)NT * 2816 * 2 <= OFF_MH - OFF_CQKV, "act overflow");
constexpr size_t DO_Q = 0;
constexpr size_t DO_K = (size_t)NT * 768 * 2;
constexpr size_t DO_VT = DO_K + (size_t)NT * 768 * 2;

struct Params {
  const float* in[41];
  float* out;
  unsigned char* ws;
  int lo, hi;
};

typedef __bf16 bf16x2_t __attribute__((ext_vector_type(2)));
typedef float f32x2_t __attribute__((ext_vector_type(2)));
__device__ __forceinline__ unsigned pack2(float a, float b) {
  f32x2_t f = {a, b};
  bf16x2_t h = __builtin_convertvector(f, bf16x2_t);
  return __builtin_bit_cast(unsigned, h);
}
__device__ __forceinline__ u16 f2bf(float f) { return (u16)(pack2(f, f) & 0xffffu); }
__device__ __forceinline__ float bf2f(u16 b) { return __uint_as_float(((unsigned)b) << 16); }
__device__ __forceinline__ float bflo(unsigned u) { return __uint_as_float(u << 16); }
__device__ __forceinline__ float bfhi(unsigned u) { return __uint_as_float(u & 0xffff0000u); }

template <int CTRL>
__device__ __forceinline__ float dppf(float v) {
  return __int_as_float(__builtin_amdgcn_mov_dpp(__float_as_int(v), CTRL, 0xF, 0xF, true));
}
__device__ __forceinline__ float sum16(float v) {
  v += dppf<0xB1>(v);
  v += dppf<0x4E>(v);
  v += dppf<0x141>(v);
  v += dppf<0x140>(v);
  return v;
}
__device__ __forceinline__ float sum8(float v) {
  v += dppf<0xB1>(v);
  v += dppf<0x4E>(v);
  v += dppf<0x141>(v);
  return v;
}
__device__ __forceinline__ float wave_sum(float v) {
  v = sum16(v);
  v += __shfl_xor(v, 16);
  v += __shfl_xor(v, 32);
  return v;
}
__device__ __forceinline__ float sigmoidf_(float x) { return 1.f / (1.f + __expf(-x)); }

__device__ __forceinline__ void tok_seq(int g, int& seq, int& start, int& T) {
  if (g < NTP) { seq = g >> 11; start = seq << 11; T = 2048; }
  else { int s = (g - NTP) >> 13; seq = 32 + s; start = NTP + (s << 13); T = 8192; }
}
__device__ __forceinline__ size_t vt_base(int seq) {
  return seq < 32 ? (size_t)seq * (512 * 2048) : (size_t)32 * 512 * 2048 + (size_t)(seq - 32) * (512 * 8192);
}

struct Acc { f32x16 a[2][2]; };
constexpr int LROW = 72;
constexpr int LTILE = 128 * LROW;

__device__ __forceinline__ void acc_zero(Acc& acc) {
#pragma unroll
  for (int i = 0; i < 2; i++)
#pragma unroll
    for (int j = 0; j < 2; j++)
#pragma unroll
      for (int r = 0; r < 16; r++) acc.a[i][j][r] = 0.f;
}

__device__ __forceinline__ void gemm_compute(Acc& acc, const u16* lds, int b) {
  const int lane = threadIdx.x & 63, wave = threadIdx.x >> 6, wm = wave >> 1, wn = wave & 1;
  const u16* A = lds + b * (2 * LTILE) + (64 * wm + (lane & 31)) * LROW + 8 * (lane >> 5);
  const u16* B = lds + b * (2 * LTILE) + LTILE + (64 * wn + (lane & 31)) * LROW + 8 * (lane >> 5);
#pragma unroll
  for (int s = 0; s < 4; s++) {
    bf16x8 a0 = *(const bf16x8*)(A + 16 * s);
    bf16x8 a1 = *(const bf16x8*)(A + 32 * LROW + 16 * s);
    bf16x8 b0 = *(const bf16x8*)(B + 16 * s);
    bf16x8 b1 = *(const bf16x8*)(B + 32 * LROW + 16 * s);
    acc.a[0][0] = __builtin_amdgcn_mfma_f32_32x32x16_bf16(a0, b0, acc.a[0][0], 0, 0, 0);
    acc.a[0][1] = __builtin_amdgcn_mfma_f32_32x32x16_bf16(a0, b1, acc.a[0][1], 0, 0, 0);
    acc.a[1][0] = __builtin_amdgcn_mfma_f32_32x32x16_bf16(a1, b0, acc.a[1][0], 0, 0, 0);
    acc.a[1][1] = __builtin_amdgcn_mfma_f32_32x32x16_bf16(a1, b1, acc.a[1][1], 0, 0, 0);
  }
}

template <bool SINGLE = false, bool DEEP = true>
__device__ __forceinline__ void gemm_main(Acc& acc, u16* lds, const u16* pa0, const u16* pa1, const u16* pa2,
                                          const u16* pa3, const u16* pb0, const u16* pb1, const u16* pb2,
                                          const u16* pb3, int K) {
  const int tid = threadIdx.x;
  const int lr = tid >> 3, lk = (tid & 7) * 8;
  uint4 xa0, xa1, xa2, xa3, xb0, xb1, xb2, xb3;
  uint4 ya0, ya1, ya2, ya3, yb0, yb1, yb2, yb3;
  const int nk = K >> 6;
#define GLOAD(S, k0)                                                                         \
  S##a0 = *(const uint4*)(pa0 + (k0) + lk); S##a1 = *(const uint4*)(pa1 + (k0) + lk);         \
  S##a2 = *(const uint4*)(pa2 + (k0) + lk); S##a3 = *(const uint4*)(pa3 + (k0) + lk);         \
  S##b0 = *(const uint4*)(pb0 + (k0) + lk); S##b1 = *(const uint4*)(pb1 + (k0) + lk);         \
  S##b2 = *(const uint4*)(pb2 + (k0) + lk); S##b3 = *(const uint4*)(pb3 + (k0) + lk);
#define SSTORE(S, b)                                                                         \
  {                                                                                          \
    u16* A_ = lds + (b) * (2 * LTILE) + lr * LROW + lk;                                      \
    u16* B_ = A_ + LTILE;                                                                    \
    *(uint4*)(A_) = S##a0; *(uint4*)(A_ + 32 * LROW) = S##a1;                                \
    *(uint4*)(A_ + 64 * LROW) = S##a2; *(uint4*)(A_ + 96 * LROW) = S##a3;                    \
    *(uint4*)(B_) = S##b0; *(uint4*)(B_ + 32 * LROW) = S##b1;                                \
    *(uint4*)(B_ + 64 * LROW) = S##b2; *(uint4*)(B_ + 96 * LROW) = S##b3;                    \
  }
  if (!DEEP) {
    GLOAD(x, 0)
    SSTORE(x, 0)
    __syncthreads();
    for (int kt = 0; kt < nk; kt++) {
      if (kt + 1 < nk) { GLOAD(x, (kt + 1) * 64) }
      gemm_compute(acc, lds, SINGLE ? 0 : (kt & 1));
      if (SINGLE) __syncthreads();
      if (kt + 1 < nk) { SSTORE(x, SINGLE ? 0 : ((kt + 1) & 1)) }
      __syncthreads();
    }
    return;
  }
  GLOAD(x, 0)
  GLOAD(y, 64)
  SSTORE(x, 0)
  __syncthreads();
  for (int kt = 0; kt < nk; kt += 2) {
    if (kt + 2 < nk) { GLOAD(x, (kt + 2) * 64) }
    __builtin_amdgcn_sched_barrier(0);
    gemm_compute(acc, lds, 0);
    if (SINGLE) __syncthreads();
    SSTORE(y, SINGLE ? 0 : 1)
    __syncthreads();
    if (kt + 3 < nk) { GLOAD(y, (kt + 3) * 64) }
    __builtin_amdgcn_sched_barrier(0);
    gemm_compute(acc, lds, SINGLE ? 0 : 1);
    if (SINGLE) __syncthreads();
    if (kt + 2 < nk) { SSTORE(x, 0) }
    __syncthreads();
  }
#undef GLOAD
#undef SSTORE
}

template <bool SINGLE = false, bool DEEP = true>
__device__ __forceinline__ void gemm_lin(Acc& acc, u16* lds, const u16* A, long lda, const u16* B, long ldb, int K) {
  const int lr = threadIdx.x >> 3;
  gemm_main<SINGLE, DEEP>(acc, lds, A + (long)lr * lda, A + (long)(lr + 32) * lda, A + (long)(lr + 64) * lda,
            A + (long)(lr + 96) * lda, B + (long)lr * ldb, B + (long)(lr + 32) * ldb, B + (long)(lr + 64) * ldb,
            B + (long)(lr + 96) * ldb, K);
}

template <class F>
__device__ __forceinline__ void epi_each(const Acc& acc, F f) {
  const int lane = threadIdx.x & 63, wave = threadIdx.x >> 6, wm = wave >> 1, wn = wave & 1;
#pragma unroll
  for (int i = 0; i < 2; i++)
#pragma unroll
    for (int j = 0; j < 2; j++)
#pragma unroll
      for (int g = 0; g < 4; g++) {
        int r0 = 64 * wm + 32 * i + 8 * g + 4 * (lane >> 5);
        int c = 64 * wn + 32 * j + (lane & 31);
        f(r0, c, acc.a[i][j][4 * g + 0], acc.a[i][j][4 * g + 1], acc.a[i][j][4 * g + 2], acc.a[i][j][4 * g + 3]);
      }
}

__device__ __forceinline__ void store_bf16_pairs(u16* colbase, long ld, int c, float v0, float v1, float v2, float v3) {
  const bool odd = c & 1;
  const float sA = odd ? v0 : v2, sB = odd ? v1 : v3;
  const float rA = dppf<0xB1>(sA), rB = dppf<0xB1>(sB);
  if (!odd) {
    *(unsigned*)(colbase) = pack2(v0, rA);
    *(unsigned*)(colbase + ld) = pack2(v1, rB);
  } else {
    *(unsigned*)(colbase + 2 * ld - 1) = pack2(rA, v2);
    *(unsigned*)(colbase + 3 * ld - 1) = pack2(rB, v3);
  }
}

__device__ __forceinline__ bool tile_map(int k, int MT, int NTL, int& mt, int& nt) {
  const int G = gridDim.x;
  if (G & 7) {
    int it = blockIdx.x + k * G;
    if (it >= MT * NTL) return false;
    mt = it / NTL; nt = it % NTL;
    return true;
  }
  const int xcd = blockIdx.x & 7, lb = blockIdx.x >> 3, nbx = G >> 3;
  const int mtx0 = (MT * xcd) >> 3, mtx1 = (MT * (xcd + 1)) >> 3, MTX = mtx1 - mtx0;
  const int idx = lb + k * nbx;
  if (idx >= MTX * NTL) return false;
  const int mg0 = idx / (8 * NTL);
  const int base = mg0 * 8;
  const int gsz = (MTX - base) < 8 ? (MTX - base) : 8;
  const int rem = idx - mg0 * 8 * NTL;
  nt = rem / gsz;
  mt = mtx0 + base + rem % gsz;
  return true;
}

template <class NMap, class KMap>
__device__ __forceinline__ void cvtw(const float* __restrict__ W, int srcN, u16* __restrict__ Wt, int dN, int dK,
                     const float* __restrict__ gain, NMap nmap, KMap kmap, long gtid, long gsz) {
  const int kch = dK >> 3;
  const long total = (long)dN * kch;
  for (long i = gtid; i < total; i += gsz) {
    int n = (int)(i % dN), kc = (int)(i / dN);
    int sn = nmap(n);
    float v[8];
#pragma unroll
    for (int j = 0; j < 8; j++) {
      int sk = kmap(kc * 8 + j);
      float x = 0.f;
      if (sn >= 0 && sk >= 0) {
        x = W[(long)sk * srcN + sn];
        if (gain) x *= gain[sk];
      }
      v[j] = x;
    }
    uint4 o;
    o.x = pack2(v[0], v[1]); o.y = pack2(v[2], v[3]); o.z = pack2(v[4], v[5]); o.w = pack2(v[6], v[7]);
    *(uint4*)(Wt + (long)n * dK + kc * 8) = o;
  }
}

__device__ __forceinline__ void phase0(const Params& P) {
  const long gtid = (long)blockIdx.x * NTHREADS + threadIdx.x, gsz = (long)gridDim.x * NTHREADS;
  unsigned char* ws = P.ws;
  if (gtid == 0) { ((unsigned*)(ws + OFF_CTL))[0] = 0u; ((unsigned*)(ws + OFF_CTL))[16] = 0u; }
  { float* rsz = (float*)(ws + OFF_RS); for (long e = gtid; e < NT; e += gsz) rsz[e] = 0.f; }
  auto idn = [](int n) { return n; };
  cvtw(P.in[5], 6176, (u16*)(ws + OFF_WIN), 6272, 1024, P.in[4],
       [](int n) {
         if (n < 640) return n;
         if (n < 2560) return 672 + (n - 640);
         if (n < 3072) return 2592 + (n - 2560);
         if (n < 3104) return 640 + (n - 3072);
         if (n < 3200) return -1;
         return 3104 + (n - 3200);
       },
       idn, gtid, gsz);
  cvtw(P.in[7], 768, (u16*)(ws + OFF_WUQ), 768, 384, P.in[6], idn, idn, gtid, gsz);
  cvtw(P.in[9], 1024, (u16*)(ws + OFF_WUKV), 1024, 256, P.in[8], idn, idn, gtid, gsz);
  cvtw(P.in[12], 1024, (u16*)(ws + OFF_WOA), 1024, 768, nullptr, idn,
       [](int k) { int h = k / 96, d = k % 96; return d < 64 ? h * 64 + d : -1; }, gtid, gsz);
  cvtw(P.in[29], 1024, (u16*)(ws + OFF_WOB), 1024, 512, nullptr, idn, idn, gtid, gsz);
  cvtw(P.in[34], 1024, (u16*)(ws + OFF_WOC), 1024, 512, nullptr, idn, idn, gtid, gsz);
  cvtw(P.in[31], 1024, (u16*)(ws + OFF_WMKV), 1024, 1024, P.in[30], idn, idn, gtid, gsz);
  cvtw(P.in[35], 1024, (u16*)(ws + OFF_WOUT), 1024, 1024, nullptr, idn, idn, gtid, gsz);
  cvtw(P.in[37], 5632, (u16*)(ws + OFF_WUP), 5632, 1024, P.in[36],
       [](int n) { int t = n >> 7, w = n & 127; return w < 64 ? t * 64 + w : 2816 + t * 64 + (w - 64); }, idn, gtid, gsz);
  cvtw(P.in[40], 1024, (u16*)(ws + OFF_WDOWN), 1024, 2816, nullptr, idn, idn, gtid, gsz);
  cvtw(P.in[23], 512, (u16*)(ws + OFF_G2), 512, 128, nullptr, idn, idn, gtid, gsz);
  cvtw(P.in[16], 512, (u16*)(ws + OFF_W2F), 512, 64, nullptr, idn, idn, gtid, gsz);
  cvtw(P.in[20], 512, (u16*)(ws + OFF_W2B), 512, 64, nullptr, idn, idn, gtid, gsz);
  cvtw(P.in[18], 512, (u16*)(ws + OFF_A2F), 512, 64, nullptr, idn, idn, gtid, gsz);
  cvtw(P.in[22], 512, (u16*)(ws + OFF_A2B), 512, 64, nullptr, idn, idn, gtid, gsz);
}

__device__ __forceinline__ void norm_row(const float* __restrict__ src, u16* __restrict__ dst) {
  const int lane = threadIdx.x & 63;
  float4 v0 = *(const float4*)(src + lane * 4);
  float4 v1 = *(const float4*)(src + 256 + lane * 4);
  float4 v2 = *(const float4*)(src + 512 + lane * 4);
  float4 v3 = *(const float4*)(src + 768 + lane * 4);
  float ss = v0.x * v0.x + v0.y * v0.y + v0.z * v0.z + v0.w * v0.w + v1.x * v1.x + v1.y * v1.y + v1.z * v1.z +
             v1.w * v1.w + v2.x * v2.x + v2.y * v2.y + v2.z * v2.z + v2.w * v2.w + v3.x * v3.x + v3.y * v3.y +
             v3.z * v3.z + v3.w * v3.w;
  ss = wave_sum(ss);
  float r = rsqrtf(ss * (1.f / 1024.f) + 1e-6f);
  uint2 o;
  o.x = pack2(v0.x * r, v0.y * r); o.y = pack2(v0.z * r, v0.w * r); *(uint2*)(dst + lane * 4) = o;
  o.x = pack2(v1.x * r, v1.y * r); o.y = pack2(v1.z * r, v1.w * r); *(uint2*)(dst + 256 + lane * 4) = o;
  o.x = pack2(v2.x * r, v2.y * r); o.y = pack2(v2.z * r, v2.w * r); *(uint2*)(dst + 512 + lane * 4) = o;
  o.x = pack2(v3.x * r, v3.y * r); o.y = pack2(v3.z * r, v3.w * r); *(uint2*)(dst + 768 + lane * 4) = o;
}

__device__ __forceinline__ void phase0b(const Params& P) {
  const int wave = threadIdx.x >> 6;
  u16* H = (u16*)(P.ws + OFF_H);
  u16* MH = (u16*)(P.ws + OFF_MH);
  for (int row = blockIdx.x * 4 + wave; row < NT + NMEMROWS; row += gridDim.x * 4) {
    if (row < NT) {
      const float* src = row < NTP ? P.in[0] + (size_t)row * 1024 : P.in[1] + (size_t)(row - NTP) * 1024;
      norm_row(src, H + (size_t)row * 1024);
    } else {
      int mr = row - NT;
      const float* src = mr < 8192 ? P.in[2] + (size_t)mr * 1024 : P.in[3] + (size_t)(mr - 8192) * 1024;
      norm_row(src, MH + (size_t)mr * 1024);
    }
  }
}

__device__ __forceinline__ void phase1(const Params& P, u16* lds) {
  unsigned char* ws = P.ws;
  const u16* H = (const u16*)(ws + OFF_H);
  const u16* Win = (const u16*)(ws + OFF_WIN);
  u16* CQKV = (u16*)(ws + OFF_CQKV);
  u16* RW = (u16*)(ws + OFF_RW);
  u16* XQ = (u16*)(ws + OFF_XQ);
  for (int kk_ = 0;; kk_++) {
    int mt, nt;
    if (!tile_map(kk_, 768, 25, mt, nt)) break;
    Acc acc; acc_zero(acc);
    {
      int m0 = mt * 128, n0 = nt * 128;
      gemm_lin(acc, lds, H + (size_t)m0 * 1024, 1024, Win + (size_t)n0 * 1024, 1024, 1024);
      epi_each(acc, [&](int r0, int c, float v0, float v1, float v2, float v3) {
        int n = n0 + c;
        u16* dst; int ld;
        if (n < 640) { dst = CQKV + n; ld = 672; }
        else if (n < 2560) { dst = RW + (n - 640); ld = 1920; }
        else if (n < 3072) { dst = XQ + (n - 2560); ld = 512; }
        else if (n < 3104) { dst = CQKV + 640 + (n - 3072); ld = 672; }
        else return;
        store_bf16_pairs(dst + (size_t)(m0 + r0) * ld, ld, c, v0, v1, v2, v3);
      });
    }
  }
  for (int i2 = blockIdx.x; i2 < 72 * 8; i2 += gridDim.x) {
    Acc acc; acc_zero(acc);
    {
      int mt = i2 / 8, nt = i2 % 8;
      int m0 = mt * 128, n0 = nt * 128;
      gemm_lin(acc, lds, (const u16*)(ws + OFF_MH) + (size_t)m0 * 1024, 1024, (const u16*)(ws + OFF_WMKV) + (size_t)n0 * 1024, 1024, 1024);
      u16* MKV = (u16*)(ws + OFF_MKV);
      epi_each(acc, [&](int r0, int c, float v0, float v1, float v2, float v3) {
        u16* dst = MKV + (size_t)(m0 + r0) * 1024 + n0 + c;
        dst[0] = f2bf(v0); dst[1024] = f2bf(v1); dst[2048] = f2bf(v2); dst[3072] = f2bf(v3);
      });
    }
  }
}

__device__ __forceinline__ void phase2(const Params& P, u16* lds) {
  unsigned char* ws = P.ws;
  const u16* CQKV = (const u16*)(ws + OFF_CQKV);
  u16* Q = (u16*)((unsigned char*)P.out + DO_Q);
  u16* Kb = (u16*)((unsigned char*)P.out + DO_K);
  u16* Vt = (u16*)((unsigned char*)P.out + DO_VT);
  __shared__ float rstd_s[128];
  const int tid = threadIdx.x;
  for (int it = blockIdx.x; it < 768 * 14; it += gridDim.x) {
    int mt = it / 14, nt = it % 14;
    int m0 = mt * 128;
    const bool isq = nt < 6;
    {
      int r = tid >> 1, hf = tid & 1;
      const u16* src = CQKV + (size_t)(m0 + r) * 672 + (isq ? hf * 192 : 384 + hf * 128);
      int nch = isq ? 24 : 16;
      float ss = 0.f;
      for (int c = 0; c < nch; c++) {
        uint4 u = *(const uint4*)(src + c * 8);
        float a;
        a = bflo(u.x); ss += a * a; a = bfhi(u.x); ss += a * a;
        a = bflo(u.y); ss += a * a; a = bfhi(u.y); ss += a * a;
        a = bflo(u.z); ss += a * a; a = bfhi(u.z); ss += a * a;
        a = bflo(u.w); ss += a * a; a = bfhi(u.w); ss += a * a;
      }
      ss += dppf<0xB1>(ss);
      if (hf == 0) rstd_s[r] = rsqrtf(ss / (isq ? 384.f : 256.f) + 1e-6f);
    }
    __syncthreads();
    Acc acc; acc_zero(acc);
    if (isq) {
      int n0 = nt * 128;
      gemm_lin(acc, lds, CQKV + (size_t)m0 * 672, 672, (const u16*)(ws + OFF_WUQ) + (size_t)n0 * 384, 384, 384);
      epi_each(acc, [&](int r0, int c, float v0, float v1, float v2, float v3) {
        store_bf16_pairs(Q + (size_t)(m0 + r0) * 768 + n0 + c, 768, c, v0 * rstd_s[r0], v1 * rstd_s[r0 + 1],
                         v2 * rstd_s[r0 + 2], v3 * rstd_s[r0 + 3]);
      });
    } else {
      int head = nt - 6;
      int n0 = head * 128;
      gemm_lin(acc, lds, CQKV + (size_t)m0 * 672 + 384, 672, (const u16*)(ws + OFF_WUKV) + (size_t)n0 * 256, 256, 256);
      int seq, start, T;
      tok_seq(m0, seq, start, T);
      u16* vtb = Vt + vt_base(seq) + (size_t)head * 64 * T + (m0 - start);
      epi_each(acc, [&](int r0, int c, float v0, float v1, float v2, float v3) {
        v0 *= rstd_s[r0]; v1 *= rstd_s[r0 + 1]; v2 *= rstd_s[r0 + 2]; v3 *= rstd_s[r0 + 3];
        if (c < 64) {
          u16* dst = Kb + (size_t)(m0 + r0) * 768 + head * 96 + c;
          dst[0] = f2bf(v0); dst[768] = f2bf(v1); dst[1536] = f2bf(v2); dst[2304] = f2bf(v3);
        } else {
          uint2 o; o.x = pack2(v0, v1); o.y = pack2(v2, v3);
          *(uint2*)(vtb + (size_t)(c - 64) * T + r0) = o;
        }
      });
    }
    __syncthreads();
  }
}

__device__ __forceinline__ void phase3(const Params& P) {
  unsigned char* ws = P.ws;
  const u16* CQKV = (const u16*)(ws + OFF_CQKV);
  u16* Kb = (u16*)((unsigned char*)P.out + DO_K);
  const float* gk = P.in[11];
  const int tid = threadIdx.x;
  const int sub = tid >> 4, i = tid & 15;
  const float inv = powf(10000.f, -(float)i / 16.f);
  const float g0 = gk[4 * i], g1 = gk[4 * i + 1], g2 = gk[4 * i + 2], g3 = gk[4 * i + 3], gr1 = gk[64 + i], gr2 = gk[80 + i];
  for (long pr = (long)blockIdx.x * 16 + sub; pr < (long)NT * 8; pr += (long)gridDim.x * 16) {
    int tok = (int)(pr >> 3), head = (int)(pr & 7);
    u16* kp = Kb + (size_t)tok * 768 + head * 96;
    uint2 u = *(const uint2*)(kp + 4 * i);
    float a0 = bflo(u.x), a1 = bfhi(u.x), a2 = bflo(u.y), a3 = bfhi(u.y);
    float x1 = bf2f(CQKV[(size_t)tok * 672 + 640 + i]);
    float x2 = bf2f(CQKV[(size_t)tok * 672 + 656 + i]);
    float ss = a0 * a0 + a1 * a1 + a2 * a2 + a3 * a3 + x1 * x1 + x2 * x2;
    ss = sum16(ss);
    float r = rsqrtf(ss * (1.f / 96.f) + 1e-6f);
    int seq, start, T;
    tok_seq(tok, seq, start, T);
    float ang = (float)(tok - start) * inv;
    float sn, cs;
    sincosf(ang, &sn, &cs);
    x1 *= r * gr1; x2 *= r * gr2;
    uint2 o; o.x = pack2(a0 * r * g0, a1 * r * g1); o.y = pack2(a2 * r * g2, a3 * r * g3);
    *(uint2*)(kp + 4 * i) = o;
    kp[64 + i] = f2bf(x1 * cs - x2 * sn);
    kp[80 + i] = f2bf(x2 * cs + x1 * sn);
  }
  const u16* MKV = (const u16*)(ws + OFF_MKV);
  u16* MK = (u16*)(ws + OFF_MK);
  u16* MVT = (u16*)(ws + OFF_MVT);
  const float* gxk = P.in[33];
  for (int pr = blockIdx.x * 16 + sub; pr < NMEMROWS * 4; pr += gridDim.x * 16) {
    int row = pr >> 2, head = pr & 3;
    int b = row >> 8, key = row & 255;
    uint4 u = *(const uint4*)(MKV + (size_t)row * 1024 + head * 256 + 8 * i);
    float a0 = bflo(u.x), a1 = bfhi(u.x), a2 = bflo(u.y), a3 = bfhi(u.y), a4 = bflo(u.z), a5 = bfhi(u.z), a6 = bflo(u.w), a7 = bfhi(u.w);
    float ss = a0 * a0 + a1 * a1 + a2 * a2 + a3 * a3 + a4 * a4 + a5 * a5 + a6 * a6 + a7 * a7;
    ss = sum16(ss);
    float r = rsqrtf(ss * (1.f / 128.f) + 1e-6f);
    const float* g = gxk + 8 * i;
    uint4 o;
    o.x = pack2(a0 * r * g[0], a1 * r * g[1]); o.y = pack2(a2 * r * g[2], a3 * r * g[3]);
    o.z = pack2(a4 * r * g[4], a5 * r * g[5]); o.w = pack2(a6 * r * g[6], a7 * r * g[7]);
    *(uint4*)(MK + ((size_t)(b * 4 + head) * 256 + key) * 128 + 8 * i) = o;
  }
  for (long e = (long)blockIdx.x * NTHREADS + tid; e < (long)NMEMROWS * 512; e += (long)gridDim.x * NTHREADS) {
    int row = (int)(e >> 9), c = (int)(e & 511);
    int head = c >> 7, dv = c & 127;
    int b = row >> 8, key = row & 255;
    MVT[((size_t)(b * 4 + head) * 128 + dv) * 256 + key] = MKV[(size_t)row * 1024 + head * 256 + 128 + dv];
  }
}

template <int DQK, int DV, bool ROPE, bool PREF>
__device__ __forceinline__ void attn_item(u16* lds, const u16* Qp, long qld, const u16* Kp, long kld, const u16* Vtp, long vld,
                          int nkeys, const float* __restrict__ gq, float qscale, int tpos0, u16* Op, long old) {
  constexpr int KP = DQK + 8;
  constexpr int KT = 64 * KP;
  constexpr int VT = DV * 72;
  constexpr int BUF = KT + VT;
  constexpr int NS = DQK / 16;
  constexpr int ND = DV / 32;
  constexpr int KCH = DQK / 8;
  constexpr int NKC = 64 * KCH / 256;
  constexpr int NVC = DV * 8 / 256;
  const int tid = threadIdx.x, lane = tid & 63, wave = tid >> 6, h = lane >> 5, lr = lane & 31;

  bf16x8 qf[NS];
  {
    const u16* qp = Qp + (long)(32 * wave + lr) * qld + 8 * h;
    float qv[NS][8];
    float ss = 0.f;
#pragma unroll
    for (int s = 0; s < NS; s++) {
      uint4 u = *(const uint4*)(qp + 16 * s);
      qv[s][0] = bflo(u.x); qv[s][1] = bfhi(u.x); qv[s][2] = bflo(u.y); qv[s][3] = bfhi(u.y);
      qv[s][4] = bflo(u.z); qv[s][5] = bfhi(u.z); qv[s][6] = bflo(u.w); qv[s][7] = bfhi(u.w);
#pragma unroll
      for (int j = 0; j < 8; j++) ss += qv[s][j] * qv[s][j];
    }
    ss += __shfl_xor(ss, 32);
    float r = rsqrtf(ss * (1.f / DQK) + 1e-6f);
#pragma unroll
    for (int s = 0; s < NS; s++)
#pragma unroll
      for (int j = 0; j < 8; j++) qv[s][j] *= r * gq[16 * s + 8 * h + j];
    if (ROPE) {
      float t = (float)(tpos0 + 32 * wave + lr);
#pragma unroll
      for (int j = 0; j < 8; j++) {
        float inv = powf(10000.f, -(float)(8 * h + j) / 16.f);
        float sn, cs;
        sincosf(t * inv, &sn, &cs);
        float x1 = qv[NS - 2][j], x2 = qv[NS - 1][j];
        qv[NS - 2][j] = x1 * cs - x2 * sn;
        qv[NS - 1][j] = x2 * cs + x1 * sn;
      }
    }
#pragma unroll
    for (int s = 0; s < NS; s++) {
      uint4 u;
      u.x = pack2(qv[s][0] * qscale, qv[s][1] * qscale); u.y = pack2(qv[s][2] * qscale, qv[s][3] * qscale);
      u.z = pack2(qv[s][4] * qscale, qv[s][5] * qscale); u.w = pack2(qv[s][6] * qscale, qv[s][7] * qscale);
      qf[s] = *(bf16x8*)&u;
    }
  }

  f32x16 o[ND];
#pragma unroll
  for (int d = 0; d < ND; d++)
#pragma unroll
    for (int r = 0; r < 16; r++) o[d][r] = 0.f;
  float lsum = 0.f;

  uint4 rk[NKC], rv[NVC];
  const int nkt = nkeys >> 6;
#define AGLOAD(kt)                                                                           \
  {                                                                                          \
    _Pragma("unroll") for (int i = 0; i < NKC; i++) {                                        \
      int c = tid + 256 * i; int row = c / KCH, kc = c % KCH;                                \
      rk[i] = *(const uint4*)(Kp + (long)((kt) * 64 + row) * kld + kc * 8);                  \
    }                                                                                        \
    _Pragma("unroll") for (int i = 0; i < NVC; i++) {                                        \
      int c = tid + 256 * i; int row = c >> 3, kc = c & 7;                                   \
      rv[i] = *(const uint4*)(Vtp + (long)row * vld + (kt) * 64 + kc * 8);                   \
    }                                                                                        \
  }
#define ASTORE(b)                                                                            \
  {                                                                                          \
    u16* Kl = lds + (b) * BUF; u16* Vl = Kl + KT;                                            \
    _Pragma("unroll") for (int i = 0; i < NKC; i++) {                                        \
      int c = tid + 256 * i; int row = c / KCH, kc = c % KCH;                                \
      *(uint4*)(Kl + row * KP + kc * 8) = rk[i];                                             \
    }                                                                                        \
    _Pragma("unroll") for (int i = 0; i < NVC; i++) {                                        \
      int c = tid + 256 * i; int row = c >> 3, kc = c & 7;                                   \
      *(uint4*)(Vl + row * 72 + kc * 8) = rv[i];                                             \
    }                                                                                        \
  }
  AGLOAD(0)
  ASTORE(0)
  __syncthreads();
  for (int kt = 0; kt < nkt; kt++) {
    if (PREF) { if (kt + 1 < nkt) AGLOAD(kt + 1) }
    else { if (kt + 1 < nkt) { AGLOAD(kt + 1) ASTORE((kt + 1) & 1) } }
    const u16* Kl = lds + (kt & 1) * BUF;
    const u16* Vl = Kl + KT;
#pragma unroll
    for (int ks = 0; ks < 2; ks++) {
      f32x16 st;
#pragma unroll
      for (int r = 0; r < 16; r++) st[r] = 0.f;
      const u16* kr = Kl + (32 * ks + lr) * KP + 8 * h;
#pragma unroll
      for (int s = 0; s < NS; s++) {
        bf16x8 kf = *(const bf16x8*)(kr + 16 * s);
        st = __builtin_amdgcn_mfma_f32_32x32x16_bf16(kf, qf[s], st, 0, 0, 0);
      }
      float p[16];
#pragma unroll
      for (int r = 0; r < 16; r++) { p[r] = __builtin_amdgcn_exp2f(st[r]); lsum += p[r]; }
#pragma unroll
      for (int s2 = 0; s2 < 2; s2++) {
        uint4 u;
        u.x = pack2(p[8 * s2 + 0], p[8 * s2 + 1]); u.y = pack2(p[8 * s2 + 2], p[8 * s2 + 3]);
        u.z = pack2(p[8 * s2 + 4], p[8 * s2 + 5]); u.w = pack2(p[8 * s2 + 6], p[8 * s2 + 7]);
        bf16x8 pb = *(bf16x8*)&u;
#pragma unroll
        for (int d = 0; d < ND; d++) {
          const u16* vr = Vl + (32 * d + lr) * 72 + 32 * ks + 16 * s2 + 4 * h;
          uint2 v0 = *(const uint2*)(vr);
          uint2 v1 = *(const uint2*)(vr + 8);
          uint4 vv; vv.x = v0.x; vv.y = v0.y; vv.z = v1.x; vv.w = v1.y;
          bf16x8 vf = *(bf16x8*)&vv;
          o[d] = __builtin_amdgcn_mfma_f32_32x32x16_bf16(vf, pb, o[d], 0, 0, 0);
        }
      }
    }
    if (PREF) { if (kt + 1 < nkt) ASTORE((kt + 1) & 1) }
    __syncthreads();
  }
#undef AGLOAD
#undef ASTORE
  lsum += __shfl_xor(lsum, 32);
  float il = 1.f / lsum;
  u16* op = Op + (long)(32 * wave + lr) * old;
#pragma unroll
  for (int d = 0; d < ND; d++)
#pragma unroll
    for (int g = 0; g < 4; g++) {
      uint2 u;
      u.x = pack2(o[d][4 * g] * il, o[d][4 * g + 1] * il);
      u.y = pack2(o[d][4 * g + 2] * il, o[d][4 * g + 3] * il);
      *(uint2*)(op + 32 * d + 8 * g + 4 * h) = u;
    }
}

typedef __attribute__((ext_vector_type(2))) float f32x2;
constexpr int SC_OP = 2048;
constexpr int SC_WR = 0, SC_KK = SC_OP, SC_WD = 2 * SC_OP, SC_KD = 3 * SC_OP, SC_BB = 4 * SC_OP;
constexpr int SC_R = SC_WR, SC_K = SC_KK, SC_LW = SC_WD, SC_LA = SC_KD;
constexpr int SC_V = 5 * SC_OP, SC_BR = SC_V + 2048, SC_CKR = SC_BR + 32, SC_Y = SC_CKR + 32;
constexpr int SC_END = SC_Y + 2048;
constexpr int SC_TW_B = SC_END * 4;
constexpr int SC_AL_B = SC_TW_B + 32 * 72 * 2;
static_assert(SC_AL_B + 32 * 72 * 2 + 960 * 4 <= LDS_BYTES, "scan lds");

__device__ __forceinline__ float fexp(float x) { return __builtin_amdgcn_exp2f(x * 1.4426950408889634f); }
__device__ __forceinline__ float frcp(float x) { return __builtin_amdgcn_rcpf(x); }
__device__ __forceinline__ float ftanh(float x) { return 1.f - 2.f * frcp(1.f + fexp(2.f * x)); }
__device__ __forceinline__ float fsigm(float x) { return frcp(1.f + fexp(-x)); }

struct Raw3 { uint4 c, a, b; };
__device__ __forceinline__ Raw3 ld3(const u16* __restrict__ p, bool hp, bool hn) {
  Raw3 r;
  r.c = *(const uint4*)p;
  r.a = hp ? *(const uint4*)(p - 1920) : make_uint4(0, 0, 0, 0);
  r.b = hn ? *(const uint4*)(p + 1920) : make_uint4(0, 0, 0, 0);
  return r;
}
__device__ __forceinline__ void mixr(const Raw3& r, const float* __restrict__ mp, const float* __restrict__ mn, float* out) {
  float cc[8] = {bflo(r.c.x), bfhi(r.c.x), bflo(r.c.y), bfhi(r.c.y), bflo(r.c.z), bfhi(r.c.z), bflo(r.c.w), bfhi(r.c.w)};
  float aa[8] = {bflo(r.a.x), bfhi(r.a.x), bflo(r.a.y), bfhi(r.a.y), bflo(r.a.z), bfhi(r.a.z), bflo(r.a.w), bfhi(r.a.w)};
  float bb[8] = {bflo(r.b.x), bfhi(r.b.x), bflo(r.b.y), bfhi(r.b.y), bflo(r.b.z), bfhi(r.b.z), bflo(r.b.w), bfhi(r.b.w)};
#pragma unroll
  for (int j = 0; j < 8; j++) out[j] = cc[j] + mp[j] * (aa[j] - cc[j]) + mn[j] * (bb[j] - cc[j]);
}
__device__ __forceinline__ void mix8(const u16* __restrict__ p, bool hp, bool hn, const float* __restrict__ mp,
                                     const float* __restrict__ mn, float* out) {
  Raw3 r = ld3(p, hp, hn);
  mixr(r, mp, mn, out);
}

template <int NRG>
__device__ __forceinline__ void scan_item(const Params& P, unsigned char* ldsb, int seq, int head, int dir, int rg) {
  float* L = (float*)ldsb;
  u16* TWb = (u16*)(ldsb + SC_TW_B);
  u16* ALb = (u16*)(ldsb + SC_AL_B);
  unsigned char* ws = P.ws;
  const u16* RW = (const u16*)(ws + OFF_RW);
  u16* Y = (u16*)(ws + (dir ? OFF_YB : OFF_YF));
  const float* w0 = dir ? P.in[19] : P.in[15];
  const float* a0 = dir ? P.in[21] : P.in[17];
  const u16* w2t = (const u16*)(ws + (dir ? OFF_W2B : OFF_W2F));
  const u16* a2t = (const u16*)(ws + (dir ? OFF_A2B : OFF_A2F));
  const int T = seq < 32 ? 2048 : 8192;
  const int start = seq < 32 ? seq * 2048 : NTP + (seq - 32) * 8192;
  const int tid = threadIdx.x, lane = tid & 63, wave = tid >> 6;
  const int hc = head * 64;
  const int pt = tid >> 3, pc = (tid & 7) * 8;
  const int wlo = dir ? 1600 : 1536, alo = dir ? 1728 : 1664;
  float* CS = (float*)(ldsb + SC_AL_B + 32 * 72 * 2);
  for (int i = tid; i < 960; i += NTHREADS) {
    const int arr = i >> 6, c = i & 63;
    const float* src;
    switch (arr) {
      case 0: src = P.in[13] + hc; break;
      case 1: src = P.in[14] + hc; break;
      case 2: src = P.in[13] + 512 + hc; break;
      case 3: src = P.in[14] + 512 + hc; break;
      case 4: src = P.in[13] + 1024 + hc; break;
      case 5: src = P.in[14] + 1024 + hc; break;
      case 6: src = P.in[13] + wlo; break;
      case 7: src = P.in[14] + wlo; break;
      case 8: src = P.in[13] + alo; break;
      case 9: src = P.in[14] + alo; break;
      case 10: src = w0 + hc; break;
      case 11: src = a0 + hc; break;
      case 12: src = P.in[24] + hc; break;
      case 13: src = P.in[25] + hc; break;
      default: src = P.in[26] + hc; break;
    }
    CS[i] = src[c];
  }
  __syncthreads();
  const float *mpr = CS + pc, *mnr = CS + 64 + pc, *mpk = CS + 128 + pc, *mnk = CS + 192 + pc, *mpv = CS + 256 + pc,
              *mnv = CS + 320 + pc, *mpw = CS + 384 + pc, *mnw = CS + 448 + pc, *mpa = CS + 512 + pc, *mna = CS + 576 + pc,
              *cw0 = CS + 640 + pc, *ca0 = CS + 704 + pc, *ckk = CS + 768 + pc, *cka = CS + 832 + pc, *crk = CS + 896 + pc;
  const int rp = tid >> 3, seg = tid & 7;
  f32x2 st[8];
#pragma unroll
  for (int k = 0; k < 8; k++) st[k] = (f32x2){0.f, 0.f};
  const int nch = T >> 5;
  Raw3 g_r, g_k, g_v, g_w, g_a;
#define SLOAD(chn)                                                                     \
  {                                                                                    \
    const int t0_ = dir ? T - 32 * ((chn) + 1) : 32 * (chn);                           \
    const int t_ = t0_ + pt;                                                           \
    const bool hp_ = t_ > 0, hn_ = t_ < T - 1;                                         \
    const u16* base_ = RW + (size_t)(start + t_) * 1920;                               \
    g_r = ld3(base_ + hc + pc, hp_, hn_); g_k = ld3(base_ + 512 + hc + pc, hp_, hn_);  \
    g_v = ld3(base_ + 1024 + hc + pc, hp_, hn_); g_w = ld3(base_ + wlo + pc, hp_, hn_); \
    g_a = ld3(base_ + alo + pc, hp_, hn_);                                             \
  }
  SLOAD(0)
  for (int ch = 0; ch < nch; ch++) {
    const int t0 = dir ? T - 32 * (ch + 1) : 32 * ch;
    bf16x8 lb0, lb1, lb2, lb3;
    {
      const int mat = wave >> 1, ntile = wave & 1;
      const u16* Bsrc = (mat ? a2t : w2t) + (size_t)(hc + 32 * ntile + (lane & 31)) * 64 + 8 * (lane >> 5);
      lb0 = *(const bf16x8*)(Bsrc); lb1 = *(const bf16x8*)(Bsrc + 16); lb2 = *(const bf16x8*)(Bsrc + 32); lb3 = *(const bf16x8*)(Bsrc + 48);
    }
    {
      float v[8];
      mixr(g_r, mpr, mnr, v);
#pragma unroll
      for (int j = 0; j < 8; j++) L[SC_R + pt * 64 + pc + j] = v[j];
      mixr(g_k, mpk, mnk, v);
#pragma unroll
      for (int j = 0; j < 8; j++) L[SC_K + pt * 64 + pc + j] = v[j];
      mixr(g_v, mpv, mnv, v);
#pragma unroll
      for (int j = 0; j < 8; j++) L[SC_V + pt * 64 + pc + j] = v[j];
      mixr(g_w, mpw, mnw, v);
      uint4 u;
      u.x = pack2(ftanh(v[0]), ftanh(v[1])); u.y = pack2(ftanh(v[2]), ftanh(v[3]));
      u.z = pack2(ftanh(v[4]), ftanh(v[5])); u.w = pack2(ftanh(v[6]), ftanh(v[7]));
      *(uint4*)(TWb + pt * 72 + pc) = u;
      mixr(g_a, mpa, mna, v);
      u.x = pack2(v[0], v[1]); u.y = pack2(v[2], v[3]); u.z = pack2(v[4], v[5]); u.w = pack2(v[6], v[7]);
      *(uint4*)(ALb + pt * 72 + pc) = u;
    }
    __syncthreads();
    {
      const int mat = wave >> 1, ntile = wave & 1;
      const u16* Asrc = (mat ? ALb : TWb) + (lane & 31) * 72 + 8 * (lane >> 5);
      f32x16 c;
#pragma unroll
      for (int r = 0; r < 16; r++) c[r] = 0.f;
      c = __builtin_amdgcn_mfma_f32_32x32x16_bf16(*(const bf16x8*)(Asrc), lb0, c, 0, 0, 0);
      c = __builtin_amdgcn_mfma_f32_32x32x16_bf16(*(const bf16x8*)(Asrc + 16), lb1, c, 0, 0, 0);
      c = __builtin_amdgcn_mfma_f32_32x32x16_bf16(*(const bf16x8*)(Asrc + 32), lb2, c, 0, 0, 0);
      c = __builtin_amdgcn_mfma_f32_32x32x16_bf16(*(const bf16x8*)(Asrc + 48), lb3, c, 0, 0, 0);
      float* dst = L + (mat ? SC_LA : SC_LW);
#pragma unroll
      for (int r = 0; r < 16; r++) {
        int tr = (r & 3) + 8 * (r >> 2) + 4 * (lane >> 5);
        dst[tr * 64 + 32 * ntile + (lane & 31)] = c[r];
      }
    }
    __syncthreads();
    {
      float ssk = 0.f, br = 0.f, kr = 0.f, bon = 0.f;
      float kkr[8], av[8], kdv[8], rr[8], dec[8];
#pragma unroll
      for (int j = 0; j < 8; j++) {
        int o = pt * 64 + pc + j;
        float r = L[SC_R + o], k = L[SC_K + o];
        float wp = cw0[j] + L[SC_LW + o];
        float z = -wp;
        float sp = z > 15.f ? z : 0.6931471805599453f * __builtin_amdgcn_logf(1.f + fexp(z));
        float w = -sp - 0.5f;
        dec[j] = fexp(-fexp(w));
        float a = fsigm(ca0[j] + L[SC_LA + o]);
        av[j] = a;
        kkr[j] = k * ckk[j];
        ssk += kkr[j] * kkr[j];
        kdv[j] = k * (1.f + (a - 1.f) * cka[j]);
        rr[j] = r;
        kr += kdv[j] * r;
        bon += r * kdv[j] * crk[j];
      }
      ssk = sum8(ssk);
      float inrm = __builtin_amdgcn_rsqf(fmaxf(ssk, 1e-24f));
#pragma unroll
      for (int j = 0; j < 8; j++) {
        float kk = kkr[j] * inrm;
        float b = kk * av[j];
        br += b * rr[j];
        int o = pt * 64 + pc + j;
        L[SC_KK + o] = kk;
        L[SC_BB + o] = b;
        L[SC_WR + o] = dec[j] * rr[j];
        L[SC_WD + o] = dec[j];
        L[SC_KD + o] = kdv[j];
      }
      br = sum8(br); kr = sum8(kr); bon = sum8(bon);
      if ((tid & 7) == 0) { L[SC_BR + pt] = br; L[SC_CKR + pt] = kr + bon; }
    }
    __syncthreads();
    if (ch + 1 < nch) SLOAD(ch + 1)
    {
#pragma unroll 1
      for (int qo = 0; qo < 4; qo++) {
        f32x2 yk = (f32x2){0.f, 0.f};
#pragma unroll
        for (int qi = 0; qi < 8; qi++) {
          const int q = qo * 8 + qi;
          const int tt = dir ? 31 - q : q;
          const float* ob = L + tt * 64 + 8 * seg;
          float4 kka = *(const float4*)(ob + SC_KK), kkb = *(const float4*)(ob + SC_KK + 4);
          float4 wra = *(const float4*)(ob + SC_WR), wrb = *(const float4*)(ob + SC_WR + 4);
          float4 wda = *(const float4*)(ob + SC_WD), wdb = *(const float4*)(ob + SC_WD + 4);
          float4 bba = *(const float4*)(ob + SC_BB), bbb = *(const float4*)(ob + SC_BB + 4);
          float4 kda = *(const float4*)(ob + SC_KD), kdb = *(const float4*)(ob + SC_KD + 4);
          float br = L[SC_BR + tt], ckr = L[SC_CKR + tt];
          float kk[8] = {kka.x, kka.y, kka.z, kka.w, kkb.x, kkb.y, kkb.z, kkb.w};
          float wr[8] = {wra.x, wra.y, wra.z, wra.w, wrb.x, wrb.y, wrb.z, wrb.w};
          float wd[8] = {wda.x, wda.y, wda.z, wda.w, wdb.x, wdb.y, wdb.z, wdb.w};
          float bb[8] = {bba.x, bba.y, bba.z, bba.w, bbb.x, bbb.y, bbb.z, bbb.w};
          float kd[8] = {kda.x, kda.y, kda.z, kda.w, kdb.x, kdb.y, kdb.z, kdb.w};
          if (NRG == 1) {
            float2 vv = *(const float2*)(L + SC_V + tt * 64 + 2 * rp);
            f32x2 v2 = (f32x2){vv.x, vv.y};
            f32x2 p1 = st[0] * kk[0], p2 = st[0] * wr[0];
#pragma unroll
            for (int k = 1; k < 8; k++) { p1 += st[k] * kk[k]; p2 += st[k] * wr[k]; }
            p1.x = sum8(p1.x); p1.y = sum8(p1.y); p2.x = sum8(p2.x); p2.y = sum8(p2.y);
            f32x2 y2 = p2 - p1 * br + v2 * ckr;
            if (qi == seg) yk = y2;
#pragma unroll
            for (int k = 0; k < 8; k++) st[k] = st[k] * wd[k] - p1 * bb[k] + v2 * kd[k];
          } else {
            const float v = L[SC_V + tt * 64 + 32 * rg + rp];
            f32x2 q1 = st[0] * (f32x2){kk[0], kk[1]}, q2 = st[0] * (f32x2){wr[0], wr[1]};
#pragma unroll
            for (int i = 1; i < 4; i++) {
              q1 += st[i] * (f32x2){kk[2 * i], kk[2 * i + 1]};
              q2 += st[i] * (f32x2){wr[2 * i], wr[2 * i + 1]};
            }
            const float p1 = sum8(q1.x + q1.y), p2 = sum8(q2.x + q2.y);
            const float y = p2 - p1 * br + v * ckr;
            if (qi == seg) yk.x = y;
#pragma unroll
            for (int i = 0; i < 4; i++)
              st[i] = st[i] * (f32x2){wd[2 * i], wd[2 * i + 1]} - p1 * (f32x2){bb[2 * i], bb[2 * i + 1]} + v * (f32x2){kd[2 * i], kd[2 * i + 1]};
          }
        }
        {
          const int q = qo * 8 + seg;
          const int tt = dir ? 31 - q : q;
          if (NRG == 1) *(float2*)(L + SC_Y + tt * 64 + 2 * rp) = make_float2(yk.x, yk.y);
          else L[SC_Y + tt * 64 + 32 * rg + rp] = yk.x;
        }
      }
    }
    __syncthreads();
    if (NRG == 1 || (pc >> 5) == rg) {
      const float* yp = L + SC_Y + pt * 64 + pc;
      uint4 u;
      u.x = pack2(yp[0], yp[1]); u.y = pack2(yp[2], yp[3]); u.z = pack2(yp[4], yp[5]); u.w = pack2(yp[6], yp[7]);
      *(uint4*)(Y + (size_t)(start + t0 + pt) * 512 + hc + pc) = u;
    }
  }
#undef SLOAD
}

__device__ __forceinline__ void phase4(const Params& P, unsigned char* ldsb) {
  __shared__ int s_item;
  unsigned* ctr = (unsigned*)(P.ws + OFF_CTL);
  u16* lds = (u16*)ldsb;
  u16* Q = (u16*)((unsigned char*)P.out + DO_Q);
  const u16* Kb = (const u16*)((unsigned char*)P.out + DO_K);
  const u16* Vt = (const u16*)((unsigned char*)P.out + DO_VT);
  u16* XQ = (u16*)(P.ws + OFF_XQ);
  const u16* MK = (const u16*)(P.ws + OFF_MK);
  const u16* MVT = (const u16*)(P.ws + OFF_MVT);
  const int total = 576 + 6144;
  const float LOG2E = 1.4426950408889634f;
  while (true) {
    __syncthreads();
    if (threadIdx.x == 0) s_item = (int)atomicAdd(ctr, 1u);
    __syncthreads();
    const int q = s_item;
    if (q >= total) break;
    int kind, idx;
    if (q < 576) { kind = 1; idx = q; }
    else if (q < 576 + 2048) { kind = 2; idx = q - 576; }
    else { kind = 3; idx = q - 2624; }
    if (kind == 1) {
      int i2 = idx < 64 ? idx : idx - 64;
      int dir = i2 & 1, head = (i2 >> 1) & 7, sl = i2 >> 4;
      scan_item<1>(P, ldsb, idx < 64 ? 32 + sl : sl, head, dir, 0);
    } else if (kind <= 3) {
      int seq, head, qb, T, start;
      if (kind == 2) { seq = 32 + (idx >> 9); head = (idx >> 6) & 7; qb = idx & 63; T = 8192; start = NTP + (seq - 32) * 8192; }
      else { seq = idx >> 7; head = (idx >> 4) & 7; qb = idx & 15; T = 2048; start = seq * 2048; }
      const size_t tok0 = (size_t)start + qb * 128;
      attn_item<96, 64, true, true>(lds, Q + tok0 * 768 + head * 96, 768, Kb + (size_t)start * 768 + head * 96, 768,
                              Vt + vt_base(seq) + (size_t)head * 64 * T, T, T, P.in[10],
                              0.10206207261596577f * LOG2E, qb * 128, Q + tok0 * 768 + head * 96, 768);
    }
  }
#ifdef SCANREP
  __syncthreads();
  for (int idx = blockIdx.x; idx < 576; idx += gridDim.x) {
    int dir = idx & 1, head = (idx >> 1) & 7, sl = idx >> 4;
    __syncthreads();
    scan_item<1>(P, ldsb, sl, head, dir, 0);
  }
#endif
  __syncthreads();
  unsigned* ctr2 = (unsigned*)(P.ws + OFF_CTL) + 16;
  while (true) {
    __syncthreads();
    if (threadIdx.x == 0) s_item = (int)atomicAdd(ctr2, 1u);
    __syncthreads();
    const int idx = s_item;
    if (idx >= 3072) break;
    int mt = idx >> 2, head = idx & 3;
    int seq, start, T;
    tok_seq(mt * 128, seq, start, T);
    const size_t tok0 = (size_t)mt * 128;
    attn_item<128, 128, false, false>(lds, XQ + tok0 * 512 + head * 128, 512, MK + (size_t)(seq * 4 + head) * 256 * 128, 128,
                                      MVT + (size_t)(seq * 4 + head) * 128 * 256, 256, 256, P.in[32],
                                      0.08838834764831845f * LOG2E, 0, XQ + tok0 * 512 + head * 128, 512);
  }
}

__device__ __forceinline__ void phase5(const Params& P, u16* lds) {
  __shared__ float st_mean[256], st_rstd[256];
  unsigned char* ws = P.ws;
  const u16* RW = (const u16*)(ws + OFF_RW);
  const u16* YF = (const u16*)(ws + OFF_YF);
  u16* YB = (u16*)(ws + OFF_YB);
  const u16* G2 = (const u16*)(ws + OFF_G2);
  const float* mup = P.in[13] + 1792;
  const float* mun = P.in[14] + 1792;
  const float* lng = P.in[27];
  const float* lnb = P.in[28];
  const int tid = threadIdx.x;
  for (int it = blockIdx.x; it < 768 * 4; it += gridDim.x) {
    int mt = it >> 2, nt = it & 3;
    int m0 = mt * 128, n0 = nt * 128;
    int seq, start, T;
    tok_seq(m0, seq, start, T);
    {
      int r = tid >> 1, hh = tid & 1;
      const u16* pf = YF + (size_t)(m0 + r) * 512 + n0 + hh * 64;
      const u16* pb = YB + (size_t)(m0 + r) * 512 + n0 + hh * 64;
      float sm = 0.f, sq = 0.f;
      for (int c = 0; c < 8; c++) {
        uint4 a = *(const uint4*)(pf + 8 * c), b = *(const uint4*)(pb + 8 * c);
        float y;
        y = bflo(a.x) + bflo(b.x); sm += y; sq += y * y; y = bfhi(a.x) + bfhi(b.x); sm += y; sq += y * y;
        y = bflo(a.y) + bflo(b.y); sm += y; sq += y * y; y = bfhi(a.y) + bfhi(b.y); sm += y; sq += y * y;
        y = bflo(a.z) + bflo(b.z); sm += y; sq += y * y; y = bfhi(a.z) + bfhi(b.z); sm += y; sq += y * y;
        y = bflo(a.w) + bflo(b.w); sm += y; sq += y * y; y = bfhi(a.w) + bfhi(b.w); sm += y; sq += y * y;
      }
      float mean = sm * (1.f / 64.f);
      float var = fmaxf(sq * (1.f / 64.f) - mean * mean, 0.f);
      st_mean[tid] = mean;
      st_rstd[tid] = rsqrtf(var + 64e-5f);
    }
    {
      const int lr = tid >> 3, lk = (tid & 7) * 8;
#pragma unroll
      for (int kb = 0; kb < 2; kb++) {
#pragma unroll
        for (int i = 0; i < 4; i++) {
          int r = lr + 32 * i;
          int t = m0 + r - start;
          float v[8];
          mix8(RW + (size_t)(m0 + r) * 1920 + 1792 + kb * 64 + lk, t > 0, t < T - 1, mup + kb * 64 + lk, mun + kb * 64 + lk, v);
          uint4 u;
          u.x = pack2(sigmoidf_(v[0]), sigmoidf_(v[1])); u.y = pack2(sigmoidf_(v[2]), sigmoidf_(v[3]));
          u.z = pack2(sigmoidf_(v[4]), sigmoidf_(v[5])); u.w = pack2(sigmoidf_(v[6]), sigmoidf_(v[7]));
          *(uint4*)(lds + kb * (2 * LTILE) + r * LROW + lk) = u;
          *(uint4*)(lds + kb * (2 * LTILE) + LTILE + r * LROW + lk) = *(const uint4*)(G2 + (size_t)(n0 + r) * 128 + kb * 64 + lk);
        }
      }
    }
    __syncthreads();
    Acc acc; acc_zero(acc);
    gemm_compute(acc, lds, 0);
    gemm_compute(acc, lds, 1);
    epi_each(acc, [&](int r0, int c, float v0, float v1, float v2, float v3) {
      int hh = c >> 6;
      float g = lng[n0 + c], b = lnb[n0 + c];
      float vv[4] = {v0, v1, v2, v3};
#pragma unroll
      for (int k = 0; k < 4; k++) {
        size_t o = (size_t)(m0 + r0 + k) * 512 + n0 + c;
        float y = bf2f(YF[o]) + bf2f(YB[o]);
        int si = (r0 + k) * 2 + hh;
        float yn = (y - st_mean[si]) * st_rstd[si] * g + b;
        YB[o] = f2bf(yn * vv[k]);
      }
    });
    __syncthreads();
  }
}

__device__ __forceinline__ void merge_branch(Acc& mg, u16* lds, const u16* Hrow, const u16* Wg_rows, const u16* Abr,
                                             const u16* Wbr, int Kb) {
  unsigned* G = (unsigned*)(lds + 2 * LTILE);
  {
    Acc acc; acc_zero(acc);
    gemm_lin<false, false>(acc, lds, Hrow, 1024, Wg_rows, 1024, 1024);
#pragma unroll
    for (int i = 0; i < 2; i++)
#pragma unroll
      for (int j = 0; j < 2; j++)
#pragma unroll
        for (int r = 0; r < 8; r++)
          G[((i * 2 + j) * 8 + r) * 256 + threadIdx.x] = pack2(sigmoidf_(acc.a[i][j][2 * r]), sigmoidf_(acc.a[i][j][2 * r + 1]));
  }
  Acc acc; acc_zero(acc);
  gemm_lin<true, false>(acc, lds, Abr, Kb, Wbr, Kb, Kb);
#pragma unroll
  for (int i = 0; i < 2; i++)
#pragma unroll
    for (int j = 0; j < 2; j++)
#pragma unroll
      for (int r = 0; r < 8; r++) {
        unsigned g = G[((i * 2 + j) * 8 + r) * 256 + threadIdx.x];
        mg.a[i][j][2 * r] += bflo(g) * acc.a[i][j][2 * r];
        mg.a[i][j][2 * r + 1] += bfhi(g) * acc.a[i][j][2 * r + 1];
      }
  __syncthreads();
}
__device__ __forceinline__ void phase6(const Params& P, u16* lds) {
  unsigned char* ws = P.ws;
  const u16* H = (const u16*)(ws + OFF_H);
  const u16* Wg = (const u16*)(ws + OFF_WIN) + (size_t)3200 * 1024;
  u16* MG = (u16*)(ws + OFF_MERGED);
  const u16* A0 = (const u16*)((unsigned char*)P.out + DO_Q);
  const u16* A1 = (const u16*)(ws + OFF_YB);
  const u16* A2 = (const u16*)(ws + OFF_XQ);
  const u16* W0 = (const u16*)(ws + OFF_WOA);
  const u16* W1 = (const u16*)(ws + OFF_WOB);
  const u16* W2 = (const u16*)(ws + OFF_WOC);
  for (int kk_ = 0;; kk_++) {
    int mt, nt;
    if (!tile_map(kk_, 768, 8, mt, nt)) break;
    int m0 = mt * 128, n0 = nt * 128;
    Acc mg; acc_zero(mg);
    const u16* Hrow = H + (size_t)m0 * 1024;
#pragma nounroll
    for (int br = 0; br < 3; br++) {
      const u16* Ab = br == 0 ? A0 + (size_t)m0 * 768 : (br == 1 ? A1 + (size_t)m0 * 512 : A2 + (size_t)m0 * 512);
      const u16* Wb = br == 0 ? W0 + (size_t)n0 * 768 : (br == 1 ? W1 + (size_t)n0 * 512 : W2 + (size_t)n0 * 512);
      merge_branch(mg, lds, Hrow, Wg + (size_t)(br * 1024 + n0) * 1024, Ab, Wb, br == 0 ? 768 : 512);
    }
    epi_each(mg, [&](int r0, int c, float v0, float v1, float v2, float v3) {
      store_bf16_pairs(MG + (size_t)(m0 + r0) * 1024 + n0 + c, 1024, c, v0, v1, v2, v3);
    });
  }
}

__device__ __forceinline__ void phase7(const Params& P, u16* lds) {
  __shared__ float rs_s[128];
  unsigned char* ws = P.ws;
  const u16* MG = (const u16*)(ws + OFF_MERGED);
  const u16* W = (const u16*)(ws + OFF_WOUT);
  u16* HB = (u16*)(ws + OFF_H);
  float* RS = (float*)(ws + OFF_RS);
  const int tid = threadIdx.x, lane = tid & 63;
  for (int kk_ = 0;; kk_++) {
    int mt, nt;
    if (!tile_map(kk_, 768, 8, mt, nt)) break;
    int m0 = mt * 128, n0 = nt * 128;
    if (tid < 128) rs_s[tid] = 0.f;
    Acc acc; acc_zero(acc);
    gemm_lin(acc, lds, MG + (size_t)m0 * 1024, 1024, W + (size_t)n0 * 1024, 1024, 1024);
    const float* xin = m0 < NTP ? P.in[0] + (size_t)m0 * 1024 : P.in[1] + (size_t)(m0 - NTP) * 1024;
    float* xo = P.out + (size_t)m0 * 1024;
    epi_each(acc, [&](int r0, int c, float v0, float v1, float v2, float v3) {
      size_t o = (size_t)r0 * 1024 + n0 + c;
      const float y0 = xin[o] + v0, y1 = xin[o + 1024] + v1, y2 = xin[o + 2048] + v2, y3 = xin[o + 3072] + v3;
      xo[o] = y0; xo[o + 1024] = y1; xo[o + 2048] = y2; xo[o + 3072] = y3;
      store_bf16_pairs(HB + (size_t)(m0 + r0) * 1024 + n0 + c, 1024, c, y0, y1, y2, y3);
      const float s0 = sum16(y0 * y0), s1 = sum16(y1 * y1), s2 = sum16(y2 * y2), s3 = sum16(y3 * y3);
      if ((lane & 15) == 0) {
        atomicAdd(&rs_s[r0], s0); atomicAdd(&rs_s[r0 + 1], s1); atomicAdd(&rs_s[r0 + 2], s2); atomicAdd(&rs_s[r0 + 3], s3);
      }
    });
    __syncthreads();
    if (tid < 128) atomicAdd(&RS[m0 + tid], rs_s[tid]);
    __syncthreads();
  }
}

__device__ __forceinline__ void phase8(const Params& P) {
  const int wave = threadIdx.x >> 6;
  u16* H = (u16*)(P.ws + OFF_H);
  for (int row = blockIdx.x * 4 + wave; row < NT; row += gridDim.x * 4)
    norm_row(P.out + (size_t)row * 1024, H + (size_t)row * 1024);
}

__device__ __forceinline__ float erf_as(float x) {
  const float ax = fabsf(x);
  const float t = __builtin_amdgcn_rcpf(1.f + 0.3275911f * ax);
  const float y = ((((1.061405429f * t - 1.453152027f) * t + 1.421413741f) * t - 0.284496736f) * t + 0.254829592f) * t;
  const float r = 1.f - y * __builtin_amdgcn_exp2f(-ax * ax * 1.4426950408889634f);
  return copysignf(r, x);
}
__device__ __forceinline__ void phase9(const Params& P, u16* lds) {
  unsigned char* ws = P.ws;
  const u16* H = (const u16*)(ws + OFF_H);
  const u16* W = (const u16*)(ws + OFF_WUP);
  u16* ACT = (u16*)(ws + OFF_ACT);
  const float* cw = P.in[38];
  const float* cb = P.in[39];
  float* Lf = (float*)lds;
  __shared__ float rstd9[128];
  const float* RS = (const float*)(ws + OFF_RS);
  const int tid = threadIdx.x, lane = tid & 63, wave = tid >> 6, wm = wave >> 1, wn = wave & 1;
  for (int kk_ = 0;; kk_++) {
    int mt, nt;
    if (!tile_map(kk_, 808, 44, mt, nt)) break;
    int start, T, ti;
    if (mt < 544) { int s = mt / 17; ti = mt % 17; start = s * 2048; T = 2048; }
    else { int m2 = mt - 544; int s = m2 / 66; ti = m2 % 66; start = NTP + s * 8192; T = 8192; }
    const int p0 = 126 * ti - 1;
    const int lr = tid >> 3;
    const u16* pa[4];
#pragma unroll
    for (int i = 0; i < 4; i++) {
      int p = p0 + lr + 32 * i;
      p = p < 0 ? 0 : (p > T - 1 ? T - 1 : p);
      pa[i] = H + (size_t)(start + p) * 1024;
    }
    const u16* Bt = W + (size_t)nt * 128 * 1024;
    if (tid < 128) {
      int p = p0 + tid;
      p = p < 0 ? 0 : (p > T - 1 ? T - 1 : p);
      rstd9[tid] = rsqrtf(RS[start + p] * (1.f / 1024.f) + 1e-6f);
    }
    Acc acc; acc_zero(acc);
    gemm_main(acc, lds, pa[0], pa[1], pa[2], pa[3], Bt + (size_t)lr * 1024, Bt + (size_t)(lr + 32) * 1024,
              Bt + (size_t)(lr + 64) * 1024, Bt + (size_t)(lr + 96) * 1024, 1024);
    {
      float* dst = Lf + wn * 8192;
#pragma unroll
      for (int i = 0; i < 2; i++)
#pragma unroll
        for (int j = 0; j < 2; j++)
#pragma unroll
          for (int r = 0; r < 16; r++) {
            int rr = 64 * wm + 32 * i + (r & 3) + 8 * (r >> 2) + 4 * (lane >> 5);
            dst[rr * 64 + 32 * j + (lane & 31)] = acc.a[i][j][r] * rstd9[rr];
          }
    }
    __syncthreads();
    {
      const int c = tid & 63, rgp = tid >> 6;
      const int col = nt * 64 + c;
      const float w0 = cw[col], w1 = cw[2816 + col], w2 = cw[2 * 2816 + col], bb = cb[col];
      int rbeg = rgp * 32; if (rbeg < 1) rbeg = 1;
      int rend = rgp * 32 + 32; if (rend > 127) rend = 127;
      auto gval = [&](int r) { int p = p0 + r; return (p >= 0 && p < T) ? Lf[r * 64 + c] : 0.f; };
      float gp = gval(rbeg - 1), gc = gval(rbeg);
      for (int r = rbeg; r < rend; r++) {
        float gn = gval(r + 1);
        int p = p0 + r;
        if (p < T) {
          float cc = w0 * gp + w1 * gc + w2 * gn + bb;
          float a = 0.5f * cc * (1.f + erf_as(cc * 0.70710678118654752f)) * Lf[8192 + r * 64 + c];
          ACT[(size_t)(start + p) * 2816 + col] = f2bf(a);
        }
        gp = gc; gc = gn;
      }
    }
    __syncthreads();
  }
}

__device__ __forceinline__ void phase10(const Params& P, u16* lds) {
  unsigned char* ws = P.ws;
  const u16* ACT = (const u16*)(ws + OFF_ACT);
  const u16* W = (const u16*)(ws + OFF_WDOWN);
  for (int kk_ = 0;; kk_++) {
    int mt, nt;
    if (!tile_map(kk_, 768, 8, mt, nt)) break;
    int m0 = mt * 128, n0 = nt * 128;
    Acc acc; acc_zero(acc);
    gemm_lin(acc, lds, ACT + (size_t)m0 * 2816, 2816, W + (size_t)n0 * 2816, 2816, 2816);
    float* xo = P.out + (size_t)m0 * 1024;
    epi_each(acc, [&](int r0, int c, float v0, float v1, float v2, float v3) {
      size_t o = (size_t)r0 * 1024 + n0 + c;
      xo[o] += v0; xo[o + 1024] += v1; xo[o + 2048] += v2; xo[o + 3072] += v3;
    });
  }
}

constexpr int NPHASE = 11;
__global__ void __launch_bounds__(NTHREADS, 2) fwd_kernel(Params P) {
  extern __shared__ __attribute__((aligned(16))) unsigned char dlds[];
  cg::grid_group grid = cg::this_grid();
  u16* lds = (u16*)dlds;
#ifndef REPMASK
#define REPMASK 0
#endif
#define PH(k, call)                                   \
  if (P.lo <= (k) && (k) < P.hi) {                    \
    call;                                             \
    if ((REPMASK >> (k)) & 1) { grid.sync(); call; }  \
    if ((k) + 1 < P.hi) grid.sync();                  \
  }
  PH(0, (phase0(P), phase0b(P)))
  PH(1, phase1(P, lds))
  PH(2, phase2(P, lds))
  PH(3, phase3(P))
  PH(4, phase4(P, dlds))
  PH(5, phase5(P, lds))
  PH(6, phase6(P, lds))
  PH(7, phase7(P, lds))
  PH(9, phase9(P, lds))
  PH(10, phase10(P, lds))
#undef PH
}

extern "C" void kernel_launch(void* const* d_in, const int* in_sizes, int n_in, void* d_out, int out_size, void* d_ws,
                              size_t ws_size, hipStream_t stream) {
  static int grid_blocks = 0;
  if (!grid_blocks) {
    int dev = 0, cus = 0, per_cu = 0;
    hipGetDevice(&dev);
    hipDeviceGetAttribute(&cus, hipDeviceAttributeMultiprocessorCount, dev);
    hipFuncSetAttribute((const void*)fwd_kernel, hipFuncAttributeMaxDynamicSharedMemorySize, LDS_BYTES);
    hipOccupancyMaxActiveBlocksPerMultiprocessor(&per_cu, (const void*)fwd_kernel, NTHREADS, LDS_BYTES);
    if (per_cu < 1) per_cu = 1;
    if (per_cu > 2) per_cu = 2;
    grid_blocks = cus * per_cu;
    if (ws_size < WS_END) fprintf(stderr, "workspace too small: %zu < %zu\n", ws_size, (size_t)WS_END);
  }
  if (ws_size < WS_END) return;
  Params p{};
  for (int i = 0; i < 41; i++) p.in[i] = (const float*)d_in[i];
  p.out = (float*)d_out;
  p.ws = (unsigned char*)d_ws;
#if MEGA
  p.lo = 0; p.hi = NPHASE;
  void* args[] = {&p};
  hipError_t e = hipLaunchCooperativeKernel((const void*)fwd_kernel, dim3(grid_blocks), dim3(NTHREADS), args, LDS_BYTES, stream);
  if (e != hipSuccess) fprintf(stderr, "cooperative launch failed: %s (grid %d)\n", hipGetErrorString(e), grid_blocks);
#else
#ifndef PHMAX
#define PHMAX 11
#endif
  for (int k = 0; k < PHMAX; k++) {
    p.lo = k; p.hi = k + 1;
    hipLaunchKernelGGL(fwd_kernel, dim3(grid_blocks), dim3(NTHREADS), LDS_BYTES, stream, p);
  }
#endif
}
```

```cpp
#include <hip/hip_runtime.h>
#include <hip/hip_cooperative_groups.h>
#include <cstdio>
#include <cstdint>
namespace cg = cooperative_groups;

typedef unsigned short u16;
typedef __attribute__((ext_vector_type(8))) short bf16x8;
typedef __attribute__((ext_vector_type(16))) float f32x16;

#ifndef MEGA
#define MEGA 1
#endif

constexpr int NT = 98304;
constexpr int NTP = 65536;
constexpr int NMEMROWS = 9216;
constexpr int NTHREADS = 256;
constexpr int LDS_BYTES = 73728;

constexpr size_t OFF_CTL = 0;
constexpr size_t OFF_WIN = 4096;
constexpr size_t OFF_WUQ = OFF_WIN + (size_t)6272 * 1024 * 2;
constexpr size_t OFF_WUKV = OFF_WUQ + (size_t)768 * 384 * 2;
constexpr size_t OFF_WOA = OFF_WUKV + (size_t)1024 * 256 * 2;
constexpr size_t OFF_WOB = OFF_WOA + (size_t)1024 * 768 * 2;
constexpr size_t OFF_WOC = OFF_WOB + (size_t)1024 * 512 * 2;
constexpr size_t OFF_WMKV = OFF_WOC + (size_t)1024 * 512 * 2;
constexpr size_t OFF_WOUT = OFF_WMKV + (size_t)2048 * 1024 * 2;
constexpr size_t OFF_WUP = OFF_WOUT + (size_t)1024 * 1024 * 2;
constexpr size_t OFF_WDOWN = OFF_WUP + (size_t)5632 * 1024 * 2;
constexpr size_t OFF_G2 = OFF_WDOWN + (size_t)1024 * 2816 * 2;
constexpr size_t OFF_W2F = OFF_G2 + (size_t)512 * 128 * 2;
constexpr size_t OFF_W2B = OFF_W2F + 65536;
constexpr size_t OFF_A2F = OFF_W2B + 65536;
constexpr size_t OFF_A2B = OFF_A2F + 65536;
constexpr size_t OFF_RS = OFF_A2B + 65536;
constexpr size_t OFF_H = 50331648;
static_assert(OFF_RS + (size_t)NT * 4 <= OFF_H, "rs");
constexpr size_t OFF_CQKV = OFF_H + (size_t)NT * 1024 * 2;
constexpr size_t OFF_RW = OFF_CQKV + (size_t)NT * 672 * 2;
constexpr size_t OFF_XQ = OFF_RW + (size_t)NT * 1920 * 2;
constexpr size_t OFF_MH = OFF_XQ + (size_t)NT * 512 * 2;
constexpr size_t OFF_MKV = OFF_MH + (size_t)NMEMROWS * 1024 * 2;
constexpr size_t OFF_MK = OFF_MKV + (size_t)NMEMROWS * 2048 * 2;
constexpr size_t OFF_MVT = OFF_MK + (size_t)NMEMROWS * 512 * 2;
constexpr size_t OFF_YB = OFF_MVT + (size_t)NMEMROWS * 512 * 2;
constexpr size_t WS_END = OFF_YB + (size_t)NT * 512 * 2;
static_assert(WS_END <= (size_t)1073741824, "workspace overflow");
constexpr size_t OFF_YF = OFF_CQKV;
constexpr size_t OFF_MERGED = OFF_RW;
constexpr size_t OFF_ACT = OFF_CQKV;
static_assert((size_t)NT * 2816 * 2 <= OFF_MH - OFF_CQKV, "act overflow");
constexpr size_t DO_Q = 0;
constexpr size_t DO_K = (size_t)NT * 768 * 2;
constexpr size_t DO_VT = DO_K + (size_t)NT * 768 * 2;

struct Params {
  const float* in[41];
  float* out;
  unsigned char* ws;
  int lo, hi;
};

typedef __bf16 bf16x2_t __attribute__((ext_vector_type(2)));
typedef float f32x2_t __attribute__((ext_vector_type(2)));
__device__ __forceinline__ unsigned pack2(float a, float b) {
  f32x2_t f = {a, b};
  bf16x2_t h = __builtin_convertvector(f, bf16x2_t);
  return __builtin_bit_cast(unsigned, h);
}
__device__ __forceinline__ u16 f2bf(float f) { return (u16)(pack2(f, f) & 0xffffu); }
__device__ __forceinline__ float bf2f(u16 b) { return __uint_as_float(((unsigned)b) << 16); }
__device__ __forceinline__ float bflo(unsigned u) { return __uint_as_float(u << 16); }
__device__ __forceinline__ float bfhi(unsigned u) { return __uint_as_float(u & 0xffff0000u); }

template <int CTRL>
__device__ __forceinline__ float dppf(float v) {
  return __int_as_float(__builtin_amdgcn_mov_dpp(__float_as_int(v), CTRL, 0xF, 0xF, true));
}
__device__ __forceinline__ float sum16(float v) {
  v += dppf<0xB1>(v);
  v += dppf<0x4E>(v);
  v += dppf<0x141>(v);
  v += dppf<0x140>(v);
  return v;
}
__device__ __forceinline__ float sum8(float v) {
  v += dppf<0xB1>(v);
  v += dppf<0x4E>(v);
  v += dppf<0x141>(v);
  return v;
}
__device__ __forceinline__ float wave_sum(float v) {
  v = sum16(v);
  v += __shfl_xor(v, 16);
  v += __shfl_xor(v, 32);
  return v;
}
__device__ __forceinline__ float sigmoidf_(float x) { return 1.f / (1.f + __expf(-x)); }

__device__ __forceinline__ void tok_seq(int g, int& seq, int& start, int& T) {
  if (g < NTP) { seq = g >> 11; start = seq << 11; T = 2048; }
  else { int s = (g - NTP) >> 13; seq = 32 + s; start = NTP + (s << 13); T = 8192; }
}
__device__ __forceinline__ size_t vt_base(int seq) {
  return seq < 32 ? (size_t)seq * (512 * 2048) : (size_t)32 * 512 * 2048 + (size_t)(seq - 32) * (512 * 8192);
}

struct Acc { f32x16 a[2][2]; };
constexpr int LROW = 72;
constexpr int LTILE = 128 * LROW;

__device__ __forceinline__ void acc_zero(Acc& acc) {
#pragma unroll
  for (int i = 0; i < 2; i++)
#pragma unroll
    for (int j = 0; j < 2; j++)
#pragma unroll
      for (int r = 0; r < 16; r++) acc.a[i][j][r] = 0.f;
}

__device__ __forceinline__ void gemm_compute(Acc& acc, const u16* lds, int b) {
  const int lane = threadIdx.x & 63, wave = threadIdx.x >> 6, wm = wave >> 1, wn = wave & 1;
  const u16* A = lds + b * (2 * LTILE) + (64 * wm + (lane & 31)) * LROW + 8 * (lane >> 5);
  const u16* B = lds + b * (2 * LTILE) + LTILE + (64 * wn + (lane & 31)) * LROW + 8 * (lane >> 5);
#pragma unroll
  for (int s = 0; s < 4; s++) {
    bf16x8 a0 = *(const bf16x8*)(A + 16 * s);
    bf16x8 a1 = *(const bf16x8*)(A + 32 * LROW + 16 * s);
    bf16x8 b0 = *(const bf16x8*)(B + 16 * s);
    bf16x8 b1 = *(const bf16x8*)(B + 32 * LROW + 16 * s);
    acc.a[0][0] = __builtin_amdgcn_mfma_f32_32x32x16_bf16(a0, b0, acc.a[0][0], 0, 0, 0);
    acc.a[0][1] = __builtin_amdgcn_mfma_f32_32x32x16_bf16(a0, b1, acc.a[0][1], 0, 0, 0);
    acc.a[1][0] = __builtin_amdgcn_mfma_f32_32x32x16_bf16(a1, b0, acc.a[1][0], 0, 0, 0);
    acc.a[1][1] = __builtin_amdgcn_mfma_f32_32x32x16_bf16(a1, b1, acc.a[1][1], 0, 0, 0);
  }
}

template <bool SINGLE = false, bool DEEP = true>
__device__ __forceinline__ void gemm_main(Acc& acc, u16* lds, const u16* pa0, const u16* pa1, const u16* pa2,
                                          const u16* pa3, const u16* pb0, const u16* pb1, const u16* pb2,
                                          const u16* pb3, int K) {
  const int tid = threadIdx.x;
  const int lr = tid >> 3, lk = (tid & 7) * 8;
  uint4 xa0, xa1, xa2, xa3, xb0, xb1, xb2, xb3;
  uint4 ya0, ya1, ya2, ya3, yb0, yb1, yb2, yb3;
  const int nk = K >> 6;
#define GLOAD(S, k0)                                                                         \
  S##a0 = *(const uint4*)(pa0 + (k0) + lk); S##a1 = *(const uint4*)(pa1 + (k0) + lk);         \
  S##a2 = *(const uint4*)(pa2 + (k0) + lk); S##a3 = *(const uint4*)(pa3 + (k0) + lk);         \
  S##b0 = *(const uint4*)(pb0 + (k0) + lk); S##b1 = *(const uint4*)(pb1 + (k0) + lk);         \
  S##b2 = *(const uint4*)(pb2 + (k0) + lk); S##b3 = *(const uint4*)(pb3 + (k0) + lk);
#define SSTORE(S, b)                                                                         \
  {                                                                                          \
    u16* A_ = lds + (b) * (2 * LTILE) + lr * LROW + lk;                                      \
    u16* B_ = A_ + LTILE;                                                                    \
    *(uint4*)(A_) = S##a0; *(uint4*)(A_ + 32 * LROW) = S##a1;                                \
    *(uint4*)(A_ + 64 * LROW) = S##a2; *(uint4*)(A_ + 96 * LROW) = S##a3;                    \
    *(uint4*)(B_) = S##b0; *(uint4*)(B_ + 32 * LROW) = S##b1;                                \
    *(uint4*)(B_ + 64 * LROW) = S##b2; *(uint4*)(B_ + 96 * LROW) = S##b3;                    \
  }
  if (!DEEP) {
    GLOAD(x, 0)
    SSTORE(x, 0)
    __syncthreads();
    for (int kt = 0; kt < nk; kt++) {
      if (kt + 1 < nk) { GLOAD(x, (kt + 1) * 64) }
      gemm_compute(acc, lds, SINGLE ? 0 : (kt & 1));
      if (SINGLE) __syncthreads();
      if (kt + 1 < nk) { SSTORE(x, SINGLE ? 0 : ((kt + 1) & 1)) }
      __syncthreads();
    }
    return;
  }
  GLOAD(x, 0)
  GLOAD(y, 64)
  SSTORE(x, 0)
  __syncthreads();
  for (int kt = 0; kt < nk; kt += 2) {
    if (kt + 2 < nk) { GLOAD(x, (kt + 2) * 64) }
    __builtin_amdgcn_sched_barrier(0);
    gemm_compute(acc, lds, 0);
    if (SINGLE) __syncthreads();
    SSTORE(y, SINGLE ? 0 : 1)
    __syncthreads();
    if (kt + 3 < nk) { GLOAD(y, (kt + 3) * 64) }
    __builtin_amdgcn_sched_barrier(0);
    gemm_compute(acc, lds, SINGLE ? 0 : 1);
    if (SINGLE) __syncthreads();
    if (kt + 2 < nk) { SSTORE(x, 0) }
    __syncthreads();
  }
#undef GLOAD
#undef SSTORE
}

template <bool SINGLE = false, bool DEEP = true>
__device__ __forceinline__ void gemm_lin(Acc& acc, u16* lds, const u16* A, long lda, const u16* B, long ldb, int K) {
  const int lr = threadIdx.x >> 3;
  gemm_main<SINGLE, DEEP>(acc, lds, A + (long)lr * lda, A + (long)(lr + 32) * lda, A + (long)(lr + 64) * lda,
            A + (long)(lr + 96) * lda, B + (long)lr * ldb, B + (long)(lr + 32) * ldb, B + (long)(lr + 64) * ldb,
            B + (long)(lr + 96) * ldb, K);
}

template <class F>
__device__ __forceinline__ void epi_each(const Acc& acc, F f) {
  const int lane = threadIdx.x & 63, wave = threadIdx.x >> 6, wm = wave >> 1, wn = wave & 1;
#pragma unroll
  for (int i = 0; i < 2; i++)
#pragma unroll
    for (int j = 0; j < 2; j++)
#pragma unroll
      for (int g = 0; g < 4; g++) {
        int r0 = 64 * wm + 32 * i + 8 * g + 4 * (lane >> 5);
        int c = 64 * wn + 32 * j + (lane & 31);
        f(r0, c, acc.a[i][j][4 * g + 0], acc.a[i][j][4 * g + 1], acc.a[i][j][4 * g + 2], acc.a[i][j][4 * g + 3]);
      }
}

__device__ __forceinline__ void store_bf16_pairs(u16* colbase, long ld, int c, float v0, float v1, float v2, float v3) {
  const bool odd = c & 1;
  const float sA = odd ? v0 : v2, sB = odd ? v1 : v3;
  const float rA = dppf<0xB1>(sA), rB = dppf<0xB1>(sB);
  if (!odd) {
    *(unsigned*)(colbase) = pack2(v0, rA);
    *(unsigned*)(colbase + ld) = pack2(v1, rB);
  } else {
    *(unsigned*)(colbase + 2 * ld - 1) = pack2(rA, v2);
    *(unsigned*)(colbase + 3 * ld - 1) = pack2(rB, v3);
  }
}

__device__ __forceinline__ bool tile_map(int k, int MT, int NTL, int& mt, int& nt) {
  const int G = gridDim.x;
  if (G & 7) {
    int it = blockIdx.x + k * G;
    if (it >= MT * NTL) return false;
    mt = it / NTL; nt = it % NTL;
    return true;
  }
  const int xcd = blockIdx.x & 7, lb = blockIdx.x >> 3, nbx = G >> 3;
  const int mtx0 = (MT * xcd) >> 3, mtx1 = (MT * (xcd + 1)) >> 3, MTX = mtx1 - mtx0;
  const int idx = lb + k * nbx;
  if (idx >= MTX * NTL) return false;
  constexpr int GM = 4;
  const int mg0 = idx / (GM * NTL);
  const int base = mg0 * GM;
  const int gsz = (MTX - base) < GM ? (MTX - base) : GM;
  const int rem = idx - mg0 * GM * NTL;
  nt = rem / gsz;
  mt = mtx0 + base + rem % gsz;
  return true;
}

template <class NMap, class KMap>
__device__ __forceinline__ void cvtw(const float* __restrict__ W, int srcN, u16* __restrict__ Wt, int dN, int dK,
                     const float* __restrict__ gain, NMap nmap, KMap kmap, long gtid, long gsz) {
  const int kch = dK >> 3;
  const long total = (long)dN * kch;
  for (long i = gtid; i < total; i += gsz) {
    int n = (int)(i % dN), kc = (int)(i / dN);
    int sn = nmap(n);
    float v[8];
#pragma unroll
    for (int j = 0; j < 8; j++) {
      int sk = kmap(kc * 8 + j);
      float x = 0.f;
      if (sn >= 0 && sk >= 0) {
        x = W[(long)sk * srcN + sn];
        if (gain) x *= gain[sk];
      }
      v[j] = x;
    }
    uint4 o;
    o.x = pack2(v[0], v[1]); o.y = pack2(v[2], v[3]); o.z = pack2(v[4], v[5]); o.w = pack2(v[6], v[7]);
    *(uint4*)(Wt + (long)n * dK + kc * 8) = o;
  }
}

__device__ __forceinline__ void phase0(const Params& P) {
  const long gtid = (long)blockIdx.x * NTHREADS + threadIdx.x, gsz = (long)gridDim.x * NTHREADS;
  unsigned char* ws = P.ws;
  if (gtid == 0) { ((unsigned*)(ws + OFF_CTL))[0] = 0u; ((unsigned*)(ws + OFF_CTL))[16] = 0u; }
  { float* rsz = (float*)(ws + OFF_RS); for (long e = gtid; e < NT; e += gsz) rsz[e] = 0.f; }
  auto idn = [](int n) { return n; };
  cvtw(P.in[5], 6176, (u16*)(ws + OFF_WIN), 6272, 1024, P.in[4],
       [](int n) {
         if (n < 640) return n;
         if (n < 2560) return 672 + (n - 640);
         if (n < 3072) return 2592 + (n - 2560);
         if (n < 3104) return 640 + (n - 3072);
         if (n < 3200) return -1;
         return 3104 + (n - 3200);
       },
       idn, gtid, gsz);
  cvtw(P.in[7], 768, (u16*)(ws + OFF_WUQ), 768, 384, P.in[6], idn, idn, gtid, gsz);
  cvtw(P.in[9], 1024, (u16*)(ws + OFF_WUKV), 1024, 256, P.in[8], idn, idn, gtid, gsz);
  cvtw(P.in[12], 1024, (u16*)(ws + OFF_WOA), 1024, 768, nullptr, idn,
       [](int k) { int h = k / 96, d = k % 96; return d < 64 ? h * 64 + d : -1; }, gtid, gsz);
  cvtw(P.in[29], 1024, (u16*)(ws + OFF_WOB), 1024, 512, nullptr, idn, idn, gtid, gsz);
  cvtw(P.in[34], 1024, (u16*)(ws + OFF_WOC), 1024, 512, nullptr, idn, idn, gtid, gsz);
  cvtw(P.in[31], 1024, (u16*)(ws + OFF_WMKV), 1024, 1024, P.in[30], idn, idn, gtid, gsz);
  cvtw(P.in[35], 1024, (u16*)(ws + OFF_WOUT), 1024, 1024, nullptr, idn, idn, gtid, gsz);
  cvtw(P.in[37], 5632, (u16*)(ws + OFF_WUP), 5632, 1024, P.in[36],
       [](int n) { int t = n >> 7, w = n & 127; return w < 64 ? t * 64 + w : 2816 + t * 64 + (w - 64); }, idn, gtid, gsz);
  cvtw(P.in[40], 1024, (u16*)(ws + OFF_WDOWN), 1024, 2816, nullptr, idn, idn, gtid, gsz);
  cvtw(P.in[23], 512, (u16*)(ws + OFF_G2), 512, 128, nullptr, idn, idn, gtid, gsz);
  cvtw(P.in[16], 512, (u16*)(ws + OFF_W2F), 512, 64, nullptr, idn, idn, gtid, gsz);
  cvtw(P.in[20], 512, (u16*)(ws + OFF_W2B), 512, 64, nullptr, idn, idn, gtid, gsz);
  cvtw(P.in[18], 512, (u16*)(ws + OFF_A2F), 512, 64, nullptr, idn, idn, gtid, gsz);
  cvtw(P.in[22], 512, (u16*)(ws + OFF_A2B), 512, 64, nullptr, idn, idn, gtid, gsz);
}

__device__ __forceinline__ void norm_row(const float* __restrict__ src, u16* __restrict__ dst) {
  const int lane = threadIdx.x & 63;
  float4 v0 = *(const float4*)(src + lane * 4);
  float4 v1 = *(const float4*)(src + 256 + lane * 4);
  float4 v2 = *(const float4*)(src + 512 + lane * 4);
  float4 v3 = *(const float4*)(src + 768 + lane * 4);
  float ss = v0.x * v0.x + v0.y * v0.y + v0.z * v0.z + v0.w * v0.w + v1.x * v1.x + v1.y * v1.y + v1.z * v1.z +
             v1.w * v1.w + v2.x * v2.x + v2.y * v2.y + v2.z * v2.z + v2.w * v2.w + v3.x * v3.x + v3.y * v3.y +
             v3.z * v3.z + v3.w * v3.w;
  ss = wave_sum(ss);
  float r = rsqrtf(ss * (1.f / 1024.f) + 1e-6f);
  uint2 o;
  o.x = pack2(v0.x * r, v0.y * r); o.y = pack2(v0.z * r, v0.w * r); *(uint2*)(dst + lane * 4) = o;
  o.x = pack2(v1.x * r, v1.y * r); o.y = pack2(v1.z * r, v1.w * r); *(uint2*)(dst + 256 + lane * 4) = o;
  o.x = pack2(v2.x * r, v2.y * r); o.y = pack2(v2.z * r, v2.w * r); *(uint2*)(dst + 512 + lane * 4) = o;
  o.x = pack2(v3.x * r, v3.y * r); o.y = pack2(v3.z * r, v3.w * r); *(uint2*)(dst + 768 + lane * 4) = o;
}

__device__ __forceinline__ void phase0b(const Params& P) {
  const int wave = threadIdx.x >> 6;
  u16* H = (u16*)(P.ws + OFF_H);
  u16* MH = (u16*)(P.ws + OFF_MH);
  for (int row = blockIdx.x * 4 + wave; row < NT + NMEMROWS; row += gridDim.x * 4) {
    if (row < NT) {
      const float* src = row < NTP ? P.in[0] + (size_t)row * 1024 : P.in[1] + (size_t)(row - NTP) * 1024;
      norm_row(src, H + (size_t)row * 1024);
    } else {
      int mr = row - NT;
      const float* src = mr < 8192 ? P.in[2] + (size_t)mr * 1024 : P.in[3] + (size_t)(mr - 8192) * 1024;
      norm_row(src, MH + (size_t)mr * 1024);
    }
  }
}

__device__ __forceinline__ void phase1(const Params& P, u16* lds) {
  unsigned char* ws = P.ws;
  const u16* H = (const u16*)(ws + OFF_H);
  const u16* Win = (const u16*)(ws + OFF_WIN);
  u16* CQKV = (u16*)(ws + OFF_CQKV);
  u16* RW = (u16*)(ws + OFF_RW);
  u16* XQ = (u16*)(ws + OFF_XQ);
  for (int kk_ = 0;; kk_++) {
    int mt, nt;
    if (!tile_map(kk_, 768, 25, mt, nt)) break;
    Acc acc; acc_zero(acc);
    {
      int m0 = mt * 128, n0 = nt * 128;
      gemm_lin(acc, lds, H + (size_t)m0 * 1024, 1024, Win + (size_t)n0 * 1024, 1024, 1024);
      epi_each(acc, [&](int r0, int c, float v0, float v1, float v2, float v3) {
        int n = n0 + c;
        u16* dst; int ld;
        if (n < 640) { dst = CQKV + n; ld = 672; }
        else if (n < 2560) { dst = RW + (n - 640); ld = 1920; }
        else if (n < 3072) { dst = XQ + (n - 2560); ld = 512; }
        else if (n < 3104) { dst = CQKV + 640 + (n - 3072); ld = 672; }
        else return;
        store_bf16_pairs(dst + (size_t)(m0 + r0) * ld, ld, c, v0, v1, v2, v3);
      });
    }
  }
  for (int i2 = blockIdx.x; i2 < 72 * 8; i2 += gridDim.x) {
    Acc acc; acc_zero(acc);
    {
      int mt = i2 / 8, nt = i2 % 8;
      int m0 = mt * 128, n0 = nt * 128;
      gemm_lin(acc, lds, (const u16*)(ws + OFF_MH) + (size_t)m0 * 1024, 1024, (const u16*)(ws + OFF_WMKV) + (size_t)n0 * 1024, 1024, 1024);
      u16* MKV = (u16*)(ws + OFF_MKV);
      epi_each(acc, [&](int r0, int c, float v0, float v1, float v2, float v3) {
        u16* dst = MKV + (size_t)(m0 + r0) * 1024 + n0 + c;
        dst[0] = f2bf(v0); dst[1024] = f2bf(v1); dst[2048] = f2bf(v2); dst[3072] = f2bf(v3);
      });
    }
  }
}

__device__ __forceinline__ void phase2(const Params& P, u16* lds) {
  unsigned char* ws = P.ws;
  const u16* CQKV = (const u16*)(ws + OFF_CQKV);
  u16* Q = (u16*)((unsigned char*)P.out + DO_Q);
  u16* Kb = (u16*)((unsigned char*)P.out + DO_K);
  u16* Vt = (u16*)((unsigned char*)P.out + DO_VT);
  __shared__ float rstd_s[128];
  const int tid = threadIdx.x;
  for (int it = blockIdx.x; it < 768 * 14; it += gridDim.x) {
    int mt = it / 14, nt = it % 14;
    int m0 = mt * 128;
    const bool isq = nt < 6;
    {
      int r = tid >> 1, hf = tid & 1;
      const u16* src = CQKV + (size_t)(m0 + r) * 672 + (isq ? hf * 192 : 384 + hf * 128);
      int nch = isq ? 24 : 16;
      float ss = 0.f;
      for (int c = 0; c < nch; c++) {
        uint4 u = *(const uint4*)(src + c * 8);
        float a;
        a = bflo(u.x); ss += a * a; a = bfhi(u.x); ss += a * a;
        a = bflo(u.y); ss += a * a; a = bfhi(u.y); ss += a * a;
        a = bflo(u.z); ss += a * a; a = bfhi(u.z); ss += a * a;
        a = bflo(u.w); ss += a * a; a = bfhi(u.w); ss += a * a;
      }
      ss += dppf<0xB1>(ss);
      if (hf == 0) rstd_s[r] = rsqrtf(ss / (isq ? 384.f : 256.f) + 1e-6f);
    }
    __syncthreads();
    Acc acc; acc_zero(acc);
    if (isq) {
      int n0 = nt * 128;
      gemm_lin(acc, lds, CQKV + (size_t)m0 * 672, 672, (const u16*)(ws + OFF_WUQ) + (size_t)n0 * 384, 384, 384);
      epi_each(acc, [&](int r0, int c, float v0, float v1, float v2, float v3) {
        store_bf16_pairs(Q + (size_t)(m0 + r0) * 768 + n0 + c, 768, c, v0 * rstd_s[r0], v1 * rstd_s[r0 + 1],
                         v2 * rstd_s[r0 + 2], v3 * rstd_s[r0 + 3]);
      });
    } else {
      int head = nt - 6;
      int n0 = head * 128;
      gemm_lin(acc, lds, CQKV + (size_t)m0 * 672 + 384, 672, (const u16*)(ws + OFF_WUKV) + (size_t)n0 * 256, 256, 256);
      int seq, start, T;
      tok_seq(m0, seq, start, T);
      u16* vtb = Vt + vt_base(seq) + (size_t)head * 64 * T + (m0 - start);
      epi_each(acc, [&](int r0, int c, float v0, float v1, float v2, float v3) {
        v0 *= rstd_s[r0]; v1 *= rstd_s[r0 + 1]; v2 *= rstd_s[r0 + 2]; v3 *= rstd_s[r0 + 3];
        if (c < 64) {
          u16* dst = Kb + (size_t)(m0 + r0) * 768 + head * 96 + c;
          dst[0] = f2bf(v0); dst[768] = f2bf(v1); dst[1536] = f2bf(v2); dst[2304] = f2bf(v3);
        } else {
          uint2 o; o.x = pack2(v0, v1); o.y = pack2(v2, v3);
          *(uint2*)(vtb + (size_t)(c - 64) * T + r0) = o;
        }
      });
    }
    __syncthreads();
  }
}

__device__ __forceinline__ void phase3(const Params& P) {
  unsigned char* ws = P.ws;
  const u16* CQKV = (const u16*)(ws + OFF_CQKV);
  u16* Kb = (u16*)((unsigned char*)P.out + DO_K);
  const float* gk = P.in[11];
  const int tid = threadIdx.x;
  const int sub = tid >> 4, i = tid & 15;
  const float inv = powf(10000.f, -(float)i / 16.f);
  const float g0 = gk[4 * i], g1 = gk[4 * i + 1], g2 = gk[4 * i + 2], g3 = gk[4 * i + 3], gr1 = gk[64 + i], gr2 = gk[80 + i];
  for (long pr = (long)blockIdx.x * 16 + sub; pr < (long)NT * 8; pr += (long)gridDim.x * 16) {
    int tok = (int)(pr >> 3), head = (int)(pr & 7);
    u16* kp = Kb + (size_t)tok * 768 + head * 96;
    uint2 u = *(const uint2*)(kp + 4 * i);
    float a0 = bflo(u.x), a1 = bfhi(u.x), a2 = bflo(u.y), a3 = bfhi(u.y);
    float x1 = bf2f(CQKV[(size_t)tok * 672 + 640 + i]);
    float x2 = bf2f(CQKV[(size_t)tok * 672 + 656 + i]);
    float ss = a0 * a0 + a1 * a1 + a2 * a2 + a3 * a3 + x1 * x1 + x2 * x2;
    ss = sum16(ss);
    float r = rsqrtf(ss * (1.f / 96.f) + 1e-6f);
    int seq, start, T;
    tok_seq(tok, seq, start, T);
    float ang = (float)(tok - start) * inv;
    float sn, cs;
    sincosf(ang, &sn, &cs);
    x1 *= r * gr1; x2 *= r * gr2;
    uint2 o; o.x = pack2(a0 * r * g0, a1 * r * g1); o.y = pack2(a2 * r * g2, a3 * r * g3);
    *(uint2*)(kp + 4 * i) = o;
    kp[64 + i] = f2bf(x1 * cs - x2 * sn);
    kp[80 + i] = f2bf(x2 * cs + x1 * sn);
  }
  const u16* MKV = (const u16*)(ws + OFF_MKV);
  u16* MK = (u16*)(ws + OFF_MK);
  u16* MVT = (u16*)(ws + OFF_MVT);
  const float* gxk = P.in[33];
  for (int pr = blockIdx.x * 16 + sub; pr < NMEMROWS * 4; pr += gridDim.x * 16) {
    int row = pr >> 2, head = pr & 3;
    int b = row >> 8, key = row & 255;
    uint4 u = *(const uint4*)(MKV + (size_t)row * 1024 + head * 256 + 8 * i);
    float a0 = bflo(u.x), a1 = bfhi(u.x), a2 = bflo(u.y), a3 = bfhi(u.y), a4 = bflo(u.z), a5 = bfhi(u.z), a6 = bflo(u.w), a7 = bfhi(u.w);
    float ss = a0 * a0 + a1 * a1 + a2 * a2 + a3 * a3 + a4 * a4 + a5 * a5 + a6 * a6 + a7 * a7;
    ss = sum16(ss);
    float r = rsqrtf(ss * (1.f / 128.f) + 1e-6f);
    const float* g = gxk + 8 * i;
    uint4 o;
    o.x = pack2(a0 * r * g[0], a1 * r * g[1]); o.y = pack2(a2 * r * g[2], a3 * r * g[3]);
    o.z = pack2(a4 * r * g[4], a5 * r * g[5]); o.w = pack2(a6 * r * g[6], a7 * r * g[7]);
    *(uint4*)(MK + ((size_t)(b * 4 + head) * 256 + key) * 128 + 8 * i) = o;
  }
  for (long e = (long)blockIdx.x * NTHREADS + tid; e < (long)NMEMROWS * 512; e += (long)gridDim.x * NTHREADS) {
    int row = (int)(e >> 9), c = (int)(e & 511);
    int head = c >> 7, dv = c & 127;
    int b = row >> 8, key = row & 255;
    MVT[((size_t)(b * 4 + head) * 128 + dv) * 256 + key] = MKV[(size_t)row * 1024 + head * 256 + 128 + dv];
  }
}

template <int DQK, int DV, bool ROPE, bool PREF>
__device__ __forceinline__ void attn_item(u16* lds, const u16* Qp, long qld, const u16* Kp, long kld, const u16* Vtp, long vld,
                          int nkeys, const float* __restrict__ gq, float qscale, int tpos0, u16* Op, long old) {
  constexpr int KP = DQK + 8;
  constexpr int KT = 64 * KP;
  constexpr int VT = DV * 72;
  constexpr int BUF = KT + VT;
  constexpr int NS = DQK / 16;
  constexpr int ND = DV / 32;
  constexpr int KCH = DQK / 8;
  constexpr int NKC = 64 * KCH / 256;
  constexpr int NVC = DV * 8 / 256;
  const int tid = threadIdx.x, lane = tid & 63, wave = tid >> 6, h = lane >> 5, lr = lane & 31;

  bf16x8 qf[NS];
  {
    const u16* qp = Qp + (long)(32 * wave + lr) * qld + 8 * h;
    float qv[NS][8];
    float ss = 0.f;
#pragma unroll
    for (int s = 0; s < NS; s++) {
      uint4 u = *(const uint4*)(qp + 16 * s);
      qv[s][0] = bflo(u.x); qv[s][1] = bfhi(u.x); qv[s][2] = bflo(u.y); qv[s][3] = bfhi(u.y);
      qv[s][4] = bflo(u.z); qv[s][5] = bfhi(u.z); qv[s][6] = bflo(u.w); qv[s][7] = bfhi(u.w);
#pragma unroll
      for (int j = 0; j < 8; j++) ss += qv[s][j] * qv[s][j];
    }
    ss += __shfl_xor(ss, 32);
    float r = rsqrtf(ss * (1.f / DQK) + 1e-6f);
#pragma unroll
    for (int s = 0; s < NS; s++)
#pragma unroll
      for (int j = 0; j < 8; j++) qv[s][j] *= r * gq[16 * s + 8 * h + j];
    if (ROPE) {
      float t = (float)(tpos0 + 32 * wave + lr);
#pragma unroll
      for (int j = 0; j < 8; j++) {
        float inv = powf(10000.f, -(float)(8 * h + j) / 16.f);
        float sn, cs;
        sincosf(t * inv, &sn, &cs);
        float x1 = qv[NS - 2][j], x2 = qv[NS - 1][j];
        qv[NS - 2][j] = x1 * cs - x2 * sn;
        qv[NS - 1][j] = x2 * cs + x1 * sn;
      }
    }
#pragma unroll
    for (int s = 0; s < NS; s++) {
      uint4 u;
      u.x = pack2(qv[s][0] * qscale, qv[s][1] * qscale); u.y = pack2(qv[s][2] * qscale, qv[s][3] * qscale);
      u.z = pack2(qv[s][4] * qscale, qv[s][5] * qscale); u.w = pack2(qv[s][6] * qscale, qv[s][7] * qscale);
      qf[s] = *(bf16x8*)&u;
    }
  }

  f32x16 o[ND];
#pragma unroll
  for (int d = 0; d < ND; d++)
#pragma unroll
    for (int r = 0; r < 16; r++) o[d][r] = 0.f;
  float lsum = 0.f;

  uint4 rk[NKC], rv[NVC];
  const int nkt = nkeys >> 6;
#define AGLOAD(kt)                                                                           \
  {                                                                                          \
    _Pragma("unroll") for (int i = 0; i < NKC; i++) {                                        \
      int c = tid + 256 * i; int row = c / KCH, kc = c % KCH;                                \
      rk[i] = *(const uint4*)(Kp + (long)((kt) * 64 + row) * kld + kc * 8);                  \
    }                                                                                        \
    _Pragma("unroll") for (int i = 0; i < NVC; i++) {                                        \
      int c = tid + 256 * i; int row = c >> 3, kc = c & 7;                                   \
      rv[i] = *(const uint4*)(Vtp + (long)row * vld + (kt) * 64 + kc * 8);                   \
    }                                                                                        \
  }
#define ASTORE(b)                                                                            \
  {                                                                                          \
    u16* Kl = lds + (b) * BUF; u16* Vl = Kl + KT;                                            \
    _Pragma("unroll") for (int i = 0; i < NKC; i++) {                                        \
      int c = tid + 256 * i; int row = c / KCH, kc = c % KCH;                                \
      *(uint4*)(Kl + row * KP + kc * 8) = rk[i];                                             \
    }                                                                                        \
    _Pragma("unroll") for (int i = 0; i < NVC; i++) {                                        \
      int c = tid + 256 * i; int row = c >> 3, kc = c & 7;                                   \
      *(uint4*)(Vl + row * 72 + kc * 8) = rv[i];                                             \
    }                                                                                        \
  }
  AGLOAD(0)
  ASTORE(0)
  __syncthreads();
  for (int kt = 0; kt < nkt; kt++) {
    if (PREF) { if (kt + 1 < nkt) AGLOAD(kt + 1) }
    else { if (kt + 1 < nkt) { AGLOAD(kt + 1) ASTORE((kt + 1) & 1) } }
    const u16* Kl = lds + (kt & 1) * BUF;
    const u16* Vl = Kl + KT;
#pragma unroll
    for (int ks = 0; ks < 2; ks++) {
      f32x16 st;
#pragma unroll
      for (int r = 0; r < 16; r++) st[r] = 0.f;
      const u16* kr = Kl + (32 * ks + lr) * KP + 8 * h;
#pragma unroll
      for (int s = 0; s < NS; s++) {
        bf16x8 kf = *(const bf16x8*)(kr + 16 * s);
        st = __builtin_amdgcn_mfma_f32_32x32x16_bf16(kf, qf[s], st, 0, 0, 0);
      }
      float p[16];
#pragma unroll
      for (int r = 0; r < 16; r++) { p[r] = __builtin_amdgcn_exp2f(st[r]); lsum += p[r]; }
#pragma unroll
      for (int s2 = 0; s2 < 2; s2++) {
        uint4 u;
        u.x = pack2(p[8 * s2 + 0], p[8 * s2 + 1]); u.y = pack2(p[8 * s2 + 2], p[8 * s2 + 3]);
        u.z = pack2(p[8 * s2 + 4], p[8 * s2 + 5]); u.w = pack2(p[8 * s2 + 6], p[8 * s2 + 7]);
        bf16x8 pb = *(bf16x8*)&u;
#pragma unroll
        for (int d = 0; d < ND; d++) {
          const u16* vr = Vl + (32 * d + lr) * 72 + 32 * ks + 16 * s2 + 4 * h;
          uint2 v0 = *(const uint2*)(vr);
          uint2 v1 = *(const uint2*)(vr + 8);
          uint4 vv; vv.x = v0.x; vv.y = v0.y; vv.z = v1.x; vv.w = v1.y;
          bf16x8 vf = *(bf16x8*)&vv;
          o[d] = __builtin_amdgcn_mfma_f32_32x32x16_bf16(vf, pb, o[d], 0, 0, 0);
        }
      }
    }
    if (PREF) { if (kt + 1 < nkt) ASTORE((kt + 1) & 1) }
    __syncthreads();
  }
#undef AGLOAD
#undef ASTORE
  lsum += __shfl_xor(lsum, 32);
  float il = 1.f / lsum;
  u16* op = Op + (long)(32 * wave + lr) * old;
#pragma unroll
  for (int d = 0; d < ND; d++)
#pragma unroll
    for (int g = 0; g < 4; g++) {
      uint2 u;
      u.x = pack2(o[d][4 * g] * il, o[d][4 * g + 1] * il);
      u.y = pack2(o[d][4 * g + 2] * il, o[d][4 * g + 3] * il);
      *(uint2*)(op + 32 * d + 8 * g + 4 * h) = u;
    }
}

typedef __attribute__((ext_vector_type(2))) float f32x2;
constexpr int SC_OP = 2048;
constexpr int SC_WR = 0, SC_KK = SC_OP, SC_WD = 2 * SC_OP, SC_KD = 3 * SC_OP, SC_BB = 4 * SC_OP;
constexpr int SC_R = SC_WR, SC_K = SC_KK, SC_LW = SC_WD, SC_LA = SC_KD;
constexpr int SC_V = 5 * SC_OP, SC_BR = SC_V + 2048, SC_CKR = SC_BR + 32, SC_Y = SC_CKR + 32;
constexpr int SC_END = SC_Y + 2048;
constexpr int SC_TW_B = SC_END * 4;
constexpr int SC_AL_B = SC_TW_B + 32 * 72 * 2;
static_assert(SC_AL_B + 32 * 72 * 2 + 960 * 4 <= LDS_BYTES, "scan lds");

__device__ __forceinline__ float fexp(float x) { return __builtin_amdgcn_exp2f(x * 1.4426950408889634f); }
__device__ __forceinline__ float frcp(float x) { return __builtin_amdgcn_rcpf(x); }
__device__ __forceinline__ float ftanh(float x) { return 1.f - 2.f * frcp(1.f + fexp(2.f * x)); }
__device__ __forceinline__ float fsigm(float x) { return frcp(1.f + fexp(-x)); }

struct Raw3 { uint4 c, a, b; };
__device__ __forceinline__ Raw3 ld3(const u16* __restrict__ p, bool hp, bool hn) {
  Raw3 r;
  r.c = *(const uint4*)p;
  r.a = hp ? *(const uint4*)(p - 1920) : make_uint4(0, 0, 0, 0);
  r.b = hn ? *(const uint4*)(p + 1920) : make_uint4(0, 0, 0, 0);
  return r;
}
__device__ __forceinline__ void mixr(const Raw3& r, const float* __restrict__ mp, const float* __restrict__ mn, float* out) {
  float cc[8] = {bflo(r.c.x), bfhi(r.c.x), bflo(r.c.y), bfhi(r.c.y), bflo(r.c.z), bfhi(r.c.z), bflo(r.c.w), bfhi(r.c.w)};
  float aa[8] = {bflo(r.a.x), bfhi(r.a.x), bflo(r.a.y), bfhi(r.a.y), bflo(r.a.z), bfhi(r.a.z), bflo(r.a.w), bfhi(r.a.w)};
  float bb[8] = {bflo(r.b.x), bfhi(r.b.x), bflo(r.b.y), bfhi(r.b.y), bflo(r.b.z), bfhi(r.b.z), bflo(r.b.w), bfhi(r.b.w)};
#pragma unroll
  for (int j = 0; j < 8; j++) out[j] = cc[j] + mp[j] * (aa[j] - cc[j]) + mn[j] * (bb[j] - cc[j]);
}
__device__ __forceinline__ void mix8(const u16* __restrict__ p, bool hp, bool hn, const float* __restrict__ mp,
                                     const float* __restrict__ mn, float* out) {
  Raw3 r = ld3(p, hp, hn);
  mixr(r, mp, mn, out);
}

template <int NRG>
__device__ __forceinline__ void scan_item(const Params& P, unsigned char* ldsb, int seq, int head, int dir, int rg) {
  float* L = (float*)ldsb;
  u16* TWb = (u16*)(ldsb + SC_TW_B);
  u16* ALb = (u16*)(ldsb + SC_AL_B);
  unsigned char* ws = P.ws;
  const u16* RW = (const u16*)(ws + OFF_RW);
  u16* Y = (u16*)(ws + (dir ? OFF_YB : OFF_YF));
  const float* w0 = dir ? P.in[19] : P.in[15];
  const float* a0 = dir ? P.in[21] : P.in[17];
  const u16* w2t = (const u16*)(ws + (dir ? OFF_W2B : OFF_W2F));
  const u16* a2t = (const u16*)(ws + (dir ? OFF_A2B : OFF_A2F));
  const int T = seq < 32 ? 2048 : 8192;
  const int start = seq < 32 ? seq * 2048 : NTP + (seq - 32) * 8192;
  const int tid = threadIdx.x, lane = tid & 63, wave = tid >> 6;
  const int hc = head * 64;
  const int pt = tid >> 3, pc = (tid & 7) * 8;
  const int wlo = dir ? 1600 : 1536, alo = dir ? 1728 : 1664;
  float* CS = (float*)(ldsb + SC_AL_B + 32 * 72 * 2);
  for (int i = tid; i < 960; i += NTHREADS) {
    const int arr = i >> 6, c = i & 63;
    const float* src;
    switch (arr) {
      case 0: src = P.in[13] + hc; break;
      case 1: src = P.in[14] + hc; break;
      case 2: src = P.in[13] + 512 + hc; break;
      case 3: src = P.in[14] + 512 + hc; break;
      case 4: src = P.in[13] + 1024 + hc; break;
      case 5: src = P.in[14] + 1024 + hc; break;
      case 6: src = P.in[13] + wlo; break;
      case 7: src = P.in[14] + wlo; break;
      case 8: src = P.in[13] + alo; break;
      case 9: src = P.in[14] + alo; break;
      case 10: src = w0 + hc; break;
      case 11: src = a0 + hc; break;
      case 12: src = P.in[24] + hc; break;
      case 13: src = P.in[25] + hc; break;
      default: src = P.in[26] + hc; break;
    }
    CS[i] = src[c];
  }
  __syncthreads();
  const float *mpr = CS + pc, *mnr = CS + 64 + pc, *mpk = CS + 128 + pc, *mnk = CS + 192 + pc, *mpv = CS + 256 + pc,
              *mnv = CS + 320 + pc, *mpw = CS + 384 + pc, *mnw = CS + 448 + pc, *mpa = CS + 512 + pc, *mna = CS + 576 + pc,
              *cw0 = CS + 640 + pc, *ca0 = CS + 704 + pc, *ckk = CS + 768 + pc, *cka = CS + 832 + pc, *crk = CS + 896 + pc;
  const int rp = tid >> 3, seg = tid & 7;
  f32x2 st[8];
#pragma unroll
  for (int k = 0; k < 8; k++) st[k] = (f32x2){0.f, 0.f};
  const int nch = T >> 5;
  Raw3 g_r, g_k, g_v, g_w, g_a;
#define SLOAD(chn)                                                                     \
  {                                                                                    \
    const int t0_ = dir ? T - 32 * ((chn) + 1) : 32 * (chn);                           \
    const int t_ = t0_ + pt;                                                           \
    const bool hp_ = t_ > 0, hn_ = t_ < T - 1;                                         \
    const u16* base_ = RW + (size_t)(start + t_) * 1920;                               \
    g_r = ld3(base_ + hc + pc, hp_, hn_); g_k = ld3(base_ + 512 + hc + pc, hp_, hn_);  \
    g_v = ld3(base_ + 1024 + hc + pc, hp_, hn_); g_w = ld3(base_ + wlo + pc, hp_, hn_); \
    g_a = ld3(base_ + alo + pc, hp_, hn_);                                             \
  }
  SLOAD(0)
  for (int ch = 0; ch < nch; ch++) {
    const int t0 = dir ? T - 32 * (ch + 1) : 32 * ch;
    bf16x8 lb0, lb1, lb2, lb3;
    {
      const int mat = wave >> 1, ntile = wave & 1;
      const u16* Bsrc = (mat ? a2t : w2t) + (size_t)(hc + 32 * ntile + (lane & 31)) * 64 + 8 * (lane >> 5);
      lb0 = *(const bf16x8*)(Bsrc); lb1 = *(const bf16x8*)(Bsrc + 16); lb2 = *(const bf16x8*)(Bsrc + 32); lb3 = *(const bf16x8*)(Bsrc + 48);
    }
    {
      float v[8];
      mixr(g_r, mpr, mnr, v);
#pragma unroll
      for (int j = 0; j < 8; j++) L[SC_R + pt * 64 + pc + j] = v[j];
      mixr(g_k, mpk, mnk, v);
#pragma unroll
      for (int j = 0; j < 8; j++) L[SC_K + pt * 64 + pc + j] = v[j];
      mixr(g_v, mpv, mnv, v);
#pragma unroll
      for (int j = 0; j < 8; j++) L[SC_V + pt * 64 + pc + j] = v[j];
      mixr(g_w, mpw, mnw, v);
      uint4 u;
      u.x = pack2(ftanh(v[0]), ftanh(v[1])); u.y = pack2(ftanh(v[2]), ftanh(v[3]));
      u.z = pack2(ftanh(v[4]), ftanh(v[5])); u.w = pack2(ftanh(v[6]), ftanh(v[7]));
      *(uint4*)(TWb + pt * 72 + pc) = u;
      mixr(g_a, mpa, mna, v);
      u.x = pack2(v[0], v[1]); u.y = pack2(v[2], v[3]); u.z = pack2(v[4], v[5]); u.w = pack2(v[6], v[7]);
      *(uint4*)(ALb + pt * 72 + pc) = u;
    }
    __syncthreads();
    {
      const int mat = wave >> 1, ntile = wave & 1;
      const u16* Asrc = (mat ? ALb : TWb) + (lane & 31) * 72 + 8 * (lane >> 5);
      f32x16 c;
#pragma unroll
      for (int r = 0; r < 16; r++) c[r] = 0.f;
      c = __builtin_amdgcn_mfma_f32_32x32x16_bf16(*(const bf16x8*)(Asrc), lb0, c, 0, 0, 0);
      c = __builtin_amdgcn_mfma_f32_32x32x16_bf16(*(const bf16x8*)(Asrc + 16), lb1, c, 0, 0, 0);
      c = __builtin_amdgcn_mfma_f32_32x32x16_bf16(*(const bf16x8*)(Asrc + 32), lb2, c, 0, 0, 0);
      c = __builtin_amdgcn_mfma_f32_32x32x16_bf16(*(const bf16x8*)(Asrc + 48), lb3, c, 0, 0, 0);
      float* dst = L + (mat ? SC_LA : SC_LW);
#pragma unroll
      for (int r = 0; r < 16; r++) {
        int tr = (r & 3) + 8 * (r >> 2) + 4 * (lane >> 5);
        dst[tr * 64 + 32 * ntile + (lane & 31)] = c[r];
      }
    }
    __syncthreads();
    {
      float ssk = 0.f, br = 0.f, kr = 0.f, bon = 0.f;
      float kkr[8], av[8], kdv[8], rr[8], dec[8];
#pragma unroll
      for (int j = 0; j < 8; j++) {
        int o = pt * 64 + pc + j;
        float r = L[SC_R + o], k = L[SC_K + o];
        float wp = cw0[j] + L[SC_LW + o];
        float z = -wp;
        float sp = z > 15.f ? z : 0.6931471805599453f * __builtin_amdgcn_logf(1.f + fexp(z));
        float w = -sp - 0.5f;
        dec[j] = fexp(-fexp(w));
        float a = fsigm(ca0[j] + L[SC_LA + o]);
        av[j] = a;
        kkr[j] = k * ckk[j];
        ssk += kkr[j] * kkr[j];
        kdv[j] = k * (1.f + (a - 1.f) * cka[j]);
        rr[j] = r;
        kr += kdv[j] * r;
        bon += r * kdv[j] * crk[j];
      }
      ssk = sum8(ssk);
      float inrm = __builtin_amdgcn_rsqf(fmaxf(ssk, 1e-24f));
#pragma unroll
      for (int j = 0; j < 8; j++) {
        float kk = kkr[j] * inrm;
        float b = kk * av[j];
        br += b * rr[j];
        int o = pt * 64 + pc + j;
        L[SC_KK + o] = kk;
        L[SC_BB + o] = b;
        L[SC_WR + o] = dec[j] * rr[j];
        L[SC_WD + o] = dec[j];
        L[SC_KD + o] = kdv[j];
      }
      br = sum8(br); kr = sum8(kr); bon = sum8(bon);
      if ((tid & 7) == 0) { L[SC_BR + pt] = br; L[SC_CKR + pt] = kr + bon; }
    }
    __syncthreads();
    if (ch + 1 < nch) SLOAD(ch + 1)
    {
#pragma unroll 1
      for (int qo = 0; qo < 4; qo++) {
        f32x2 yk = (f32x2){0.f, 0.f};
#pragma unroll
        for (int qi = 0; qi < 8; qi++) {
          const int q = qo * 8 + qi;
          const int tt = dir ? 31 - q : q;
          const float* ob = L + tt * 64 + 8 * seg;
          float4 kka = *(const float4*)(ob + SC_KK), kkb = *(const float4*)(ob + SC_KK + 4);
          float4 wra = *(const float4*)(ob + SC_WR), wrb = *(const float4*)(ob + SC_WR + 4);
          float4 wda = *(const float4*)(ob + SC_WD), wdb = *(const float4*)(ob + SC_WD + 4);
          float4 bba = *(const float4*)(ob + SC_BB), bbb = *(const float4*)(ob + SC_BB + 4);
          float4 kda = *(const float4*)(ob + SC_KD), kdb = *(const float4*)(ob + SC_KD + 4);
          float br = L[SC_BR + tt], ckr = L[SC_CKR + tt];
          float kk[8] = {kka.x, kka.y, kka.z, kka.w, kkb.x, kkb.y, kkb.z, kkb.w};
          float wr[8] = {wra.x, wra.y, wra.z, wra.w, wrb.x, wrb.y, wrb.z, wrb.w};
          float wd[8] = {wda.x, wda.y, wda.z, wda.w, wdb.x, wdb.y, wdb.z, wdb.w};
          float bb[8] = {bba.x, bba.y, bba.z, bba.w, bbb.x, bbb.y, bbb.z, bbb.w};
          float kd[8] = {kda.x, kda.y, kda.z, kda.w, kdb.x, kdb.y, kdb.z, kdb.w};
          if (NRG == 1) {
            float2 vv = *(const float2*)(L + SC_V + tt * 64 + 2 * rp);
            f32x2 v2 = (f32x2){vv.x, vv.y};
            f32x2 p1 = st[0] * kk[0], p2 = st[0] * wr[0];
#pragma unroll
            for (int k = 1; k < 8; k++) { p1 += st[k] * kk[k]; p2 += st[k] * wr[k]; }
            p1.x = sum8(p1.x); p1.y = sum8(p1.y); p2.x = sum8(p2.x); p2.y = sum8(p2.y);
            f32x2 y2 = p2 - p1 * br + v2 * ckr;
            if (qi == seg) yk = y2;
#pragma unroll
            for (int k = 0; k < 8; k++) st[k] = st[k] * wd[k] - p1 * bb[k] + v2 * kd[k];
          } else {
            const float v = L[SC_V + tt * 64 + 32 * rg + rp];
            f32x2 q1 = st[0] * (f32x2){kk[0], kk[1]}, q2 = st[0] * (f32x2){wr[0], wr[1]};
#pragma unroll
            for (int i = 1; i < 4; i++) {
              q1 += st[i] * (f32x2){kk[2 * i], kk[2 * i + 1]};
              q2 += st[i] * (f32x2){wr[2 * i], wr[2 * i + 1]};
            }
            const float p1 = sum8(q1.x + q1.y), p2 = sum8(q2.x + q2.y);
            const float y = p2 - p1 * br + v * ckr;
            if (qi == seg) yk.x = y;
#pragma unroll
            for (int i = 0; i < 4; i++)
              st[i] = st[i] * (f32x2){wd[2 * i], wd[2 * i + 1]} - p1 * (f32x2){bb[2 * i], bb[2 * i + 1]} + v * (f32x2){kd[2 * i], kd[2 * i + 1]};
          }
        }
        {
          const int q = qo * 8 + seg;
          const int tt = dir ? 31 - q : q;
          if (NRG == 1) *(float2*)(L + SC_Y + tt * 64 + 2 * rp) = make_float2(yk.x, yk.y);
          else L[SC_Y + tt * 64 + 32 * rg + rp] = yk.x;
        }
      }
    }
    __syncthreads();
    if (NRG == 1 || (pc >> 5) == rg) {
      const float* yp = L + SC_Y + pt * 64 + pc;
      uint4 u;
      u.x = pack2(yp[0], yp[1]); u.y = pack2(yp[2], yp[3]); u.z = pack2(yp[4], yp[5]); u.w = pack2(yp[6], yp[7]);
      *(uint4*)(Y + (size_t)(start + t0 + pt) * 512 + hc + pc) = u;
    }
  }
#undef SLOAD
}

__device__ __forceinline__ void phase4(const Params& P, unsigned char* ldsb) {
  __shared__ int s_item;
  unsigned* ctr = (unsigned*)(P.ws + OFF_CTL);
  u16* lds = (u16*)ldsb;
  u16* Q = (u16*)((unsigned char*)P.out + DO_Q);
  const u16* Kb = (const u16*)((unsigned char*)P.out + DO_K);
  const u16* Vt = (const u16*)((unsigned char*)P.out + DO_VT);
  u16* XQ = (u16*)(P.ws + OFF_XQ);
  const u16* MK = (const u16*)(P.ws + OFF_MK);
  const u16* MVT = (const u16*)(P.ws + OFF_MVT);
  const int total = 576 + 6144;
  const float LOG2E = 1.4426950408889634f;
  while (true) {
    __syncthreads();
    if (threadIdx.x == 0) s_item = (int)atomicAdd(ctr, 1u);
    __syncthreads();
    const int q = s_item;
    if (q >= total) break;
    int kind, idx;
    if (q < 576) { kind = 1; idx = q; }
    else if (q < 576 + 2048) { kind = 2; idx = q - 576; }
    else { kind = 3; idx = q - 2624; }
    if (kind == 1) {
      int i2 = idx < 64 ? idx : idx - 64;
      int dir = i2 & 1, head = (i2 >> 1) & 7, sl = i2 >> 4;
      scan_item<1>(P, ldsb, idx < 64 ? 32 + sl : sl, head, dir, 0);
    } else if (kind <= 3) {
      int seq, head, qb, T, start;
      if (kind == 2) { seq = 32 + (idx >> 9); head = (idx >> 6) & 7; qb = idx & 63; T = 8192; start = NTP + (seq - 32) * 8192; }
      else { seq = idx >> 7; head = (idx >> 4) & 7; qb = idx & 15; T = 2048; start = seq * 2048; }
      const size_t tok0 = (size_t)start + qb * 128;
      attn_item<96, 64, true, true>(lds, Q + tok0 * 768 + head * 96, 768, Kb + (size_t)start * 768 + head * 96, 768,
                              Vt + vt_base(seq) + (size_t)head * 64 * T, T, T, P.in[10],
                              0.10206207261596577f * LOG2E, qb * 128, Q + tok0 * 768 + head * 96, 768);
    }
  }
#ifdef SCANREP
  __syncthreads();
  for (int idx = blockIdx.x; idx < 576; idx += gridDim.x) {
    int dir = idx & 1, head = (idx >> 1) & 7, sl = idx >> 4;
    __syncthreads();
    scan_item<1>(P, ldsb, sl, head, dir, 0);
  }
#endif
  __syncthreads();
  unsigned* ctr2 = (unsigned*)(P.ws + OFF_CTL) + 16;
  while (true) {
    __syncthreads();
    if (threadIdx.x == 0) s_item = (int)atomicAdd(ctr2, 1u);
    __syncthreads();
    const int idx = s_item;
    if (idx >= 3072) break;
    int mt = idx >> 2, head = idx & 3;
    int seq, start, T;
    tok_seq(mt * 128, seq, start, T);
    const size_t tok0 = (size_t)mt * 128;
    attn_item<128, 128, false, false>(lds, XQ + tok0 * 512 + head * 128, 512, MK + (size_t)(seq * 4 + head) * 256 * 128, 128,
                                      MVT + (size_t)(seq * 4 + head) * 128 * 256, 256, 256, P.in[32],
                                      0.08838834764831845f * LOG2E, 0, XQ + tok0 * 512 + head * 128, 512);
  }
}

__device__ __forceinline__ void phase5(const Params& P, u16* lds) {
  __shared__ float st_mean[256], st_rstd[256];
  unsigned char* ws = P.ws;
  const u16* RW = (const u16*)(ws + OFF_RW);
  const u16* YF = (const u16*)(ws + OFF_YF);
  u16* YB = (u16*)(ws + OFF_YB);
  const u16* G2 = (const u16*)(ws + OFF_G2);
  const float* mup = P.in[13] + 1792;
  const float* mun = P.in[14] + 1792;
  const float* lng = P.in[27];
  const float* lnb = P.in[28];
  const int tid = threadIdx.x;
  for (int it = blockIdx.x; it < 768 * 4; it += gridDim.x) {
    int mt = it >> 2, nt = it & 3;
    int m0 = mt * 128, n0 = nt * 128;
    int seq, start, T;
    tok_seq(m0, seq, start, T);
    {
      int r = tid >> 1, hh = tid & 1;
      const u16* pf = YF + (size_t)(m0 + r) * 512 + n0 + hh * 64;
      const u16* pb = YB + (size_t)(m0 + r) * 512 + n0 + hh * 64;
      float sm = 0.f, sq = 0.f;
      for (int c = 0; c < 8; c++) {
        uint4 a = *(const uint4*)(pf + 8 * c), b = *(const uint4*)(pb + 8 * c);
        float y;
        y = bflo(a.x) + bflo(b.x); sm += y; sq += y * y; y = bfhi(a.x) + bfhi(b.x); sm += y; sq += y * y;
        y = bflo(a.y) + bflo(b.y); sm += y; sq += y * y; y = bfhi(a.y) + bfhi(b.y); sm += y; sq += y * y;
        y = bflo(a.z) + bflo(b.z); sm += y; sq += y * y; y = bfhi(a.z) + bfhi(b.z); sm += y; sq += y * y;
        y = bflo(a.w) + bflo(b.w); sm += y; sq += y * y; y = bfhi(a.w) + bfhi(b.w); sm += y; sq += y * y;
      }
      float mean = sm * (1.f / 64.f);
      float var = fmaxf(sq * (1.f / 64.f) - mean * mean, 0.f);
      st_mean[tid] = mean;
      st_rstd[tid] = rsqrtf(var + 64e-5f);
    }
    {
      const int lr = tid >> 3, lk = (tid & 7) * 8;
#pragma unroll
      for (int kb = 0; kb < 2; kb++) {
#pragma unroll
        for (int i = 0; i < 4; i++) {
          int r = lr + 32 * i;
          int t = m0 + r - start;
          float v[8];
          mix8(RW + (size_t)(m0 + r) * 1920 + 1792 + kb * 64 + lk, t > 0, t < T - 1, mup + kb * 64 + lk, mun + kb * 64 + lk, v);
          uint4 u;
          u.x = pack2(sigmoidf_(v[0]), sigmoidf_(v[1])); u.y = pack2(sigmoidf_(v[2]), sigmoidf_(v[3]));
          u.z = pack2(sigmoidf_(v[4]), sigmoidf_(v[5])); u.w = pack2(sigmoidf_(v[6]), sigmoidf_(v[7]));
          *(uint4*)(lds + kb * (2 * LTILE) + r * LROW + lk) = u;
          *(uint4*)(lds + kb * (2 * LTILE) + LTILE + r * LROW + lk) = *(const uint4*)(G2 + (size_t)(n0 + r) * 128 + kb * 64 + lk);
        }
      }
    }
    __syncthreads();
    Acc acc; acc_zero(acc);
    gemm_compute(acc, lds, 0);
    gemm_compute(acc, lds, 1);
    epi_each(acc, [&](int r0, int c, float v0, float v1, float v2, float v3) {
      int hh = c >> 6;
      float g = lng[n0 + c], b = lnb[n0 + c];
      float vv[4] = {v0, v1, v2, v3};
#pragma unroll
      for (int k = 0; k < 4; k++) {
        size_t o = (size_t)(m0 + r0 + k) * 512 + n0 + c;
        float y = bf2f(YF[o]) + bf2f(YB[o]);
        int si = (r0 + k) * 2 + hh;
        float yn = (y - st_mean[si]) * st_rstd[si] * g + b;
        YB[o] = f2bf(yn * vv[k]);
      }
    });
    __syncthreads();
  }
}

__device__ __forceinline__ void merge_branch(Acc& mg, u16* lds, const u16* Hrow, const u16* Wg_rows, const u16* Abr,
                                             const u16* Wbr, int Kb) {
  unsigned* G = (unsigned*)(lds + 2 * LTILE);
  {
    Acc acc; acc_zero(acc);
    gemm_lin<false, false>(acc, lds, Hrow, 1024, Wg_rows, 1024, 1024);
#pragma unroll
    for (int i = 0; i < 2; i++)
#pragma unroll
      for (int j = 0; j < 2; j++)
#pragma unroll
        for (int r = 0; r < 8; r++)
          G[((i * 2 + j) * 8 + r) * 256 + threadIdx.x] = pack2(sigmoidf_(acc.a[i][j][2 * r]), sigmoidf_(acc.a[i][j][2 * r + 1]));
  }
  Acc acc; acc_zero(acc);
  gemm_lin<true, false>(acc, lds, Abr, Kb, Wbr, Kb, Kb);
#pragma unroll
  for (int i = 0; i < 2; i++)
#pragma unroll
    for (int j = 0; j < 2; j++)
#pragma unroll
      for (int r = 0; r < 8; r++) {
        unsigned g = G[((i * 2 + j) * 8 + r) * 256 + threadIdx.x];
        mg.a[i][j][2 * r] += bflo(g) * acc.a[i][j][2 * r];
        mg.a[i][j][2 * r + 1] += bfhi(g) * acc.a[i][j][2 * r + 1];
      }
  __syncthreads();
}
__device__ __forceinline__ void phase6(const Params& P, u16* lds) {
  unsigned char* ws = P.ws;
  const u16* H = (const u16*)(ws + OFF_H);
  const u16* Wg = (const u16*)(ws + OFF_WIN) + (size_t)3200 * 1024;
  u16* MG = (u16*)(ws + OFF_MERGED);
  const u16* A0 = (const u16*)((unsigned char*)P.out + DO_Q);
  const u16* A1 = (const u16*)(ws + OFF_YB);
  const u16* A2 = (const u16*)(ws + OFF_XQ);
  const u16* W0 = (const u16*)(ws + OFF_WOA);
  const u16* W1 = (const u16*)(ws + OFF_WOB);
  const u16* W2 = (const u16*)(ws + OFF_WOC);
  for (int kk_ = 0;; kk_++) {
    int mt, nt;
    if (!tile_map(kk_, 768, 8, mt, nt)) break;
    int m0 = mt * 128, n0 = nt * 128;
    Acc mg; acc_zero(mg);
    const u16* Hrow = H + (size_t)m0 * 1024;
#pragma nounroll
    for (int br = 0; br < 3; br++) {
      const u16* Ab = br == 0 ? A0 + (size_t)m0 * 768 : (br == 1 ? A1 + (size_t)m0 * 512 : A2 + (size_t)m0 * 512);
      const u16* Wb = br == 0 ? W0 + (size_t)n0 * 768 : (br == 1 ? W1 + (size_t)n0 * 512 : W2 + (size_t)n0 * 512);
      merge_branch(mg, lds, Hrow, Wg + (size_t)(br * 1024 + n0) * 1024, Ab, Wb, br == 0 ? 768 : 512);
    }
    epi_each(mg, [&](int r0, int c, float v0, float v1, float v2, float v3) {
      store_bf16_pairs(MG + (size_t)(m0 + r0) * 1024 + n0 + c, 1024, c, v0, v1, v2, v3);
    });
  }
}

__device__ __forceinline__ void phase7(const Params& P, u16* lds) {
  __shared__ float rs_s[128];
  unsigned char* ws = P.ws;
  const u16* MG = (const u16*)(ws + OFF_MERGED);
  const u16* W = (const u16*)(ws + OFF_WOUT);
  u16* HB = (u16*)(ws + OFF_H);
  float* RS = (float*)(ws + OFF_RS);
  const int tid = threadIdx.x, lane = tid & 63;
  for (int kk_ = 0;; kk_++) {
    int mt, nt;
    if (!tile_map(kk_, 768, 8, mt, nt)) break;
    int m0 = mt * 128, n0 = nt * 128;
    if (tid < 128) rs_s[tid] = 0.f;
    Acc acc; acc_zero(acc);
    gemm_lin(acc, lds, MG + (size_t)m0 * 1024, 1024, W + (size_t)n0 * 1024, 1024, 1024);
    const float* xin = m0 < NTP ? P.in[0] + (size_t)m0 * 1024 : P.in[1] + (size_t)(m0 - NTP) * 1024;
    float* xo = P.out + (size_t)m0 * 1024;
    epi_each(acc, [&](int r0, int c, float v0, float v1, float v2, float v3) {
      size_t o = (size_t)r0 * 1024 + n0 + c;
      const float y0 = xin[o] + v0, y1 = xin[o + 1024] + v1, y2 = xin[o + 2048] + v2, y3 = xin[o + 3072] + v3;
      xo[o] = y0; xo[o + 1024] = y1; xo[o + 2048] = y2; xo[o + 3072] = y3;
      store_bf16_pairs(HB + (size_t)(m0 + r0) * 1024 + n0 + c, 1024, c, y0, y1, y2, y3);
      const float s0 = sum16(y0 * y0), s1 = sum16(y1 * y1), s2 = sum16(y2 * y2), s3 = sum16(y3 * y3);
      if ((lane & 15) == 0) {
        atomicAdd(&rs_s[r0], s0); atomicAdd(&rs_s[r0 + 1], s1); atomicAdd(&rs_s[r0 + 2], s2); atomicAdd(&rs_s[r0 + 3], s3);
      }
    });
    __syncthreads();
    if (tid < 128) atomicAdd(&RS[m0 + tid], rs_s[tid]);
    __syncthreads();
  }
}

__device__ __forceinline__ void phase8(const Params& P) {
  const int wave = threadIdx.x >> 6;
  u16* H = (u16*)(P.ws + OFF_H);
  for (int row = blockIdx.x * 4 + wave; row < NT; row += gridDim.x * 4)
    norm_row(P.out + (size_t)row * 1024, H + (size_t)row * 1024);
}

__device__ __forceinline__ float erf_as(float x) {
  const float ax = fabsf(x);
  const float t = __builtin_amdgcn_rcpf(1.f + 0.3275911f * ax);
  const float y = ((((1.061405429f * t - 1.453152027f) * t + 1.421413741f) * t - 0.284496736f) * t + 0.254829592f) * t;
  const float r = 1.f - y * __builtin_amdgcn_exp2f(-ax * ax * 1.4426950408889634f);
  return copysignf(r, x);
}
__device__ __forceinline__ void phase9(const Params& P, u16* lds) {
  unsigned char* ws = P.ws;
  const u16* H = (const u16*)(ws + OFF_H);
  const u16* W = (const u16*)(ws + OFF_WUP);
  u16* ACT = (u16*)(ws + OFF_ACT);
  const float* cw = P.in[38];
  const float* cb = P.in[39];
  float* Lf = (float*)lds;
  __shared__ float rstd9[128];
  const float* RS = (const float*)(ws + OFF_RS);
  const int tid = threadIdx.x, lane = tid & 63, wave = tid >> 6, wm = wave >> 1, wn = wave & 1;
  for (int kk_ = 0;; kk_++) {
    int mt, nt;
    if (!tile_map(kk_, 808, 44, mt, nt)) break;
    int start, T, ti;
    if (mt < 544) { int s = mt / 17; ti = mt % 17; start = s * 2048; T = 2048; }
    else { int m2 = mt - 544; int s = m2 / 66; ti = m2 % 66; start = NTP + s * 8192; T = 8192; }
    const int p0 = 126 * ti - 1;
    const int lr = tid >> 3;
    const u16* pa[4];
#pragma unroll
    for (int i = 0; i < 4; i++) {
      int p = p0 + lr + 32 * i;
      p = p < 0 ? 0 : (p > T - 1 ? T - 1 : p);
      pa[i] = H + (size_t)(start + p) * 1024;
    }
    const u16* Bt = W + (size_t)nt * 128 * 1024;
    if (tid < 128) {
      int p = p0 + tid;
      p = p < 0 ? 0 : (p > T - 1 ? T - 1 : p);
      rstd9[tid] = rsqrtf(RS[start + p] * (1.f / 1024.f) + 1e-6f);
    }
    Acc acc; acc_zero(acc);
    gemm_main(acc, lds, pa[0], pa[1], pa[2], pa[3], Bt + (size_t)lr * 1024, Bt + (size_t)(lr + 32) * 1024,
              Bt + (size_t)(lr + 64) * 1024, Bt + (size_t)(lr + 96) * 1024, 1024);
    {
      float* dst = Lf + wn * 8192;
#pragma unroll
      for (int i = 0; i < 2; i++)
#pragma unroll
        for (int j = 0; j < 2; j++)
#pragma unroll
          for (int r = 0; r < 16; r++) {
            int rr = 64 * wm + 32 * i + (r & 3) + 8 * (r >> 2) + 4 * (lane >> 5);
            dst[rr * 64 + 32 * j + (lane & 31)] = acc.a[i][j][r] * rstd9[rr];
          }
    }
    __syncthreads();
    {
      const int c = tid & 63, rgp = tid >> 6;
      const int col = nt * 64 + c;
      const float w0 = cw[col], w1 = cw[2816 + col], w2 = cw[2 * 2816 + col], bb = cb[col];
      int rbeg = rgp * 32; if (rbeg < 1) rbeg = 1;
      int rend = rgp * 32 + 32; if (rend > 127) rend = 127;
      auto gval = [&](int r) { int p = p0 + r; return (p >= 0 && p < T) ? Lf[r * 64 + c] : 0.f; };
      float gp = gval(rbeg - 1), gc = gval(rbeg);
      for (int r = rbeg; r < rend; r++) {
        float gn = gval(r + 1);
        int p = p0 + r;
        if (p < T) {
          float cc = w0 * gp + w1 * gc + w2 * gn + bb;
          float a = 0.5f * cc * (1.f + erf_as(cc * 0.70710678118654752f)) * Lf[8192 + r * 64 + c];
          ACT[(size_t)(start + p) * 2816 + col] = f2bf(a);
        }
        gp = gc; gc = gn;
      }
    }
    __syncthreads();
  }
}

__device__ __forceinline__ void phase10(const Params& P, u16* lds) {
  unsigned char* ws = P.ws;
  const u16* ACT = (const u16*)(ws + OFF_ACT);
  const u16* W = (const u16*)(ws + OFF_WDOWN);
  for (int kk_ = 0;; kk_++) {
    int mt, nt;
    if (!tile_map(kk_, 768, 8, mt, nt)) break;
    int m0 = mt * 128, n0 = nt * 128;
    Acc acc; acc_zero(acc);
    gemm_lin(acc, lds, ACT + (size_t)m0 * 2816, 2816, W + (size_t)n0 * 2816, 2816, 2816);
    float* xo = P.out + (size_t)m0 * 1024;
    epi_each(acc, [&](int r0, int c, float v0, float v1, float v2, float v3) {
      size_t o = (size_t)r0 * 1024 + n0 + c;
      xo[o] += v0; xo[o + 1024] += v1; xo[o + 2048] += v2; xo[o + 3072] += v3;
    });
  }
}

constexpr int NPHASE = 11;
__global__ void __launch_bounds__(NTHREADS, 2) fwd_kernel(Params P) {
  extern __shared__ __attribute__((aligned(16))) unsigned char dlds[];
  cg::grid_group grid = cg::this_grid();
  u16* lds = (u16*)dlds;
#ifndef REPMASK
#define REPMASK 0
#endif
#define PH(k, call)                                   \
  if (P.lo <= (k) && (k) < P.hi) {                    \
    call;                                             \
    if ((REPMASK >> (k)) & 1) { grid.sync(); call; }  \
    if ((k) + 1 < P.hi) grid.sync();                  \
  }
  PH(0, (phase0(P), phase0b(P)))
  PH(1, phase1(P, lds))
  PH(2, phase2(P, lds))
  PH(3, phase3(P))
  PH(4, phase4(P, dlds))
  PH(5, phase5(P, lds))
  PH(6, phase6(P, lds))
  PH(7, phase7(P, lds))
  PH(9, phase9(P, lds))
  PH(10, phase10(P, lds))
#undef PH
}

extern "C" void kernel_launch(void* const* d_in, const int* in_sizes, int n_in, void* d_out, int out_size, void* d_ws,
                              size_t ws_size, hipStream_t stream) {
  static int grid_blocks = 0;
  if (!grid_blocks) {
    int dev = 0, cus = 0, per_cu = 0;
    hipGetDevice(&dev);
    hipDeviceGetAttribute(&cus, hipDeviceAttributeMultiprocessorCount, dev);
    hipFuncSetAttribute((const void*)fwd_kernel, hipFuncAttributeMaxDynamicSharedMemorySize, LDS_BYTES);
    hipOccupancyMaxActiveBlocksPerMultiprocessor(&per_cu, (const void*)fwd_kernel, NTHREADS, LDS_BYTES);
    if (per_cu < 1) per_cu = 1;
    if (per_cu > 2) per_cu = 2;
    grid_blocks = cus * per_cu;
    if (ws_size < WS_END) fprintf(stderr, "workspace too small: %zu < %zu\n", ws_size, (size_t)WS_END);
  }
  if (ws_size < WS_END) return;
  Params p{};
  for (int i = 0; i < 41; i++) p.in[i] = (const float*)d_in[i];
  p.out = (float*)d_out;
  p.ws = (unsigned char*)d_ws;
#if MEGA
  p.lo = 0; p.hi = NPHASE;
  void* args[] = {&p};
  hipError_t e = hipLaunchCooperativeKernel((const void*)fwd_kernel, dim3(grid_blocks), dim3(NTHREADS), args, LDS_BYTES, stream);
  if (e != hipSuccess) fprintf(stderr, "cooperative launch failed: %s (grid %d)\n", hipGetErrorString(e), grid_blocks);
#else
#ifndef PHMAX
#define PHMAX 11
#endif
  for (int k = 0; k < PHMAX; k++) {
    p.lo = k; p.hi = k + 1;
    hipLaunchKernelGGL(fwd_kernel, dim3(grid_blocks), dim3(NTHREADS), LDS_BYTES, stream, p);
  }
#endif
}
```

```cpp
#include <hip/hip_runtime.h>
#include <hip/hip_cooperative_groups.h>
#include <cstdio>
#include <cstdint>
namespace cg = cooperative_groups;

typedef unsigned short u16;
typedef __attribute__((ext_vector_type(8))) short bf16x8;
typedef __attribute__((ext_vector_type(16))) float f32x16;

#ifndef MEGA
#define MEGA 1
#endif

constexpr int NT = 98304;
constexpr int NTP = 65536;
constexpr int NMEMROWS = 9216;
constexpr int NTHREADS = 256;
constexpr int LDS_BYTES = 73728;

constexpr size_t OFF_CTL = 0;
constexpr size_t OFF_WIN = 4096;
constexpr size_t OFF_WUQ = OFF_WIN + (size_t)6272 * 1024 * 2;
constexpr size_t OFF_WUKV = OFF_WUQ + (size_t)768 * 384 * 2;
constexpr size_t OFF_WOA = OFF_WUKV + (size_t)1024 * 256 * 2;
constexpr size_t OFF_WOB = OFF_WOA + (size_t)1024 * 768 * 2;
constexpr size_t OFF_WOC = OFF_WOB + (size_t)1024 * 512 * 2;
constexpr size_t OFF_WMKV = OFF_WOC + (size_t)1024 * 512 * 2;
constexpr size_t OFF_WOUT = OFF_WMKV + (size_t)2048 * 1024 * 2;
constexpr size_t OFF_WUP = OFF_WOUT + (size_t)1024 * 1024 * 2;
constexpr size_t OFF_WDOWN = OFF_WUP + (size_t)5632 * 1024 * 2;
constexpr size_t OFF_G2 = OFF_WDOWN + (size_t)1024 * 2816 * 2;
constexpr size_t OFF_W2F = OFF_G2 + (size_t)512 * 128 * 2;
constexpr size_t OFF_W2B = OFF_W2F + 65536;
constexpr size_t OFF_A2F = OFF_W2B + 65536;
constexpr size_t OFF_A2B = OFF_A2F + 65536;
constexpr size_t OFF_RS = OFF_A2B + 65536;
constexpr size_t OFF_H = 50331648;
static_assert(OFF_RS + (size_t)NT * 4 <= OFF_H, "rs");
constexpr size_t OFF_CQKV = OFF_H + (size_t)NT * 1024 * 2;
constexpr size_t OFF_RW = OFF_CQKV + (size_t)NT * 672 * 2;
constexpr size_t OFF_XQ = OFF_RW + (size_t)NT * 1920 * 2;
constexpr size_t OFF_MH = OFF_XQ + (size_t)NT * 512 * 2;
constexpr size_t OFF_MKV = OFF_MH + (size_t)NMEMROWS * 1024 * 2;
constexpr size_t OFF_MK = OFF_MKV + (size_t)NMEMROWS * 2048 * 2;
constexpr size_t OFF_MVT = OFF_MK + (size_t)NMEMROWS * 512 * 2;
constexpr size_t OFF_YB = OFF_MVT + (size_t)NMEMROWS * 512 * 2;
constexpr size_t WS_END = OFF_YB + (size_t)NT * 512 * 2;
static_assert(WS_END <= (size_t)1073741824, "workspace overflow");
constexpr size_t OFF_YF = OFF_CQKV;
constexpr size_t OFF_MERGED = OFF_RW;
constexpr size_t OFF_ACT = OFF_CQKV;
static_assert((size_t)NT * 2816 * 2 <= OFF_MH - OFF_CQKV, "act overflow");
constexpr size_t DO_Q = 0;
constexpr size_t DO_K = (size_t)NT * 768 * 2;
constexpr size_t DO_VT = DO_K + (size_t)NT * 768 * 2;

struct Params {
  const float* in[41];
  float* out;
  unsigned char* ws;
  int lo, hi;
};

typedef __bf16 bf16x2_t __attribute__((ext_vector_type(2)));
typedef float f32x2_t __attribute__((ext_vector_type(2)));
__device__ __forceinline__ unsigned pack2(float a, float b) {
  f32x2_t f = {a, b};
  bf16x2_t h = __builtin_convertvector(f, bf16x2_t);
  return __builtin_bit_cast(unsigned, h);
}
__device__ __forceinline__ u16 f2bf(float f) { return (u16)(pack2(f, f) & 0xffffu); }
__device__ __forceinline__ float bf2f(u16 b) { return __uint_as_float(((unsigned)b) << 16); }
__device__ __forceinline__ float bflo(unsigned u) { return __uint_as_float(u << 16); }
__device__ __forceinline__ float bfhi(unsigned u) { return __uint_as_float(u & 0xffff0000u); }

template <int CTRL>
__device__ __forceinline__ float dppf(float v) {
  return __int_as_float(__builtin_amdgcn_mov_dpp(__float_as_int(v), CTRL, 0xF, 0xF, true));
}
__device__ __forceinline__ float sum16(float v) {
  v += dppf<0xB1>(v);
  v += dppf<0x4E>(v);
  v += dppf<0x141>(v);
  v += dppf<0x140>(v);
  return v;
}
__device__ __forceinline__ float sum8(float v) {
  v += dppf<0xB1>(v);
  v += dppf<0x4E>(v);
  v += dppf<0x141>(v);
  return v;
}
__device__ __forceinline__ float wave_sum(float v) {
  v = sum16(v);
  v += __shfl_xor(v, 16);
  v += __shfl_xor(v, 32);
  return v;
}
__device__ __forceinline__ float sigmoidf_(float x) { return 1.f / (1.f + __expf(-x)); }

__device__ __forceinline__ void tok_seq(int g, int& seq, int& start, int& T) {
  if (g < NTP) { seq = g >> 11; start = seq << 11; T = 2048; }
  else { int s = (g - NTP) >> 13; seq = 32 + s; start = NTP + (s << 13); T = 8192; }
}
__device__ __forceinline__ size_t vt_base(int seq) {
  return seq < 32 ? (size_t)seq * (512 * 2048) : (size_t)32 * 512 * 2048 + (size_t)(seq - 32) * (512 * 8192);
}

struct Acc { f32x16 a[2][2]; };
constexpr int LROW = 72;
constexpr int LTILE = 128 * LROW;

__device__ __forceinline__ void acc_zero(Acc& acc) {
#pragma unroll
  for (int i = 0; i < 2; i++)
#pragma unroll
    for (int j = 0; j < 2; j++)
#pragma unroll
      for (int r = 0; r < 16; r++) acc.a[i][j][r] = 0.f;
}

__device__ __forceinline__ void gemm_compute(Acc& acc, const u16* lds, int b) {
  const int lane = threadIdx.x & 63, wave = threadIdx.x >> 6, wm = wave >> 1, wn = wave & 1;
  const u16* A = lds + b * (2 * LTILE) + (64 * wm + (lane & 31)) * LROW + 8 * (lane >> 5);
  const u16* B = lds + b * (2 * LTILE) + LTILE + (64 * wn + (lane & 31)) * LROW + 8 * (lane >> 5);
#pragma unroll
  for (int s = 0; s < 4; s++) {
    bf16x8 a0 = *(const bf16x8*)(A + 16 * s);
    bf16x8 a1 = *(const bf16x8*)(A + 32 * LROW + 16 * s);
    bf16x8 b0 = *(const bf16x8*)(B + 16 * s);
    bf16x8 b1 = *(const bf16x8*)(B + 32 * LROW + 16 * s);
    acc.a[0][0] = __builtin_amdgcn_mfma_f32_32x32x16_bf16(a0, b0, acc.a[0][0], 0, 0, 0);
    acc.a[0][1] = __builtin_amdgcn_mfma_f32_32x32x16_bf16(a0, b1, acc.a[0][1], 0, 0, 0);
    acc.a[1][0] = __builtin_amdgcn_mfma_f32_32x32x16_bf16(a1, b0, acc.a[1][0], 0, 0, 0);
    acc.a[1][1] = __builtin_amdgcn_mfma_f32_32x32x16_bf16(a1, b1, acc.a[1][1], 0, 0, 0);
  }
}

template <bool SINGLE = false, bool DEEP = true>
__device__ __forceinline__ void gemm_main(Acc& acc, u16* lds, const u16* pa0, const u16* pa1, const u16* pa2,
                                          const u16* pa3, const u16* pb0, const u16* pb1, const u16* pb2,
                                          const u16* pb3, int K) {
  const int tid = threadIdx.x;
  const int lr = tid >> 3, lk = (tid & 7) * 8;
  uint4 xa0, xa1, xa2, xa3, xb0, xb1, xb2, xb3;
  uint4 ya0, ya1, ya2, ya3, yb0, yb1, yb2, yb3;
  const int nk = K >> 6;
#define GLOAD(S, k0)                                                                         \
  S##a0 = *(const uint4*)(pa0 + (k0) + lk); S##a1 = *(const uint4*)(pa1 + (k0) + lk);         \
  S##a2 = *(const uint4*)(pa2 + (k0) + lk); S##a3 = *(const uint4*)(pa3 + (k0) + lk);         \
  S##b0 = *(const uint4*)(pb0 + (k0) + lk); S##b1 = *(const uint4*)(pb1 + (k0) + lk);         \
  S##b2 = *(const uint4*)(pb2 + (k0) + lk); S##b3 = *(const uint4*)(pb3 + (k0) + lk);
#define SSTORE(S, b)                                                                         \
  {                                                                                          \
    u16* A_ = lds + (b) * (2 * LTILE) + lr * LROW + lk;                                      \
    u16* B_ = A_ + LTILE;                                                                    \
    *(uint4*)(A_) = S##a0; *(uint4*)(A_ + 32 * LROW) = S##a1;                                \
    *(uint4*)(A_ + 64 * LROW) = S##a2; *(uint4*)(A_ + 96 * LROW) = S##a3;                    \
    *(uint4*)(B_) = S##b0; *(uint4*)(B_ + 32 * LROW) = S##b1;                                \
    *(uint4*)(B_ + 64 * LROW) = S##b2; *(uint4*)(B_ + 96 * LROW) = S##b3;                    \
  }
  if (!DEEP) {
    GLOAD(x, 0)
    SSTORE(x, 0)
    __syncthreads();
    for (int kt = 0; kt < nk; kt++) {
      if (kt + 1 < nk) { GLOAD(x, (kt + 1) * 64) }
      gemm_compute(acc, lds, SINGLE ? 0 : (kt & 1));
      if (SINGLE) __syncthreads();
      if (kt + 1 < nk) { SSTORE(x, SINGLE ? 0 : ((kt + 1) & 1)) }
      __syncthreads();
    }
    return;
  }
  GLOAD(x, 0)
  GLOAD(y, 64)
  SSTORE(x, 0)
  __syncthreads();
  for (int kt = 0; kt < nk; kt += 2) {
    if (kt + 2 < nk) { GLOAD(x, (kt + 2) * 64) }
    __builtin_amdgcn_sched_barrier(0);
    gemm_compute(acc, lds, 0);
    if (SINGLE) __syncthreads();
    SSTORE(y, SINGLE ? 0 : 1)
    __syncthreads();
    if (kt + 3 < nk) { GLOAD(y, (kt + 3) * 64) }
    __builtin_amdgcn_sched_barrier(0);
    gemm_compute(acc, lds, SINGLE ? 0 : 1);
    if (SINGLE) __syncthreads();
    if (kt + 2 < nk) { SSTORE(x, 0) }
    __syncthreads();
  }
#undef GLOAD
#undef SSTORE
}

template <bool SINGLE = false, bool DEEP = true>
__device__ __forceinline__ void gemm_lin(Acc& acc, u16* lds, const u16* A, long lda, const u16* B, long ldb, int K) {
  const int lr = threadIdx.x >> 3;
  gemm_main<SINGLE, DEEP>(acc, lds, A + (long)lr * lda, A + (long)(lr + 32) * lda, A + (long)(lr + 64) * lda,
            A + (long)(lr + 96) * lda, B + (long)lr * ldb, B + (long)(lr + 32) * ldb, B + (long)(lr + 64) * ldb,
            B + (long)(lr + 96) * ldb, K);
}

template <class F>
__device__ __forceinline__ void epi_each(const Acc& acc, F f) {
  const int lane = threadIdx.x & 63, wave = threadIdx.x >> 6, wm = wave >> 1, wn = wave & 1;
#pragma unroll
  for (int i = 0; i < 2; i++)
#pragma unroll
    for (int j = 0; j < 2; j++)
#pragma unroll
      for (int g = 0; g < 4; g++) {
        int r0 = 64 * wm + 32 * i + 8 * g + 4 * (lane >> 5);
        int c = 64 * wn + 32 * j + (lane & 31);
        f(r0, c, acc.a[i][j][4 * g + 0], acc.a[i][j][4 * g + 1], acc.a[i][j][4 * g + 2], acc.a[i][j][4 * g + 3]);
      }
}

__device__ __forceinline__ void store_bf16_pairs(u16* colbase, long ld, int c, float v0, float v1, float v2, float v3) {
  const bool odd = c & 1;
  const float sA = odd ? v0 : v2, sB = odd ? v1 : v3;
  const float rA = dppf<0xB1>(sA), rB = dppf<0xB1>(sB);
  if (!odd) {
    *(unsigned*)(colbase) = pack2(v0, rA);
    *(unsigned*)(colbase + ld) = pack2(v1, rB);
  } else {
    *(unsigned*)(colbase + 2 * ld - 1) = pack2(rA, v2);
    *(unsigned*)(colbase + 3 * ld - 1) = pack2(rB, v3);
  }
}

__device__ __forceinline__ bool tile_map(int k, int MT, int NTL, int& mt, int& nt) {
  const int G = gridDim.x;
  if (G & 7) {
    int it = blockIdx.x + k * G;
    if (it >= MT * NTL) return false;
    mt = it / NTL; nt = it % NTL;
    return true;
  }
  const int xcd = blockIdx.x & 7, lb = blockIdx.x >> 3, nbx = G >> 3;
  const int mtx0 = (MT * xcd) >> 3, mtx1 = (MT * (xcd + 1)) >> 3, MTX = mtx1 - mtx0;
  const int idx = lb + k * nbx;
  if (idx >= MTX * NTL) return false;
  constexpr int GM = 4;
  const int mg0 = idx / (GM * NTL);
  const int base = mg0 * GM;
  const int gsz = (MTX - base) < GM ? (MTX - base) : GM;
  const int rem = idx - mg0 * GM * NTL;
  nt = rem / gsz;
  mt = mtx0 + base + rem % gsz;
  return true;
}

template <class NMap, class KMap>
__device__ __forceinline__ void cvtw(const float* __restrict__ W, int srcN, u16* __restrict__ Wt, int dN, int dK,
                     const float* __restrict__ gain, NMap nmap, KMap kmap, long gtid, long gsz) {
  const int kch = dK >> 3;
  const long total = (long)dN * kch;
  for (long i = gtid; i < total; i += gsz) {
    int n = (int)(i % dN), kc = (int)(i / dN);
    int sn = nmap(n);
    float v[8];
#pragma unroll
    for (int j = 0; j < 8; j++) {
      int sk = kmap(kc * 8 + j);
      float x = 0.f;
      if (sn >= 0 && sk >= 0) {
        x = W[(long)sk * srcN + sn];
        if (gain) x *= gain[sk];
      }
      v[j] = x;
    }
    uint4 o;
    o.x = pack2(v[0], v[1]); o.y = pack2(v[2], v[3]); o.z = pack2(v[4], v[5]); o.w = pack2(v[6], v[7]);
    *(uint4*)(Wt + (long)n * dK + kc * 8) = o;
  }
}

__device__ __forceinline__ void phase0(const Params& P) {
  const long gtid = (long)blockIdx.x * NTHREADS + threadIdx.x, gsz = (long)gridDim.x * NTHREADS;
  unsigned char* ws = P.ws;
  if (gtid == 0) { ((unsigned*)(ws + OFF_CTL))[0] = 0u; ((unsigned*)(ws + OFF_CTL))[16] = 0u; }
  { float* rsz = (float*)(ws + OFF_RS); for (long e = gtid; e < NT; e += gsz) rsz[e] = 0.f; }
  auto idn = [](int n) { return n; };
  cvtw(P.in[5], 6176, (u16*)(ws + OFF_WIN), 6272, 1024, P.in[4],
       [](int n) {
         if (n < 640) return n;
         if (n < 2560) return 672 + (n - 640);
         if (n < 3072) return 2592 + (n - 2560);
         if (n < 3104) return 640 + (n - 3072);
         if (n < 3200) return -1;
         return 3104 + (n - 3200);
       },
       idn, gtid, gsz);
  cvtw(P.in[7], 768, (u16*)(ws + OFF_WUQ), 768, 384, P.in[6], idn, idn, gtid, gsz);
  cvtw(P.in[9], 1024, (u16*)(ws + OFF_WUKV), 1024, 256, P.in[8], idn, idn, gtid, gsz);
  cvtw(P.in[12], 1024, (u16*)(ws + OFF_WOA), 1024, 768, nullptr, idn,
       [](int k) { int h = k / 96, d = k % 96; return d < 64 ? h * 64 + d : -1; }, gtid, gsz);
  cvtw(P.in[29], 1024, (u16*)(ws + OFF_WOB), 1024, 512, nullptr, idn, idn, gtid, gsz);
  cvtw(P.in[34], 1024, (u16*)(ws + OFF_WOC), 1024, 512, nullptr, idn, idn, gtid, gsz);
  cvtw(P.in[31], 1024, (u16*)(ws + OFF_WMKV), 1024, 1024, P.in[30], idn, idn, gtid, gsz);
  cvtw(P.in[35], 1024, (u16*)(ws + OFF_WOUT), 1024, 1024, nullptr, idn, idn, gtid, gsz);
  cvtw(P.in[37], 5632, (u16*)(ws + OFF_WUP), 5632, 1024, P.in[36],
       [](int n) { int t = n >> 7, w = n & 127; return w < 64 ? t * 64 + w : 2816 + t * 64 + (w - 64); }, idn, gtid, gsz);
  cvtw(P.in[40], 1024, (u16*)(ws + OFF_WDOWN), 1024, 2816, nullptr, idn, idn, gtid, gsz);
  cvtw(P.in[23], 512, (u16*)(ws + OFF_G2), 512, 128, nullptr, idn, idn, gtid, gsz);
  cvtw(P.in[16], 512, (u16*)(ws + OFF_W2F), 512, 64, nullptr, idn, idn, gtid, gsz);
  cvtw(P.in[20], 512, (u16*)(ws + OFF_W2B), 512, 64, nullptr, idn, idn, gtid, gsz);
  cvtw(P.in[18], 512, (u16*)(ws + OFF_A2F), 512, 64, nullptr, idn, idn, gtid, gsz);
  cvtw(P.in[22], 512, (u16*)(ws + OFF_A2B), 512, 64, nullptr, idn, idn, gtid, gsz);
}

__device__ __forceinline__ void norm_row(const float* __restrict__ src, u16* __restrict__ dst) {
  const int lane = threadIdx.x & 63;
  float4 v0 = *(const float4*)(src + lane * 4);
  float4 v1 = *(const float4*)(src + 256 + lane * 4);
  float4 v2 = *(const float4*)(src + 512 + lane * 4);
  float4 v3 = *(const float4*)(src + 768 + lane * 4);
  float ss = v0.x * v0.x + v0.y * v0.y + v0.z * v0.z + v0.w * v0.w + v1.x * v1.x + v1.y * v1.y + v1.z * v1.z +
             v1.w * v1.w + v2.x * v2.x + v2.y * v2.y + v2.z * v2.z + v2.w * v2.w + v3.x * v3.x + v3.y * v3.y +
             v3.z * v3.z + v3.w * v3.w;
  ss = wave_sum(ss);
  float r = rsqrtf(ss * (1.f / 1024.f) + 1e-6f);
  uint2 o;
  o.x = pack2(v0.x * r, v0.y * r); o.y = pack2(v0.z * r, v0.w * r); *(uint2*)(dst + lane * 4) = o;
  o.x = pack2(v1.x * r, v1.y * r); o.y = pack2(v1.z * r, v1.w * r); *(uint2*)(dst + 256 + lane * 4) = o;
  o.x = pack2(v2.x * r, v2.y * r); o.y = pack2(v2.z * r, v2.w * r); *(uint2*)(dst + 512 + lane * 4) = o;
  o.x = pack2(v3.x * r, v3.y * r); o.y = pack2(v3.z * r, v3.w * r); *(uint2*)(dst + 768 + lane * 4) = o;
}

__device__ __forceinline__ void phase0b(const Params& P) {
  const int wave = threadIdx.x >> 6;
  u16* H = (u16*)(P.ws + OFF_H);
  u16* MH = (u16*)(P.ws + OFF_MH);
  for (int row = blockIdx.x * 4 + wave; row < NT + NMEMROWS; row += gridDim.x * 4) {
    if (row < NT) {
      const float* src = row < NTP ? P.in[0] + (size_t)row * 1024 : P.in[1] + (size_t)(row - NTP) * 1024;
      norm_row(src, H + (size_t)row * 1024);
    } else {
      int mr = row - NT;
      const float* src = mr < 8192 ? P.in[2] + (size_t)mr * 1024 : P.in[3] + (size_t)(mr - 8192) * 1024;
      norm_row(src, MH + (size_t)mr * 1024);
    }
  }
}

__device__ __forceinline__ void phase1(const Params& P, u16* lds) {
  unsigned char* ws = P.ws;
  const u16* H = (const u16*)(ws + OFF_H);
  const u16* Win = (const u16*)(ws + OFF_WIN);
  u16* CQKV = (u16*)(ws + OFF_CQKV);
  u16* RW = (u16*)(ws + OFF_RW);
  u16* XQ = (u16*)(ws + OFF_XQ);
  for (int kk_ = 0;; kk_++) {
    int mt, nt;
    if (!tile_map(kk_, 768, 25, mt, nt)) break;
    Acc acc; acc_zero(acc);
    {
      int m0 = mt * 128, n0 = nt * 128;
      gemm_lin(acc, lds, H + (size_t)m0 * 1024, 1024, Win + (size_t)n0 * 1024, 1024, 1024);
      epi_each(acc, [&](int r0, int c, float v0, float v1, float v2, float v3) {
        int n = n0 + c;
        u16* dst; int ld;
        if (n < 640) { dst = CQKV + n; ld = 672; }
        else if (n < 2560) { dst = RW + (n - 640); ld = 1920; }
        else if (n < 3072) { dst = XQ + (n - 2560); ld = 512; }
        else if (n < 3104) { dst = CQKV + 640 + (n - 3072); ld = 672; }
        else return;
        store_bf16_pairs(dst + (size_t)(m0 + r0) * ld, ld, c, v0, v1, v2, v3);
      });
    }
  }
  for (int i2 = blockIdx.x; i2 < 72 * 8; i2 += gridDim.x) {
    Acc acc; acc_zero(acc);
    {
      int mt = i2 / 8, nt = i2 % 8;
      int m0 = mt * 128, n0 = nt * 128;
      gemm_lin(acc, lds, (const u16*)(ws + OFF_MH) + (size_t)m0 * 1024, 1024, (const u16*)(ws + OFF_WMKV) + (size_t)n0 * 1024, 1024, 1024);
      u16* MKV = (u16*)(ws + OFF_MKV);
      epi_each(acc, [&](int r0, int c, float v0, float v1, float v2, float v3) {
        u16* dst = MKV + (size_t)(m0 + r0) * 1024 + n0 + c;
        dst[0] = f2bf(v0); dst[1024] = f2bf(v1); dst[2048] = f2bf(v2); dst[3072] = f2bf(v3);
      });
    }
  }
}

__device__ __forceinline__ void phase2(const Params& P, u16* lds) {
  unsigned char* ws = P.ws;
  const u16* CQKV = (const u16*)(ws + OFF_CQKV);
  u16* Q = (u16*)((unsigned char*)P.out + DO_Q);
  u16* Kb = (u16*)((unsigned char*)P.out + DO_K);
  u16* Vt = (u16*)((unsigned char*)P.out + DO_VT);
  __shared__ float rstd_s[128];
  const int tid = threadIdx.x;
  for (int it = blockIdx.x; it < 768 * 14; it += gridDim.x) {
    int mt = it / 14, nt = it % 14;
    int m0 = mt * 128;
    const bool isq = nt < 6;
    {
      int r = tid >> 1, hf = tid & 1;
      const u16* src = CQKV + (size_t)(m0 + r) * 672 + (isq ? hf * 192 : 384 + hf * 128);
      int nch = isq ? 24 : 16;
      float ss = 0.f;
      for (int c = 0; c < nch; c++) {
        uint4 u = *(const uint4*)(src + c * 8);
        float a;
        a = bflo(u.x); ss += a * a; a = bfhi(u.x); ss += a * a;
        a = bflo(u.y); ss += a * a; a = bfhi(u.y); ss += a * a;
        a = bflo(u.z); ss += a * a; a = bfhi(u.z); ss += a * a;
        a = bflo(u.w); ss += a * a; a = bfhi(u.w); ss += a * a;
      }
      ss += dppf<0xB1>(ss);
      if (hf == 0) rstd_s[r] = rsqrtf(ss / (isq ? 384.f : 256.f) + 1e-6f);
    }
    __syncthreads();
    Acc acc; acc_zero(acc);
    if (isq) {
      int n0 = nt * 128;
      gemm_lin(acc, lds, CQKV + (size_t)m0 * 672, 672, (const u16*)(ws + OFF_WUQ) + (size_t)n0 * 384, 384, 384);
      epi_each(acc, [&](int r0, int c, float v0, float v1, float v2, float v3) {
        store_bf16_pairs(Q + (size_t)(m0 + r0) * 768 + n0 + c, 768, c, v0 * rstd_s[r0], v1 * rstd_s[r0 + 1],
                         v2 * rstd_s[r0 + 2], v3 * rstd_s[r0 + 3]);
      });
    } else {
      int head = nt - 6;
      int n0 = head * 128;
      gemm_lin(acc, lds, CQKV + (size_t)m0 * 672 + 384, 672, (const u16*)(ws + OFF_WUKV) + (size_t)n0 * 256, 256, 256);
      int seq, start, T;
      tok_seq(m0, seq, start, T);
      u16* vtb = Vt + vt_base(seq) + (size_t)head * 64 * T + (m0 - start);
      epi_each(acc, [&](int r0, int c, float v0, float v1, float v2, float v3) {
        v0 *= rstd_s[r0]; v1 *= rstd_s[r0 + 1]; v2 *= rstd_s[r0 + 2]; v3 *= rstd_s[r0 + 3];
        if (c < 64) {
          u16* dst = Kb + (size_t)(m0 + r0) * 768 + head * 96 + c;
          dst[0] = f2bf(v0); dst[768] = f2bf(v1); dst[1536] = f2bf(v2); dst[2304] = f2bf(v3);
        } else {
          uint2 o; o.x = pack2(v0, v1); o.y = pack2(v2, v3);
          *(uint2*)(vtb + (size_t)(c - 64) * T + r0) = o;
        }
      });
    }
    __syncthreads();
  }
}

__device__ __forceinline__ void phase3(const Params& P) {
  unsigned char* ws = P.ws;
  const u16* CQKV = (const u16*)(ws + OFF_CQKV);
  u16* Kb = (u16*)((unsigned char*)P.out + DO_K);
  const float* gk = P.in[11];
  const int tid = threadIdx.x;
  const int sub = tid >> 4, i = tid & 15;
  const float inv = powf(10000.f, -(float)i / 16.f);
  const float g0 = gk[4 * i], g1 = gk[4 * i + 1], g2 = gk[4 * i + 2], g3 = gk[4 * i + 3], gr1 = gk[64 + i], gr2 = gk[80 + i];
  for (long pr = (long)blockIdx.x * 16 + sub; pr < (long)NT * 8; pr += (long)gridDim.x * 16) {
    int tok = (int)(pr >> 3), head = (int)(pr & 7);
    u16* kp = Kb + (size_t)tok * 768 + head * 96;
    uint2 u = *(const uint2*)(kp + 4 * i);
    float a0 = bflo(u.x), a1 = bfhi(u.x), a2 = bflo(u.y), a3 = bfhi(u.y);
    float x1 = bf2f(CQKV[(size_t)tok * 672 + 640 + i]);
    float x2 = bf2f(CQKV[(size_t)tok * 672 + 656 + i]);
    float ss = a0 * a0 + a1 * a1 + a2 * a2 + a3 * a3 + x1 * x1 + x2 * x2;
    ss = sum16(ss);
    float r = rsqrtf(ss * (1.f / 96.f) + 1e-6f);
    int seq, start, T;
    tok_seq(tok, seq, start, T);
    float ang = (float)(tok - start) * inv;
    float sn, cs;
    sincosf(ang, &sn, &cs);
    x1 *= r * gr1; x2 *= r * gr2;
    uint2 o; o.x = pack2(a0 * r * g0, a1 * r * g1); o.y = pack2(a2 * r * g2, a3 * r * g3);
    *(uint2*)(kp + 4 * i) = o;
    kp[64 + i] = f2bf(x1 * cs - x2 * sn);
    kp[80 + i] = f2bf(x2 * cs + x1 * sn);
  }
  const u16* MKV = (const u16*)(ws + OFF_MKV);
  u16* MK = (u16*)(ws + OFF_MK);
  u16* MVT = (u16*)(ws + OFF_MVT);
  const float* gxk = P.in[33];
  for (int pr = blockIdx.x * 16 + sub; pr < NMEMROWS * 4; pr += gridDim.x * 16) {
    int row = pr >> 2, head = pr & 3;
    int b = row >> 8, key = row & 255;
    uint4 u = *(const uint4*)(MKV + (size_t)row * 1024 + head * 256 + 8 * i);
    float a0 = bflo(u.x), a1 = bfhi(u.x), a2 = bflo(u.y), a3 = bfhi(u.y), a4 = bflo(u.z), a5 = bfhi(u.z), a6 = bflo(u.w), a7 = bfhi(u.w);
    float ss = a0 * a0 + a1 * a1 + a2 * a2 + a3 * a3 + a4 * a4 + a5 * a5 + a6 * a6 + a7 * a7;
    ss = sum16(ss);
    float r = rsqrtf(ss * (1.f / 128.f) + 1e-6f);
    const float* g = gxk + 8 * i;
    uint4 o;
    o.x = pack2(a0 * r * g[0], a1 * r * g[1]); o.y = pack2(a2 * r * g[2], a3 * r * g[3]);
    o.z = pack2(a4 * r * g[4], a5 * r * g[5]); o.w = pack2(a6 * r * g[6], a7 * r * g[7]);
    *(uint4*)(MK + ((size_t)(b * 4 + head) * 256 + key) * 128 + 8 * i) = o;
  }
  for (long e = (long)blockIdx.x * NTHREADS + tid; e < (long)NMEMROWS * 512; e += (long)gridDim.x * NTHREADS) {
    int row = (int)(e >> 9), c = (int)(e & 511);
    int head = c >> 7, dv = c & 127;
    int b = row >> 8, key = row & 255;
    MVT[((size_t)(b * 4 + head) * 128 + dv) * 256 + key] = MKV[(size_t)row * 1024 + head * 256 + 128 + dv];
  }
}

template <int DQK, int DV, bool ROPE, bool PREF>
__device__ __forceinline__ void attn_item(u16* lds, const u16* Qp, long qld, const u16* Kp, long kld, const u16* Vtp, long vld,
                          int nkeys, const float* __restrict__ gq, float qscale, int tpos0, u16* Op, long old) {
  constexpr int KP = DQK + 8;
  constexpr int KT = 64 * KP;
  constexpr int VT = DV * 72;
  constexpr int BUF = KT + VT;
  constexpr int NS = DQK / 16;
  constexpr int ND = DV / 32;
  constexpr int KCH = DQK / 8;
  constexpr int NKC = 64 * KCH / 256;
  constexpr int NVC = DV * 8 / 256;
  const int tid = threadIdx.x, lane = tid & 63, wave = tid >> 6, h = lane >> 5, lr = lane & 31;

  bf16x8 qf[NS];
  {
    const u16* qp = Qp + (long)(32 * wave + lr) * qld + 8 * h;
    float qv[NS][8];
    float ss = 0.f;
#pragma unroll
    for (int s = 0; s < NS; s++) {
      uint4 u = *(const uint4*)(qp + 16 * s);
      qv[s][0] = bflo(u.x); qv[s][1] = bfhi(u.x); qv[s][2] = bflo(u.y); qv[s][3] = bfhi(u.y);
      qv[s][4] = bflo(u.z); qv[s][5] = bfhi(u.z); qv[s][6] = bflo(u.w); qv[s][7] = bfhi(u.w);
#pragma unroll
      for (int j = 0; j < 8; j++) ss += qv[s][j] * qv[s][j];
    }
    ss += __shfl_xor(ss, 32);
    float r = rsqrtf(ss * (1.f / DQK) + 1e-6f);
#pragma unroll
    for (int s = 0; s < NS; s++)
#pragma unroll
      for (int j = 0; j < 8; j++) qv[s][j] *= r * gq[16 * s + 8 * h + j];
    if (ROPE) {
      float t = (float)(tpos0 + 32 * wave + lr);
#pragma unroll
      for (int j = 0; j < 8; j++) {
        float inv = powf(10000.f, -(float)(8 * h + j) / 16.f);
        float sn, cs;
        sincosf(t * inv, &sn, &cs);
        float x1 = qv[NS - 2][j], x2 = qv[NS - 1][j];
        qv[NS - 2][j] = x1 * cs - x2 * sn;
        qv[NS - 1][j] = x2 * cs + x1 * sn;
      }
    }
#pragma unroll
    for (int s = 0; s < NS; s++) {
      uint4 u;
      u.x = pack2(qv[s][0] * qscale, qv[s][1] * qscale); u.y = pack2(qv[s][2] * qscale, qv[s][3] * qscale);
      u.z = pack2(qv[s][4] * qscale, qv[s][5] * qscale); u.w = pack2(qv[s][6] * qscale, qv[s][7] * qscale);
      qf[s] = *(bf16x8*)&u;
    }
  }

  f32x16 o[ND];
#pragma unroll
  for (int d = 0; d < ND; d++)
#pragma unroll
    for (int r = 0; r < 16; r++) o[d][r] = 0.f;
  float lsum = 0.f;

  uint4 rk[NKC], rv[NVC];
  const int nkt = nkeys >> 6;
#define AGLOAD(kt)                                                                           \
  {                                                                                          \
    _Pragma("unroll") for (int i = 0; i < NKC; i++) {                                        \
      int c = tid + 256 * i; int row = c / KCH, kc = c % KCH;                                \
      rk[i] = *(const uint4*)(Kp + (long)((kt) * 64 + row) * kld + kc * 8);                  \
    }                                                                                        \
    _Pragma("unroll") for (int i = 0; i < NVC; i++) {                                        \
      int c = tid + 256 * i; int row = c >> 3, kc = c & 7;                                   \
      rv[i] = *(const uint4*)(Vtp + (long)row * vld + (kt) * 64 + kc * 8);                   \
    }                                                                                        \
  }
#define ASTORE(b)                                                                            \
  {                                                                                          \
    u16* Kl = lds + (b) * BUF; u16* Vl = Kl + KT;                                            \
    _Pragma("unroll") for (int i = 0; i < NKC; i++) {                                        \
      int c = tid + 256 * i; int row = c / KCH, kc = c % KCH;                                \
      *(uint4*)(Kl + row * KP + kc * 8) = rk[i];                                             \
    }                                                                                        \
    _Pragma("unroll") for (int i = 0; i < NVC; i++) {                                        \
      int c = tid + 256 * i; int row = c >> 3, kc = c & 7;                                   \
      *(uint4*)(Vl + row * 72 + kc * 8) = rv[i];                                             \
    }                                                                                        \
  }
  AGLOAD(0)
  ASTORE(0)
  __syncthreads();
  for (int kt = 0; kt < nkt; kt++) {
    if (PREF) { if (kt + 1 < nkt) AGLOAD(kt + 1) }
    else { if (kt + 1 < nkt) { AGLOAD(kt + 1) ASTORE((kt + 1) & 1) } }
    const u16* Kl = lds + (kt & 1) * BUF;
    const u16* Vl = Kl + KT;
#pragma unroll
    for (int ks = 0; ks < 2; ks++) {
      f32x16 st;
#pragma unroll
      for (int r = 0; r < 16; r++) st[r] = 0.f;
      const u16* kr = Kl + (32 * ks + lr) * KP + 8 * h;
#pragma unroll
      for (int s = 0; s < NS; s++) {
        bf16x8 kf = *(const bf16x8*)(kr + 16 * s);
        st = __builtin_amdgcn_mfma_f32_32x32x16_bf16(kf, qf[s], st, 0, 0, 0);
      }
      float p[16];
#pragma unroll
      for (int r = 0; r < 16; r++) { p[r] = __builtin_amdgcn_exp2f(st[r]); lsum += p[r]; }
#pragma unroll
      for (int s2 = 0; s2 < 2; s2++) {
        uint4 u;
        u.x = pack2(p[8 * s2 + 0], p[8 * s2 + 1]); u.y = pack2(p[8 * s2 + 2], p[8 * s2 + 3]);
        u.z = pack2(p[8 * s2 + 4], p[8 * s2 + 5]); u.w = pack2(p[8 * s2 + 6], p[8 * s2 + 7]);
        bf16x8 pb = *(bf16x8*)&u;
#pragma unroll
        for (int d = 0; d < ND; d++) {
          const u16* vr = Vl + (32 * d + lr) * 72 + 32 * ks + 16 * s2 + 4 * h;
          uint2 v0 = *(const uint2*)(vr);
          uint2 v1 = *(const uint2*)(vr + 8);
          uint4 vv; vv.x = v0.x; vv.y = v0.y; vv.z = v1.x; vv.w = v1.y;
          bf16x8 vf = *(bf16x8*)&vv;
          o[d] = __builtin_amdgcn_mfma_f32_32x32x16_bf16(vf, pb, o[d], 0, 0, 0);
        }
      }
    }
    if (PREF) { if (kt + 1 < nkt) ASTORE((kt + 1) & 1) }
    __syncthreads();
  }
#undef AGLOAD
#undef ASTORE
  lsum += __shfl_xor(lsum, 32);
  float il = 1.f / lsum;
  u16* op = Op + (long)(32 * wave + lr) * old;
#pragma unroll
  for (int d = 0; d < ND; d++)
#pragma unroll
    for (int g = 0; g < 4; g++) {
      uint2 u;
      u.x = pack2(o[d][4 * g] * il, o[d][4 * g + 1] * il);
      u.y = pack2(o[d][4 * g + 2] * il, o[d][4 * g + 3] * il);
      *(uint2*)(op + 32 * d + 8 * g + 4 * h) = u;
    }
}

typedef __attribute__((ext_vector_type(2))) float f32x2;
constexpr int SC_OP = 2048;
constexpr int SC_WR = 0, SC_KK = SC_OP, SC_WD = 2 * SC_OP, SC_KD = 3 * SC_OP, SC_BB = 4 * SC_OP;
constexpr int SC_R = SC_WR, SC_K = SC_KK, SC_LW = SC_WD, SC_LA = SC_KD;
constexpr int SC_V = 5 * SC_OP, SC_BR = SC_V + 2048, SC_CKR = SC_BR + 32, SC_Y = SC_CKR + 32;
constexpr int SC_END = SC_Y + 2048;
constexpr int SC_TW_B = SC_END * 4;
constexpr int SC_AL_B = SC_TW_B + 32 * 72 * 2;
static_assert(SC_AL_B + 32 * 72 * 2 + 960 * 4 <= LDS_BYTES, "scan lds");

__device__ __forceinline__ float fexp(float x) { return __builtin_amdgcn_exp2f(x * 1.4426950408889634f); }
__device__ __forceinline__ float frcp(float x) { return __builtin_amdgcn_rcpf(x); }
__device__ __forceinline__ float ftanh(float x) { return 1.f - 2.f * frcp(1.f + fexp(2.f * x)); }
__device__ __forceinline__ float fsigm(float x) { return frcp(1.f + fexp(-x)); }

struct Raw3 { uint4 c, a, b; };
__device__ __forceinline__ Raw3 ld3(const u16* __restrict__ p, bool hp, bool hn) {
  Raw3 r;
  r.c = *(const uint4*)p;
  r.a = hp ? *(const uint4*)(p - 1920) : make_uint4(0, 0, 0, 0);
  r.b = hn ? *(const uint4*)(p + 1920) : make_uint4(0, 0, 0, 0);
  return r;
}
__device__ __forceinline__ void mixr(const Raw3& r, const float* __restrict__ mp, const float* __restrict__ mn, float* out) {
  float cc[8] = {bflo(r.c.x), bfhi(r.c.x), bflo(r.c.y), bfhi(r.c.y), bflo(r.c.z), bfhi(r.c.z), bflo(r.c.w), bfhi(r.c.w)};
  float aa[8] = {bflo(r.a.x), bfhi(r.a.x), bflo(r.a.y), bfhi(r.a.y), bflo(r.a.z), bfhi(r.a.z), bflo(r.a.w), bfhi(r.a.w)};
  float bb[8] = {bflo(r.b.x), bfhi(r.b.x), bflo(r.b.y), bfhi(r.b.y), bflo(r.b.z), bfhi(r.b.z), bflo(r.b.w), bfhi(r.b.w)};
#pragma unroll
  for (int j = 0; j < 8; j++) out[j] = cc[j] + mp[j] * (aa[j] - cc[j]) + mn[j] * (bb[j] - cc[j]);
}
__device__ __forceinline__ void mix8(const u16* __restrict__ p, bool hp, bool hn, const float* __restrict__ mp,
                                     const float* __restrict__ mn, float* out) {
  Raw3 r = ld3(p, hp, hn);
  mixr(r, mp, mn, out);
}

template <int NRG>
__device__ __forceinline__ void scan_item(const Params& P, unsigned char* ldsb, int seq, int head, int dir, int rg) {
  float* L = (float*)ldsb;
  u16* TWb = (u16*)(ldsb + SC_TW_B);
  u16* ALb = (u16*)(ldsb + SC_AL_B);
  unsigned char* ws = P.ws;
  const u16* RW = (const u16*)(ws + OFF_RW);
  u16* Y = (u16*)(ws + (dir ? OFF_YB : OFF_YF));
  const float* w0 = dir ? P.in[19] : P.in[15];
  const float* a0 = dir ? P.in[21] : P.in[17];
  const u16* w2t = (const u16*)(ws + (dir ? OFF_W2B : OFF_W2F));
  const u16* a2t = (const u16*)(ws + (dir ? OFF_A2B : OFF_A2F));
  const int T = seq < 32 ? 2048 : 8192;
  const int start = seq < 32 ? seq * 2048 : NTP + (seq - 32) * 8192;
  const int tid = threadIdx.x, lane = tid & 63, wave = tid >> 6;
  const int hc = head * 64;
  const int pt = tid >> 3, pc = (tid & 7) * 8;
  const int wlo = dir ? 1600 : 1536, alo = dir ? 1728 : 1664;
  float* CS = (float*)(ldsb + SC_AL_B + 32 * 72 * 2);
  for (int i = tid; i < 960; i += NTHREADS) {
    const int arr = i >> 6, c = i & 63;
    const float* src;
    switch (arr) {
      case 0: src = P.in[13] + hc; break;
      case 1: src = P.in[14] + hc; break;
      case 2: src = P.in[13] + 512 + hc; break;
      case 3: src = P.in[14] + 512 + hc; break;
      case 4: src = P.in[13] + 1024 + hc; break;
      case 5: src = P.in[14] + 1024 + hc; break;
      case 6: src = P.in[13] + wlo; break;
      case 7: src = P.in[14] + wlo; break;
      case 8: src = P.in[13] + alo; break;
      case 9: src = P.in[14] + alo; break;
      case 10: src = w0 + hc; break;
      case 11: src = a0 + hc; break;
      case 12: src = P.in[24] + hc; break;
      case 13: src = P.in[25] + hc; break;
      default: src = P.in[26] + hc; break;
    }
    CS[i] = src[c];
  }
  __syncthreads();
  const float *mpr = CS + pc, *mnr = CS + 64 + pc, *mpk = CS + 128 + pc, *mnk = CS + 192 + pc, *mpv = CS + 256 + pc,
              *mnv = CS + 320 + pc, *mpw = CS + 384 + pc, *mnw = CS + 448 + pc, *mpa = CS + 512 + pc, *mna = CS + 576 + pc,
              *cw0 = CS + 640 + pc, *ca0 = CS + 704 + pc, *ckk = CS + 768 + pc, *cka = CS + 832 + pc, *crk = CS + 896 + pc;
  const int rp = tid >> 3, seg = tid & 7;
  f32x2 st[8];
#pragma unroll
  for (int k = 0; k < 8; k++) st[k] = (f32x2){0.f, 0.f};
  const int nch = T >> 5;
  Raw3 g_r, g_k, g_v, g_w, g_a;
#define SLOAD(chn)                                                                     \
  {                                                                                    \
    const int t0_ = dir ? T - 32 * ((chn) + 1) : 32 * (chn);                           \
    const int t_ = t0_ + pt;                                                           \
    const bool hp_ = t_ > 0, hn_ = t_ < T - 1;                                         \
    const u16* base_ = RW + (size_t)(start + t_) * 1920;                               \
    g_r = ld3(base_ + hc + pc, hp_, hn_); g_k = ld3(base_ + 512 + hc + pc, hp_, hn_);  \
    g_v = ld3(base_ + 1024 + hc + pc, hp_, hn_); g_w = ld3(base_ + wlo + pc, hp_, hn_); \
    g_a = ld3(base_ + alo + pc, hp_, hn_);                                             \
  }
  SLOAD(0)
  for (int ch = 0; ch < nch; ch++) {
    const int t0 = dir ? T - 32 * (ch + 1) : 32 * ch;
    bf16x8 lb0, lb1, lb2, lb3;
    {
      const int mat = wave >> 1, ntile = wave & 1;
      const u16* Bsrc = (mat ? a2t : w2t) + (size_t)(hc + 32 * ntile + (lane & 31)) * 64 + 8 * (lane >> 5);
      lb0 = *(const bf16x8*)(Bsrc); lb1 = *(const bf16x8*)(Bsrc + 16); lb2 = *(const bf16x8*)(Bsrc + 32); lb3 = *(const bf16x8*)(Bsrc + 48);
    }
    {
      float v[8];
      mixr(g_r, mpr, mnr, v);
#pragma unroll
      for (int j = 0; j < 8; j++) L[SC_R + pt * 64 + pc + j] = v[j];
      mixr(g_k, mpk, mnk, v);
#pragma unroll
      for (int j = 0; j < 8; j++) L[SC_K + pt * 64 + pc + j] = v[j];
      mixr(g_v, mpv, mnv, v);
#pragma unroll
      for (int j = 0; j < 8; j++) L[SC_V + pt * 64 + pc + j] = v[j];
      mixr(g_w, mpw, mnw, v);
      uint4 u;
      u.x = pack2(ftanh(v[0]), ftanh(v[1])); u.y = pack2(ftanh(v[2]), ftanh(v[3]));
      u.z = pack2(ftanh(v[4]), ftanh(v[5])); u.w = pack2(ftanh(v[6]), ftanh(v[7]));
      *(uint4*)(TWb + pt * 72 + pc) = u;
      mixr(g_a, mpa, mna, v);
      u.x = pack2(v[0], v[1]); u.y = pack2(v[2], v[3]); u.z = pack2(v[4], v[5]); u.w = pack2(v[6], v[7]);
      *(uint4*)(ALb + pt * 72 + pc) = u;
    }
    __syncthreads();
    {
      const int mat = wave >> 1, ntile = wave & 1;
      const u16* Asrc = (mat ? ALb : TWb) + (lane & 31) * 72 + 8 * (lane >> 5);
      f32x16 c;
#pragma unroll
      for (int r = 0; r < 16; r++) c[r] = 0.f;
      c = __builtin_amdgcn_mfma_f32_32x32x16_bf16(*(const bf16x8*)(Asrc), lb0, c, 0, 0, 0);
      c = __builtin_amdgcn_mfma_f32_32x32x16_bf16(*(const bf16x8*)(Asrc + 16), lb1, c, 0, 0, 0);
      c = __builtin_amdgcn_mfma_f32_32x32x16_bf16(*(const bf16x8*)(Asrc + 32), lb2, c, 0, 0, 0);
      c = __builtin_amdgcn_mfma_f32_32x32x16_bf16(*(const bf16x8*)(Asrc + 48), lb3, c, 0, 0, 0);
      float* dst = L + (mat ? SC_LA : SC_LW);
#pragma unroll
      for (int r = 0; r < 16; r++) {
        int tr = (r & 3) + 8 * (r >> 2) + 4 * (lane >> 5);
        dst[tr * 64 + 32 * ntile + (lane & 31)] = c[r];
      }
    }
    __syncthreads();
    {
      float ssk = 0.f, br = 0.f, kr = 0.f, bon = 0.f;
      float kkr[8], av[8], kdv[8], rr[8], dec[8];
#pragma unroll
      for (int j = 0; j < 8; j++) {
        int o = pt * 64 + pc + j;
        float r = L[SC_R + o], k = L[SC_K + o];
        float wp = cw0[j] + L[SC_LW + o];
        float z = -wp;
        float sp = z > 15.f ? z : 0.6931471805599453f * __builtin_amdgcn_logf(1.f + fexp(z));
        float w = -sp - 0.5f;
        dec[j] = fexp(-fexp(w));
        float a = fsigm(ca0[j] + L[SC_LA + o]);
        av[j] = a;
        kkr[j] = k * ckk[j];
        ssk += kkr[j] * kkr[j];
        kdv[j] = k * (1.f + (a - 1.f) * cka[j]);
        rr[j] = r;
        kr += kdv[j] * r;
        bon += r * kdv[j] * crk[j];
      }
      ssk = sum8(ssk);
      float inrm = __builtin_amdgcn_rsqf(fmaxf(ssk, 1e-24f));
#pragma unroll
      for (int j = 0; j < 8; j++) {
        float kk = kkr[j] * inrm;
        float b = kk * av[j];
        br += b * rr[j];
        int o = pt * 64 + pc + j;
        L[SC_KK + o] = kk;
        L[SC_BB + o] = b;
        L[SC_WR + o] = dec[j] * rr[j];
        L[SC_WD + o] = dec[j];
        L[SC_KD + o] = kdv[j];
      }
      br = sum8(br); kr = sum8(kr); bon = sum8(bon);
      if ((tid & 7) == 0) { L[SC_BR + pt] = br; L[SC_CKR + pt] = kr + bon; }
    }
    __syncthreads();
    if (ch + 1 < nch) SLOAD(ch + 1)
    {
#pragma unroll 1
      for (int qo = 0; qo < 4; qo++) {
        f32x2 yk = (f32x2){0.f, 0.f};
#pragma unroll
        for (int qi = 0; qi < 8; qi++) {
          const int q = qo * 8 + qi;
          const int tt = dir ? 31 - q : q;
          const float* ob = L + tt * 64 + 8 * seg;
          float4 kka = *(const float4*)(ob + SC_KK), kkb = *(const float4*)(ob + SC_KK + 4);
          float4 wra = *(const float4*)(ob + SC_WR), wrb = *(const float4*)(ob + SC_WR + 4);
          float4 wda = *(const float4*)(ob + SC_WD), wdb = *(const float4*)(ob + SC_WD + 4);
          float4 bba = *(const float4*)(ob + SC_BB), bbb = *(const float4*)(ob + SC_BB + 4);
          float4 kda = *(const float4*)(ob + SC_KD), kdb = *(const float4*)(ob + SC_KD + 4);
          float br = L[SC_BR + tt], ckr = L[SC_CKR + tt];
          float kk[8] = {kka.x, kka.y, kka.z, kka.w, kkb.x, kkb.y, kkb.z, kkb.w};
          float wr[8] = {wra.x, wra.y, wra.z, wra.w, wrb.x, wrb.y, wrb.z, wrb.w};
          float wd[8] = {wda.x, wda.y, wda.z, wda.w, wdb.x, wdb.y, wdb.z, wdb.w};
          float bb[8] = {bba.x, bba.y, bba.z, bba.w, bbb.x, bbb.y, bbb.z, bbb.w};
          float kd[8] = {kda.x, kda.y, kda.z, kda.w, kdb.x, kdb.y, kdb.z, kdb.w};
          if (NRG == 1) {
            float2 vv = *(const float2*)(L + SC_V + tt * 64 + 2 * rp);
            f32x2 v2 = (f32x2){vv.x, vv.y};
            f32x2 p1 = st[0] * kk[0], p2 = st[0] * wr[0];
#pragma unroll
            for (int k = 1; k < 8; k++) { p1 += st[k] * kk[k]; p2 += st[k] * wr[k]; }
            p1.x = sum8(p1.x); p1.y = sum8(p1.y); p2.x = sum8(p2.x); p2.y = sum8(p2.y);
            f32x2 y2 = p2 - p1 * br + v2 * ckr;
            if (qi == seg) yk = y2;
#pragma unroll
            for (int k = 0; k < 8; k++) st[k] = st[k] * wd[k] - p1 * bb[k] + v2 * kd[k];
          } else {
            const float v = L[SC_V + tt * 64 + 32 * rg + rp];
            f32x2 q1 = st[0] * (f32x2){kk[0], kk[1]}, q2 = st[0] * (f32x2){wr[0], wr[1]};
#pragma unroll
            for (int i = 1; i < 4; i++) {
              q1 += st[i] * (f32x2){kk[2 * i], kk[2 * i + 1]};
              q2 += st[i] * (f32x2){wr[2 * i], wr[2 * i + 1]};
            }
            const float p1 = sum8(q1.x + q1.y), p2 = sum8(q2.x + q2.y);
            const float y = p2 - p1 * br + v * ckr;
            if (qi == seg) yk.x = y;
#pragma unroll
            for (int i = 0; i < 4; i++)
              st[i] = st[i] * (f32x2){wd[2 * i], wd[2 * i + 1]} - p1 * (f32x2){bb[2 * i], bb[2 * i + 1]} + v * (f32x2){kd[2 * i], kd[2 * i + 1]};
          }
        }
        {
          const int q = qo * 8 + seg;
          const int tt = dir ? 31 - q : q;
          if (NRG == 1) *(float2*)(L + SC_Y + tt * 64 + 2 * rp) = make_float2(yk.x, yk.y);
          else L[SC_Y + tt * 64 + 32 * rg + rp] = yk.x;
        }
      }
    }
    __syncthreads();
    if (NRG == 1 || (pc >> 5) == rg) {
      const float* yp = L + SC_Y + pt * 64 + pc;
      uint4 u;
      u.x = pack2(yp[0], yp[1]); u.y = pack2(yp[2], yp[3]); u.z = pack2(yp[4], yp[5]); u.w = pack2(yp[6], yp[7]);
      *(uint4*)(Y + (size_t)(start + t0 + pt) * 512 + hc + pc) = u;
    }
  }
#undef SLOAD
}

__device__ __forceinline__ void phase4(const Params& P, unsigned char* ldsb) {
  __shared__ int s_item;
  unsigned* ctr = (unsigned*)(P.ws + OFF_CTL);
  u16* lds = (u16*)ldsb;
  u16* Q = (u16*)((unsigned char*)P.out + DO_Q);
  const u16* Kb = (const u16*)((unsigned char*)P.out + DO_K);
  const u16* Vt = (const u16*)((unsigned char*)P.out + DO_VT);
  u16* XQ = (u16*)(P.ws + OFF_XQ);
  const u16* MK = (const u16*)(P.ws + OFF_MK);
  const u16* MVT = (const u16*)(P.ws + OFF_MVT);
  const int total = 576 + 6144;
  const float LOG2E = 1.4426950408889634f;
  while (true) {
    __syncthreads();
    if (threadIdx.x == 0) s_item = (int)atomicAdd(ctr, 1u);
    __syncthreads();
    const int q = s_item;
    if (q >= total) break;
    int kind, idx;
    if (q < 64) { kind = 1; idx = q; }
    else if (q < 64 + 2560) {
      int q2 = q - 64, grp = q2 / 5, sub = q2 % 5;
      if (sub == 0) { kind = 1; idx = 64 + grp; }
      else { kind = 2; idx = 4 * grp + (sub - 1); }
    }
    else { kind = 3; idx = q - 2624; }
    if (kind == 1) {
      int i2 = idx < 64 ? idx : idx - 64;
      int dir = i2 & 1, head = (i2 >> 1) & 7, sl = i2 >> 4;
      scan_item<1>(P, ldsb, idx < 64 ? 32 + sl : sl, head, dir, 0);
    } else if (kind <= 3) {
      int seq, head, qb, T, start;
      if (kind == 2) { seq = 32 + (idx >> 9); head = (idx >> 6) & 7; qb = idx & 63; T = 8192; start = NTP + (seq - 32) * 8192; }
      else { seq = idx >> 7; head = (idx >> 4) & 7; qb = idx & 15; T = 2048; start = seq * 2048; }
      const size_t tok0 = (size_t)start + qb * 128;
      attn_item<96, 64, true, true>(lds, Q + tok0 * 768 + head * 96, 768, Kb + (size_t)start * 768 + head * 96, 768,
                              Vt + vt_base(seq) + (size_t)head * 64 * T, T, T, P.in[10],
                              0.10206207261596577f * LOG2E, qb * 128, Q + tok0 * 768 + head * 96, 768);
    }
  }
#ifdef SCANREP
  __syncthreads();
  for (int idx = blockIdx.x; idx < 576; idx += gridDim.x) {
    int dir = idx & 1, head = (idx >> 1) & 7, sl = idx >> 4;
    __syncthreads();
    scan_item<1>(P, ldsb, sl, head, dir, 0);
  }
#endif
  __syncthreads();
  unsigned* ctr2 = (unsigned*)(P.ws + OFF_CTL) + 16;
  while (true) {
    __syncthreads();
    if (threadIdx.x == 0) s_item = (int)atomicAdd(ctr2, 1u);
    __syncthreads();
    const int idx = s_item;
    if (idx >= 3072) break;
    int mt = idx >> 2, head = idx & 3;
    int seq, start, T;
    tok_seq(mt * 128, seq, start, T);
    const size_t tok0 = (size_t)mt * 128;
    attn_item<128, 128, false, false>(lds, XQ + tok0 * 512 + head * 128, 512, MK + (size_t)(seq * 4 + head) * 256 * 128, 128,
                                      MVT + (size_t)(seq * 4 + head) * 128 * 256, 256, 256, P.in[32],
                                      0.08838834764831845f * LOG2E, 0, XQ + tok0 * 512 + head * 128, 512);
  }
}

__device__ __forceinline__ void phase5(const Params& P, u16* lds) {
  __shared__ float st_mean[256], st_rstd[256];
  unsigned char* ws = P.ws;
  const u16* RW = (const u16*)(ws + OFF_RW);
  const u16* YF = (const u16*)(ws + OFF_YF);
  u16* YB = (u16*)(ws + OFF_YB);
  const u16* G2 = (const u16*)(ws + OFF_G2);
  const float* mup = P.in[13] + 1792;
  const float* mun = P.in[14] + 1792;
  const float* lng = P.in[27];
  const float* lnb = P.in[28];
  const int tid = threadIdx.x;
  for (int it = blockIdx.x; it < 768 * 4; it += gridDim.x) {
    int mt = it >> 2, nt = it & 3;
    int m0 = mt * 128, n0 = nt * 128;
    int seq, start, T;
    tok_seq(m0, seq, start, T);
    {
      int r = tid >> 1, hh = tid & 1;
      const u16* pf = YF + (size_t)(m0 + r) * 512 + n0 + hh * 64;
      const u16* pb = YB + (size_t)(m0 + r) * 512 + n0 + hh * 64;
      float sm = 0.f, sq = 0.f;
      for (int c = 0; c < 8; c++) {
        uint4 a = *(const uint4*)(pf + 8 * c), b = *(const uint4*)(pb + 8 * c);
        float y;
        y = bflo(a.x) + bflo(b.x); sm += y; sq += y * y; y = bfhi(a.x) + bfhi(b.x); sm += y; sq += y * y;
        y = bflo(a.y) + bflo(b.y); sm += y; sq += y * y; y = bfhi(a.y) + bfhi(b.y); sm += y; sq += y * y;
        y = bflo(a.z) + bflo(b.z); sm += y; sq += y * y; y = bfhi(a.z) + bfhi(b.z); sm += y; sq += y * y;
        y = bflo(a.w) + bflo(b.w); sm += y; sq += y * y; y = bfhi(a.w) + bfhi(b.w); sm += y; sq += y * y;
      }
      float mean = sm * (1.f / 64.f);
      float var = fmaxf(sq * (1.f / 64.f) - mean * mean, 0.f);
      st_mean[tid] = mean;
      st_rstd[tid] = rsqrtf(var + 64e-5f);
    }
    {
      const int lr = tid >> 3, lk = (tid & 7) * 8;
#pragma unroll
      for (int kb = 0; kb < 2; kb++) {
#pragma unroll
        for (int i = 0; i < 4; i++) {
          int r = lr + 32 * i;
          int t = m0 + r - start;
          float v[8];
          mix8(RW + (size_t)(m0 + r) * 1920 + 1792 + kb * 64 + lk, t > 0, t < T - 1, mup + kb * 64 + lk, mun + kb * 64 + lk, v);
          uint4 u;
          u.x = pack2(sigmoidf_(v[0]), sigmoidf_(v[1])); u.y = pack2(sigmoidf_(v[2]), sigmoidf_(v[3]));
          u.z = pack2(sigmoidf_(v[4]), sigmoidf_(v[5])); u.w = pack2(sigmoidf_(v[6]), sigmoidf_(v[7]));
          *(uint4*)(lds + kb * (2 * LTILE) + r * LROW + lk) = u;
          *(uint4*)(lds + kb * (2 * LTILE) + LTILE + r * LROW + lk) = *(const uint4*)(G2 + (size_t)(n0 + r) * 128 + kb * 64 + lk);
        }
      }
    }
    __syncthreads();
    Acc acc; acc_zero(acc);
    gemm_compute(acc, lds, 0);
    gemm_compute(acc, lds, 1);
    epi_each(acc, [&](int r0, int c, float v0, float v1, float v2, float v3) {
      int hh = c >> 6;
      float g = lng[n0 + c], b = lnb[n0 + c];
      float vv[4] = {v0, v1, v2, v3};
#pragma unroll
      for (int k = 0; k < 4; k++) {
        size_t o = (size_t)(m0 + r0 + k) * 512 + n0 + c;
        float y = bf2f(YF[o]) + bf2f(YB[o]);
        int si = (r0 + k) * 2 + hh;
        float yn = (y - st_mean[si]) * st_rstd[si] * g + b;
        YB[o] = f2bf(yn * vv[k]);
      }
    });
    __syncthreads();
  }
}

__device__ __forceinline__ void merge_branch(Acc& mg, u16* lds, const u16* Hrow, const u16* Wg_rows, const u16* Abr,
                                             const u16* Wbr, int Kb) {
  unsigned* G = (unsigned*)(lds + 2 * LTILE);
  {
    Acc acc; acc_zero(acc);
    gemm_lin<false, false>(acc, lds, Hrow, 1024, Wg_rows, 1024, 1024);
#pragma unroll
    for (int i = 0; i < 2; i++)
#pragma unroll
      for (int j = 0; j < 2; j++)
#pragma unroll
        for (int r = 0; r < 8; r++)
          G[((i * 2 + j) * 8 + r) * 256 + threadIdx.x] = pack2(sigmoidf_(acc.a[i][j][2 * r]), sigmoidf_(acc.a[i][j][2 * r + 1]));
  }
  Acc acc; acc_zero(acc);
  gemm_lin<true, false>(acc, lds, Abr, Kb, Wbr, Kb, Kb);
#pragma unroll
  for (int i = 0; i < 2; i++)
#pragma unroll
    for (int j = 0; j < 2; j++)
#pragma unroll
      for (int r = 0; r < 8; r++) {
        unsigned g = G[((i * 2 + j) * 8 + r) * 256 + threadIdx.x];
        mg.a[i][j][2 * r] += bflo(g) * acc.a[i][j][2 * r];
        mg.a[i][j][2 * r + 1] += bfhi(g) * acc.a[i][j][2 * r + 1];
      }
  __syncthreads();
}
__device__ __forceinline__ void phase6(const Params& P, u16* lds) {
  unsigned char* ws = P.ws;
  const u16* H = (const u16*)(ws + OFF_H);
  const u16* Wg = (const u16*)(ws + OFF_WIN) + (size_t)3200 * 1024;
  u16* MG = (u16*)(ws + OFF_MERGED);
  const u16* A0 = (const u16*)((unsigned char*)P.out + DO_Q);
  const u16* A1 = (const u16*)(ws + OFF_YB);
  const u16* A2 = (const u16*)(ws + OFF_XQ);
  const u16* W0 = (const u16*)(ws + OFF_WOA);
  const u16* W1 = (const u16*)(ws + OFF_WOB);
  const u16* W2 = (const u16*)(ws + OFF_WOC);
  for (int kk_ = 0;; kk_++) {
    int mt, nt;
    if (!tile_map(kk_, 768, 8, mt, nt)) break;
    int m0 = mt * 128, n0 = nt * 128;
    Acc mg; acc_zero(mg);
    const u16* Hrow = H + (size_t)m0 * 1024;
#pragma nounroll
    for (int br = 0; br < 3; br++) {
      const u16* Ab = br == 0 ? A0 + (size_t)m0 * 768 : (br == 1 ? A1 + (size_t)m0 * 512 : A2 + (size_t)m0 * 512);
      const u16* Wb = br == 0 ? W0 + (size_t)n0 * 768 : (br == 1 ? W1 + (size_t)n0 * 512 : W2 + (size_t)n0 * 512);
      merge_branch(mg, lds, Hrow, Wg + (size_t)(br * 1024 + n0) * 1024, Ab, Wb, br == 0 ? 768 : 512);
    }
    epi_each(mg, [&](int r0, int c, float v0, float v1, float v2, float v3) {
      store_bf16_pairs(MG + (size_t)(m0 + r0) * 1024 + n0 + c, 1024, c, v0, v1, v2, v3);
    });
  }
}

__device__ __forceinline__ void phase7(const Params& P, u16* lds) {
  __shared__ float rs_s[128];
  unsigned char* ws = P.ws;
  const u16* MG = (const u16*)(ws + OFF_MERGED);
  const u16* W = (const u16*)(ws + OFF_WOUT);
  u16* HB = (u16*)(ws + OFF_H);
  float* RS = (float*)(ws + OFF_RS);
  const int tid = threadIdx.x, lane = tid & 63;
  for (int kk_ = 0;; kk_++) {
    int mt, nt;
    if (!tile_map(kk_, 768, 8, mt, nt)) break;
    int m0 = mt * 128, n0 = nt * 128;
    if (tid < 128) rs_s[tid] = 0.f;
    Acc acc; acc_zero(acc);
    gemm_lin(acc, lds, MG + (size_t)m0 * 1024, 1024, W + (size_t)n0 * 1024, 1024, 1024);
    const float* xin = m0 < NTP ? P.in[0] + (size_t)m0 * 1024 : P.in[1] + (size_t)(m0 - NTP) * 1024;
    float* xo = P.out + (size_t)m0 * 1024;
    epi_each(acc, [&](int r0, int c, float v0, float v1, float v2, float v3) {
      size_t o = (size_t)r0 * 1024 + n0 + c;
      const float y0 = xin[o] + v0, y1 = xin[o + 1024] + v1, y2 = xin[o + 2048] + v2, y3 = xin[o + 3072] + v3;
      xo[o] = y0; xo[o + 1024] = y1; xo[o + 2048] = y2; xo[o + 3072] = y3;
      store_bf16_pairs(HB + (size_t)(m0 + r0) * 1024 + n0 + c, 1024, c, y0, y1, y2, y3);
      const float s0 = sum16(y0 * y0), s1 = sum16(y1 * y1), s2 = sum16(y2 * y2), s3 = sum16(y3 * y3);
      if ((lane & 15) == 0) {
        atomicAdd(&rs_s[r0], s0); atomicAdd(&rs_s[r0 + 1], s1); atomicAdd(&rs_s[r0 + 2], s2); atomicAdd(&rs_s[r0 + 3], s3);
      }
    });
    __syncthreads();
    if (tid < 128) atomicAdd(&RS[m0 + tid], rs_s[tid]);
    __syncthreads();
  }
}

__device__ __forceinline__ void phase8(const Params& P) {
  const int wave = threadIdx.x >> 6;
  u16* H = (u16*)(P.ws + OFF_H);
  for (int row = blockIdx.x * 4 + wave; row < NT; row += gridDim.x * 4)
    norm_row(P.out + (size_t)row * 1024, H + (size_t)row * 1024);
}

__device__ __forceinline__ float erf_as(float x) {
  const float ax = fabsf(x);
  const float t = __builtin_amdgcn_rcpf(1.f + 0.3275911f * ax);
  const float y = ((((1.061405429f * t - 1.453152027f) * t + 1.421413741f) * t - 0.284496736f) * t + 0.254829592f) * t;
  const float r = 1.f - y * __builtin_amdgcn_exp2f(-ax * ax * 1.4426950408889634f);
  return copysignf(r, x);
}
__device__ __forceinline__ void phase9(const Params& P, u16* lds) {
  unsigned char* ws = P.ws;
  const u16* H = (const u16*)(ws + OFF_H);
  const u16* W = (const u16*)(ws + OFF_WUP);
  u16* ACT = (u16*)(ws + OFF_ACT);
  const float* cw = P.in[38];
  const float* cb = P.in[39];
  float* Lf = (float*)lds;
  __shared__ float rstd9[128];
  const float* RS = (const float*)(ws + OFF_RS);
  const int tid = threadIdx.x, lane = tid & 63, wave = tid >> 6, wm = wave >> 1, wn = wave & 1;
  for (int kk_ = 0;; kk_++) {
    int mt, nt;
    if (!tile_map(kk_, 808, 44, mt, nt)) break;
    int start, T, ti;
    if (mt < 544) { int s = mt / 17; ti = mt % 17; start = s * 2048; T = 2048; }
    else { int m2 = mt - 544; int s = m2 / 66; ti = m2 % 66; start = NTP + s * 8192; T = 8192; }
    const int p0 = 126 * ti - 1;
    const int lr = tid >> 3;
    const u16* pa[4];
#pragma unroll
    for (int i = 0; i < 4; i++) {
      int p = p0 + lr + 32 * i;
      p = p < 0 ? 0 : (p > T - 1 ? T - 1 : p);
      pa[i] = H + (size_t)(start + p) * 1024;
    }
    const u16* Bt = W + (size_t)nt * 128 * 1024;
    if (tid < 128) {
      int p = p0 + tid;
      p = p < 0 ? 0 : (p > T - 1 ? T - 1 : p);
      rstd9[tid] = rsqrtf(RS[start + p] * (1.f / 1024.f) + 1e-6f);
    }
    Acc acc; acc_zero(acc);
    gemm_main(acc, lds, pa[0], pa[1], pa[2], pa[3], Bt + (size_t)lr * 1024, Bt + (size_t)(lr + 32) * 1024,
              Bt + (size_t)(lr + 64) * 1024, Bt + (size_t)(lr + 96) * 1024, 1024);
    {
      float* dst = Lf + wn * 8192;
#pragma unroll
      for (int i = 0; i < 2; i++)
#pragma unroll
        for (int j = 0; j < 2; j++)
#pragma unroll
          for (int r = 0; r < 16; r++) {
            int rr = 64 * wm + 32 * i + (r & 3) + 8 * (r >> 2) + 4 * (lane >> 5);
            dst[rr * 64 + 32 * j + (lane & 31)] = acc.a[i][j][r] * rstd9[rr];
          }
    }
    __syncthreads();
    {
      const int c = tid & 63, rgp = tid >> 6;
      const int col = nt * 64 + c;
      const float w0 = cw[col], w1 = cw[2816 + col], w2 = cw[2 * 2816 + col], bb = cb[col];
      int rbeg = rgp * 32; if (rbeg < 1) rbeg = 1;
      int rend = rgp * 32 + 32; if (rend > 127) rend = 127;
      auto gval = [&](int r) { int p = p0 + r; return (p >= 0 && p < T) ? Lf[r * 64 + c] : 0.f; };
      float gp = gval(rbeg - 1), gc = gval(rbeg);
      for (int r = rbeg; r < rend; r++) {
        float gn = gval(r + 1);
        int p = p0 + r;
        if (p < T) {
          float cc = w0 * gp + w1 * gc + w2 * gn + bb;
          float a = 0.5f * cc * (1.f + erf_as(cc * 0.70710678118654752f)) * Lf[8192 + r * 64 + c];
          ACT[(size_t)(start + p) * 2816 + col] = f2bf(a);
        }
        gp = gc; gc = gn;
      }
    }
    __syncthreads();
  }
}

__device__ __forceinline__ void phase10(const Params& P, u16* lds) {
  unsigned char* ws = P.ws;
  const u16* ACT = (const u16*)(ws + OFF_ACT);
  const u16* W = (const u16*)(ws + OFF_WDOWN);
  for (int kk_ = 0;; kk_++) {
    int mt, nt;
    if (!tile_map(kk_, 768, 8, mt, nt)) break;
    int m0 = mt * 128, n0 = nt * 128;
    Acc acc; acc_zero(acc);
    gemm_lin(acc, lds, ACT + (size_t)m0 * 2816, 2816, W + (size_t)n0 * 2816, 2816, 2816);
    float* xo = P.out + (size_t)m0 * 1024;
    epi_each(acc, [&](int r0, int c, float v0, float v1, float v2, float v3) {
      size_t o = (size_t)r0 * 1024 + n0 + c;
      xo[o] += v0; xo[o + 1024] += v1; xo[o + 2048] += v2; xo[o + 3072] += v3;
    });
  }
}

constexpr int NPHASE = 11;
__global__ void __launch_bounds__(NTHREADS, 2) fwd_kernel(Params P) {
  extern __shared__ __attribute__((aligned(16))) unsigned char dlds[];
  cg::grid_group grid = cg::this_grid();
  u16* lds = (u16*)dlds;
#ifndef REPMASK
#define REPMASK 0
#endif
#define PH(k, call)                                   \
  if (P.lo <= (k) && (k) < P.hi) {                    \
    call;                                             \
    if ((REPMASK >> (k)) & 1) { grid.sync(); call; }  \
    if ((k) + 1 < P.hi) grid.sync();                  \
  }
  PH(0, (phase0(P), phase0b(P)))
  PH(1, phase1(P, lds))
  PH(2, phase2(P, lds))
  PH(3, phase3(P))
  PH(4, phase4(P, dlds))
  PH(5, phase5(P, lds))
  PH(6, phase6(P, lds))
  PH(7, phase7(P, lds))
  PH(9, phase9(P, lds))
  PH(10, phase10(P, lds))
#undef PH
}

extern "C" void kernel_launch(void* const* d_in, const int* in_sizes, int n_in, void* d_out, int out_size, void* d_ws,
                              size_t ws_size, hipStream_t stream) {
  static int grid_blocks = 0;
  if (!grid_blocks) {
    int dev = 0, cus = 0, per_cu = 0;
    hipGetDevice(&dev);
    hipDeviceGetAttribute(&cus, hipDeviceAttributeMultiprocessorCount, dev);
    hipFuncSetAttribute((const void*)fwd_kernel, hipFuncAttributeMaxDynamicSharedMemorySize, LDS_BYTES);
    hipOccupancyMaxActiveBlocksPerMultiprocessor(&per_cu, (const void*)fwd_kernel, NTHREADS, LDS_BYTES);
    if (per_cu < 1) per_cu = 1;
    if (per_cu > 2) per_cu = 2;
    grid_blocks = cus * per_cu;
    if (ws_size < WS_END) fprintf(stderr, "workspace too small: %zu < %zu\n", ws_size, (size_t)WS_END);
  }
  if (ws_size < WS_END) return;
  Params p{};
  for (int i = 0; i < 41; i++) p.in[i] = (const float*)d_in[i];
  p.out = (float*)d_out;
  p.ws = (unsigned char*)d_ws;
#if MEGA
  p.lo = 0; p.hi = NPHASE;
  void* args[] = {&p};
  hipError_t e = hipLaunchCooperativeKernel((const void*)fwd_kernel, dim3(grid_blocks), dim3(NTHREADS), args, LDS_BYTES, stream);
  if (e != hipSuccess) fprintf(stderr, "cooperative launch failed: %s (grid %d)\n", hipGetErrorString(e), grid_blocks);
#else
#ifndef PHMAX
#define PHMAX 11
#endif
  for (int k = 0; k < PHMAX; k++) {
    p.lo = k; p.hi = k + 1;
    hipLaunchKernelGGL(fwd_kernel, dim3(grid_blocks), dim3(NTHREADS), LDS_BYTES, stream, p);
  }
#endif
}
```
